# Optimizing an MI355X kernel written in HIP

```python
import math
import jax, jax.numpy as jnp
from jax import lax
import numpy as np

D_MODEL = 2048
BATCH = 4
SEQ = 4096
DEPTH = 1

HEAD_DIM = 128
N_HEADS_A = 8
N_HEADS_B = 8
D_A = N_HEADS_A * HEAD_DIM
D_B = N_HEADS_B * HEAD_DIM
D_MIX = D_A + D_B
Q_RANK = 512
IDX_HEADS = 16
IDX_DIM = 64
TOPK_MAX = 256
N_BUCKETS = 32
MAX_DISTANCE = 128
Q_BLOCK = 128
N_GROUPS = 4
EXPERTS_PER_GROUP = 8
N_EXPERTS = N_GROUPS * EXPERTS_PER_GROUP
EXPERT_TOPK = 2
D_EXPERT = 512
MOE_BLOCK = 128
N_MOD = 6
EPS = 1e-6
IN_COLS = (Q_RANK, HEAD_DIM, HEAD_DIM, IDX_DIM, IDX_HEADS, D_B, D_B, D_B)
D_IN = sum(IN_COLS)

kernel_name = "hymba_dsa_stickbreak_hmoe_layer"


def rms_norm(x, g):
    xf = x.astype(jnp.float32)
    y = xf * lax.rsqrt(jnp.mean(xf * xf, axis=-1, keepdims=True) + EPS)
    return (y * g.astype(jnp.float32)).astype(x.dtype)


def t5_bucket(dist):
    max_exact = N_BUCKETS // 2
    d = jnp.maximum(dist, 1).astype(jnp.float32)
    large = max_exact + (jnp.log(d / max_exact) / math.log(MAX_DISTANCE / max_exact)
                         * (N_BUCKETS - max_exact)).astype(jnp.int32)
    large = jnp.minimum(large, N_BUCKETS - 1)
    return jnp.where(dist < max_exact, dist, large)


def dsa_block(q_blk, qi_blk, wi_blk, t_blk, k, v, k_idx, rel_bias, topk):
    s_pos = jnp.arange(k.shape[1], dtype=jnp.int32)
    causal = s_pos[None, :] <= t_blk[:, None]
    sc = jnp.einsum('bqhd,bsd->bqhs', qi_blk, k_idx)
    score = jnp.einsum('bqhs,bqh->bqs', jax.nn.relu(sc), wi_blk).astype(jnp.float32)
    score = jnp.where(causal[None], score, -jnp.inf)
    _, sel = lax.top_k(score, topk)
    valid = sel <= t_blk[None, :, None]
    k_sel = jax.vmap(lambda kk, ii: kk[ii])(k, sel)
    v_sel = jax.vmap(lambda vv, ii: vv[ii])(v, sel)
    logits = jnp.einsum('bqhd,bqkd->bqhk', q_blk, k_sel).astype(jnp.float32)
    bias = rel_bias[t5_bucket(jnp.maximum(t_blk[None, :, None] - sel, 0))]
    logits = logits + jnp.moveaxis(bias, -1, 2).astype(jnp.float32)
    logits = jnp.where(valid[:, :, None, :], logits, -jnp.inf)
    p = jax.nn.softmax(logits, axis=-1)
    return jnp.einsum('bqhk,bqkd->bqhd', p.astype(v.dtype), v_sel)


def stick_breaking_block(q_blk, t_blk, k, v):
    s_pos = jnp.arange(k.shape[1], dtype=jnp.int32)
    strict = (s_pos[None, :] < t_blk[:, None])[None, None]
    z = jnp.einsum('bqhd,bshd->bhqs', q_blk, k).astype(jnp.float32)
    log_1m = jnp.where(strict, jax.nn.log_sigmoid(-z), 0.0)
    tail = lax.cumsum(log_1m, axis=3, reverse=True) - log_1m
    a = jnp.where(strict, jnp.exp(jax.nn.log_sigmoid(z) + tail), 0.0)
    return jnp.einsum('bhqs,bshd->bqhd', a.astype(v.dtype), v)


def hybrid_mixer(h, w_in, q_norm_g, w_q_up, q_gain, k_gain, rel_bias, gn_a, gn_b, w_out):
    B, S, _ = h.shape
    splits = list(np.cumsum(IN_COLS)[:-1])
    c_q, k_a, v_a, k_idx, w_idx, q_b, k_b, v_b = jnp.split(h @ w_in, splits, axis=-1)
    q_up = rms_norm(c_q, q_norm_g) @ w_q_up
    q_a = q_up[..., :D_A].reshape(B, S, N_HEADS_A, HEAD_DIM)
    q_a = rms_norm(q_a, q_gain) * (HEAD_DIM ** -0.5)
    k_a = rms_norm(k_a, k_gain)
    q_idx = q_up[..., D_A:].reshape(B, S, IDX_HEADS, IDX_DIM) * (IDX_DIM ** -0.5)
    w_idx = w_idx * (IDX_HEADS ** -0.5)
    q_b = q_b.reshape(B, S, N_HEADS_B, HEAD_DIM) * (HEAD_DIM ** -0.5)
    k_b = k_b.reshape(B, S, N_HEADS_B, HEAD_DIM)
    v_b = v_b.reshape(B, S, N_HEADS_B, HEAD_DIM)

    topk = min(TOPK_MAX, S // 4)
    nb = S // Q_BLOCK

    def to_blocks(a):
        return jnp.moveaxis(a.reshape(B, nb, Q_BLOCK, *a.shape[2:]), 1, 0)

    t_all = jnp.arange(S, dtype=jnp.int32).reshape(nb, Q_BLOCK)

    def per_block(args):
        qa, qi, wi, qb, t = args
        oa = dsa_block(qa, qi, wi, t, k_a, v_a, k_idx, rel_bias, topk)
        ob = stick_breaking_block(qb, t, k_b, v_b)
        return oa, ob

    o_a, o_b = lax.map(per_block, (to_blocks(q_a), to_blocks(q_idx), to_blocks(w_idx),
                                   to_blocks(q_b), t_all))
    o_a = jnp.moveaxis(o_a, 0, 1).reshape(B, S, D_A)
    o_b = jnp.moveaxis(o_b, 0, 1).reshape(B, S, D_B)
    o = jnp.concatenate([rms_norm(o_a, gn_a), rms_norm(o_b, gn_b)], axis=-1)
    return o @ w_out


def hierarchical_moe(h, router_g, router_e, w_gate, w_up, w_down):
    n, d = h.shape
    pg = jax.nn.softmax((h @ router_g).astype(jnp.float32), axis=-1)
    g_idx = jnp.argmax(pg, axis=-1).astype(jnp.int32)
    g_w = jnp.max(pg, axis=-1)
    le = (h @ router_e).astype(jnp.float32).reshape(n, N_GROUPS, EXPERTS_PER_GROUP)
    le = jnp.take_along_axis(le, g_idx[:, None, None], axis=1)[:, 0]
    top_p, top_i = lax.top_k(jax.nn.softmax(le, axis=-1), EXPERT_TOPK)
    gate = g_w[:, None] * top_p / jnp.sum(top_p, axis=-1, keepdims=True)
    expert = g_idx[:, None] * EXPERTS_PER_GROUP + top_i.astype(jnp.int32)

    a = n * EXPERT_TOPK
    flat_e = expert.reshape(a)
    flat_w = gate.reshape(a)
    flat_tok = jnp.repeat(jnp.arange(n, dtype=jnp.int32), EXPERT_TOPK)
    order = jnp.argsort(flat_e)
    se = flat_e[order]
    counts = jnp.bincount(flat_e, length=N_EXPERTS).astype(jnp.int32)
    padded = (counts + MOE_BLOCK - 1) // MOE_BLOCK * MOE_BLOCK
    pad_end = jnp.cumsum(padded)
    pad_start = pad_end - padded
    start = jnp.cumsum(counts) - counts
    dest = pad_start[se] + jnp.arange(a, dtype=jnp.int32) - start[se]
    p = a + N_EXPERTS * MOE_BLOCK
    nb = p // MOE_BLOCK
    buf_tok = jnp.zeros((p,), jnp.int32).at[dest].set(flat_tok[order])
    buf_w = jnp.zeros((p,), jnp.float32).at[dest].set(flat_w[order])
    blk_expert = jnp.minimum(
        jnp.searchsorted(pad_end, jnp.arange(nb, dtype=jnp.int32) * MOE_BLOCK, side='right'),
        N_EXPERTS - 1)
    xb = h[buf_tok].reshape(nb, MOE_BLOCK, d)

    def expert_block(args):
        xe, e = args
        u = jax.nn.silu(xe @ w_gate[e]) * (xe @ w_up[e])
        return u @ w_down[e]

    yb = lax.map(expert_block, (xb, blk_expert)).reshape(p, d)
    return jnp.zeros_like(h).at[buf_tok].add(yb * buf_w[:, None].astype(h.dtype))


def setup_inputs(seed: int = 0) -> dict:
    key = jax.random.key(seed)
    ks = jax.random.split(key, 24)
    f = jnp.float32
    nrm = lambda k, shape, s: jax.random.normal(k, shape, f) * s
    L, D = DEPTH, D_MODEL
    return {
        "x": nrm(ks[0], (BATCH, SEQ, D), 1.0),
        "c": nrm(ks[1], (BATCH, D), 1.0),
        "w_mod": nrm(ks[2], (L, D, N_MOD * D), 0.5 * D ** -0.5),
        "b_mod": nrm(ks[3], (L, N_MOD * D), 0.02),
        "ln1_g": 1.0 + nrm(ks[4], (L, D), 0.02),
        "w_in": nrm(ks[5], (L, D, D_IN), D ** -0.5),
        "q_norm_g": 1.0 + nrm(ks[6], (L, Q_RANK), 0.02),
        "w_q_up": nrm(ks[7], (L, Q_RANK, D_A + IDX_HEADS * IDX_DIM), Q_RANK ** -0.5),
        "q_gain": 1.0 + nrm(ks[8], (L, HEAD_DIM), 0.02),
        "k_gain": 1.0 + nrm(ks[9], (L, HEAD_DIM), 0.02),
        "rel_bias": nrm(ks[10], (N_BUCKETS, N_HEADS_A), 0.5),
        "gn_a": 1.0 + nrm(ks[11], (L, D_A), 0.02),
        "gn_b": 1.0 + nrm(ks[12], (L, D_B), 0.02),
        "w_out": nrm(ks[13], (L, D_MIX, D), D_MIX ** -0.5),
        "ln2_g": 1.0 + nrm(ks[14], (L, D), 0.02),
        "router_g": nrm(ks[15], (L, D, N_GROUPS), D ** -0.5),
        "router_e": nrm(ks[16], (L, D, N_EXPERTS), D ** -0.5),
        "w_gate": nrm(ks[17], (L, N_EXPERTS, D, D_EXPERT), D ** -0.5),
        "w_up": nrm(ks[18], (L, N_EXPERTS, D, D_EXPERT), D ** -0.5),
        "w_down": nrm(ks[19], (L, N_EXPERTS, D_EXPERT, D), D_EXPERT ** -0.5),
    }


def reference(x, c, w_mod, b_mod, ln1_g, w_in, q_norm_g, w_q_up, q_gain, k_gain, rel_bias,
              gn_a, gn_b, w_out, ln2_g, router_g, router_e, w_gate, w_up, w_down):
    B, S, D = x.shape
    for l in range(DEPTH):
        mod = jax.nn.silu(c) @ w_mod[l] + b_mod[l]
        sh1, sc1, g1, sh2, sc2, g2 = [m[:, None, :] for m in jnp.split(mod, N_MOD, axis=-1)]
        h = rms_norm(x, ln1_g[l]) * (1.0 + sc1) + sh1
        x = x + g1 * hybrid_mixer(h, w_in[l], q_norm_g[l], w_q_up[l], q_gain[l], k_gain[l],
                                  rel_bias, gn_a[l], gn_b[l], w_out[l])
        h = rms_norm(x, ln2_g[l]) * (1.0 + sc2) + sh2
        y = hierarchical_moe(h.reshape(B * S, D), router_g[l], router_e[l],
                             w_gate[l], w_up[l], w_down[l])
        x = x + g2 * y.reshape(B, S, D)
    return x
```

```cpp
#include <hip/hip_runtime.h>
#include <stdint.h>

typedef unsigned short bf16_t;

constexpr int D = 2048, NB = 4, S = 4096, M = NB * S;
constexpr int NMOD = 6 * D;
constexpr int DIN = 3920;
constexpr float EPS = 1e-6f;
constexpr size_t MiB = 1ull << 20;
constexpr size_t WS_MOD = 1 * MiB;
constexpr size_t WS_RC = 2 * MiB;
constexpr size_t WS_EID = 3 * MiB;
constexpr size_t WS_GW = 4 * MiB;
constexpr size_t WS_XN = 8 * MiB;
constexpr size_t WS_B0 = 72 * MiB;
constexpr size_t WS_QB = 104 * MiB;
constexpr size_t WS_KB = 136 * MiB;
constexpr size_t WS_VB = 168 * MiB;
constexpr size_t WS_QA = 200 * MiB;
constexpr size_t WS_QI = 232 * MiB;
constexpr size_t WS_SEL = 264 * MiB;
constexpr size_t WS_O = 272 * MiB;
constexpr size_t WS_OBRAW = 336 * MiB;
constexpr size_t WS_END = 400 * MiB;

__device__ __forceinline__ float bf2f(bf16_t v) { return __uint_as_float(((unsigned)v) << 16); }
__device__ __forceinline__ bf16_t f2bf(float f) { unsigned u = __float_as_uint(f); u += 0x7fffu + ((u >> 16) & 1u); return (bf16_t)(u >> 16); }
__device__ __forceinline__ float silu_f(float v) { return v / (1.f + __expf(-v)); }

__device__ __forceinline__ float block_sum(float v, float* sh) {
    for (int o = 32; o > 0; o >>= 1) v += __shfl_xor(v, o);
    const int w = threadIdx.x >> 6, nw = blockDim.x >> 6;
    __syncthreads();
    if ((threadIdx.x & 63) == 0) sh[w] = v;
    __syncthreads();
    float t = 0.f;
    for (int i = 0; i < nw; ++i) t += sh[i];
    return t;
}
__device__ __forceinline__ int block_sum_i(int v, int* sh) {
    for (int o = 32; o > 0; o >>= 1) v += __shfl_xor(v, o);
    const int w = threadIdx.x >> 6, nw = blockDim.x >> 6;
    __syncthreads();
    if ((threadIdx.x & 63) == 0) sh[w] = v;
    __syncthreads();
    int t = 0;
    for (int i = 0; i < nw; ++i) t += sh[i];
    return t;
}

__global__ void __launch_bounds__(256) k_mod(const float* __restrict__ c, const float* __restrict__ w_mod, const float* __restrict__ b_mod, float* __restrict__ mod) {
    __shared__ float sc[NB * D];
    for (int i = threadIdx.x; i < NB * D; i += 256) sc[i] = silu_f(c[i]);
    __syncthreads();
    const int n = blockIdx.x * 256 + threadIdx.x;
    float a0 = 0, a1 = 0, a2 = 0, a3 = 0;
    for (int k = 0; k < D; ++k) {
        const float w = w_mod[(size_t)k * NMOD + n];
        a0 += sc[k] * w; a1 += sc[D + k] * w; a2 += sc[2 * D + k] * w; a3 += sc[3 * D + k] * w;
    }
    const float bb = b_mod[n];
    mod[n] = a0 + bb; mod[NMOD + n] = a1 + bb; mod[2 * NMOD + n] = a2 + bb; mod[3 * NMOD + n] = a3 + bb;
}

__global__ void __launch_bounds__(256) k_xn(const float* __restrict__ x, const float* __restrict__ g, const float* __restrict__ mod, bf16_t* __restrict__ XN) {
    __shared__ float sh[8];
    const int m = blockIdx.x, b = m >> 12;
    const float* xr = x + (size_t)m * D;
    float v[8]; float ss = 0.f;
    for (int i = 0; i < 8; ++i) { v[i] = xr[threadIdx.x + 256 * i]; ss += v[i] * v[i]; }
    ss = block_sum(ss, sh);
    const float rstd = rsqrtf(ss * (1.f / D) + EPS);
    const float* mb = mod + (size_t)b * NMOD;
    for (int i = 0; i < 8; ++i) { const int k = threadIdx.x + 256 * i; const float y = v[i] * rstd * g[k]; XN[(size_t)m * D + k] = f2bf(y * (1.f + mb[D + k]) + mb[k]); }
}

struct EpiIn {
    bf16_t* B0; bf16_t* QB; bf16_t* KB; bf16_t* VB;
    __device__ void operator()(int m, int n, float v) const {
        if (n < 848) { if (n >= 832) v *= 0.25f; B0[(size_t)m * 1024 + n] = f2bf(v); }
        else if (n < 1872) QB[(size_t)m * 1024 + (n - 848)] = f2bf(v * 0.08838834764831845f);
        else if (n < 2896) KB[(size_t)m * 1024 + (n - 1872)] = f2bf(v);
        else VB[(size_t)m * 1024 + (n - 2896)] = f2bf(v);
    }
};
struct EpiQup {
    const float* RC; bf16_t* QA; bf16_t* QI;
    __device__ void operator()(int m, int n, float v) const {
        v *= RC[m];
        if (n < 1024) QA[(size_t)m * 1024 + n] = f2bf(v); else QI[(size_t)m * 1024 + (n - 1024)] = f2bf(v * 0.125f);
    }
};
struct EpiOut {
    const float* x; const float* mod; float* out;
    __device__ void operator()(int m, int n, float v) const { const int b = m >> 12; out[(size_t)m * D + n] = x[(size_t)m * D + n] + mod[(size_t)b * NMOD + 2 * D + n] * v; }
};
template <class Epi>
__global__ void __launch_bounds__(256) k_gemm(const bf16_t* __restrict__ A, int lda, const float* __restrict__ W, int ldw, const float* __restrict__ kscale, int K, int N, Epi epi) {
    const int n = blockIdx.x * 256 + threadIdx.x; const int m0 = blockIdx.y * 8;
    if (n >= N) return;
    float acc[8];
    for (int i = 0; i < 8; ++i) acc[i] = 0.f;
    for (int k = 0; k < K; k += 2) {
        float w0 = W[(size_t)k * ldw + n], w1 = W[(size_t)(k + 1) * ldw + n];
        if (kscale) { w0 *= kscale[k]; w1 *= kscale[k + 1]; }
#pragma unroll
        for (int i = 0; i < 8; ++i) { const unsigned a = *(const unsigned*)(A + (size_t)(m0 + i) * lda + k); acc[i] += __uint_as_float(a << 16) * w0 + __uint_as_float(a & 0xffff0000u) * w1; }
    }
    for (int i = 0; i < 8; ++i) epi(m0 + i, n, acc[i]);
}

__global__ void __launch_bounds__(64) k_cqk(bf16_t* __restrict__ B0, const float* __restrict__ k_gain, float* __restrict__ RC) {
    const int m = blockIdx.x, l = threadIdx.x;
    bf16_t* r = B0 + (size_t)m * 1024;
    float ss = 0.f;
    for (int i = 0; i < 8; ++i) { const float v = bf2f(r[l + 64 * i]); ss += v * v; }
    for (int o = 32; o > 0; o >>= 1) ss += __shfl_xor(ss, o);
    if (l == 0) RC[m] = rsqrtf(ss * (1.f / 512.f) + EPS);
    const float k0 = bf2f(r[512 + l]), k1 = bf2f(r[576 + l]);
    float s2 = k0 * k0 + k1 * k1;
    for (int o = 32; o > 0; o >>= 1) s2 += __shfl_xor(s2, o);
    const float rs = rsqrtf(s2 * (1.f / 128.f) + EPS);
    r[512 + l] = f2bf(k0 * rs * k_gain[l]); r[576 + l] = f2bf(k1 * rs * k_gain[64 + l]);
}

__device__ __forceinline__ unsigned fkey(float f) { const unsigned u = __float_as_uint(f); return (u & 0x80000000u) ? ~u : (u | 0x80000000u); }
__device__ __forceinline__ int t5_bucket(int dist) {
    if (dist < 16) return dist;
    int large = 16 + (int)(__logf((float)dist * (1.f / 16.f)) / 2.0794415416798357f * 16.f);
    return large < 31 ? large : 31;
}

__global__ void __launch_bounds__(256) k_dsa(const bf16_t* __restrict__ B0, const bf16_t* __restrict__ QI, const bf16_t* __restrict__ QA, const float* __restrict__ q_gain,
                                             const float* __restrict__ rel_bias, const float* __restrict__ gn_a, bf16_t* __restrict__ SEL, bf16_t* __restrict__ O) {
    __shared__ float s_qi[1024];
    __shared__ float s_w[16];
    __shared__ float s_sc[4096];
    __shared__ int s_sel[256];
    __shared__ float s_q[1024];
    __shared__ float s_p[8 * 256];
    __shared__ float s_red[8];
    __shared__ int s_redi[8];
    __shared__ int s_wc[2][4];
    __shared__ float s_hss[8];
    const int tid = threadIdx.x, lane = tid & 63, wv = tid >> 6;
    const int m = blockIdx.x, b = m >> 12, t = m & 4095, n = t + 1;
    for (int i = tid; i < 1024; i += 256) s_qi[i] = bf2f(QI[(size_t)m * 1024 + i]);
    if (tid < 16) s_w[tid] = bf2f(B0[(size_t)m * 1024 + 832 + tid]);
    if (tid < 8) s_hss[tid] = 0.f;
    __syncthreads();
    for (int s = tid; s < n; s += 256) {
        const bf16_t* kp = B0 + (size_t)(b * S + s) * 1024 + 768;
        float kd[64];
        for (int d = 0; d < 64; ++d) kd[d] = bf2f(kp[d]);
        float sc = 0.f;
        for (int h = 0; h < 16; ++h) { float a = 0.f; for (int d = 0; d < 64; ++d) a += s_qi[h * 64 + d] * kd[d]; sc += s_w[h] * fmaxf(a, 0.f); }
        s_sc[s] = sc;
    }
    __syncthreads();
    int cnt;
    if (n <= 256) { cnt = n; s_sel[tid] = tid < n ? tid : 0; }
    else {
        cnt = 256;
        unsigned T = 0u;
        for (int bit = 31; bit >= 0; --bit) {
            const unsigned cand = T | (1u << bit);
            int c = 0;
            for (int s = tid; s < n; s += 256) c += fkey(s_sc[s]) >= cand ? 1 : 0;
            c = block_sum_i(c, s_redi);
            if (c >= 256) T = cand;
        }
        int cg = 0;
        for (int s = tid; s < n; s += 256) cg += fkey(s_sc[s]) > T ? 1 : 0;
        cg = block_sum_i(cg, s_redi);
        const int need = 256 - cg;
        int run_sel = 0, run_eq = 0;
        for (int base = 0; base < n; base += 256) {
            const int s = base + tid; const bool valid = s < n; const unsigned k = valid ? fkey(s_sc[s]) : 0u;
            const bool isgt = valid && k > T, iseq = valid && k == T;
            const unsigned long long beq = __ballot(iseq);
            const unsigned long long ltm = (1ull << lane) - 1ull;
            __syncthreads();
            if (lane == 0) s_wc[0][wv] = __popcll(beq);
            __syncthreads();
            int eqb = run_eq, eqtot = 0;
            for (int w = 0; w < 4; ++w) { if (w < wv) eqb += s_wc[0][w]; eqtot += s_wc[0][w]; }
            const int trank = eqb + __popcll(beq & ltm);
            const bool take = isgt || (iseq && trank < need);
            const unsigned long long bt = __ballot(take);
            if (lane == 0) s_wc[1][wv] = __popcll(bt);
            __syncthreads();
            int pb = run_sel, ptot = 0;
            for (int w = 0; w < 4; ++w) { if (w < wv) pb += s_wc[1][w]; ptot += s_wc[1][w]; }
            if (take) s_sel[pb + __popcll(bt & ltm)] = s;
            run_sel += ptot; run_eq += eqtot;
        }
    }
    __syncthreads();
    SEL[(size_t)m * 256 + tid] = (bf16_t)(tid < cnt ? s_sel[tid] : 0);
    float qv[4];
    for (int i = 0; i < 4; ++i) { const int e = tid + 256 * i; qv[i] = bf2f(QA[(size_t)m * 1024 + e]); atomicAdd(&s_hss[e >> 7], qv[i] * qv[i]); }
    __syncthreads();
    for (int i = 0; i < 4; ++i) { const int e = tid + 256 * i; s_q[e] = qv[i] * rsqrtf(s_hss[e >> 7] * (1.f / 128.f) + EPS) * q_gain[e & 127] * 0.08838834764831845f; }
    __syncthreads();
    {
        const int j = tid;
        if (j < cnt) {
            const int s = s_sel[j];
            const bf16_t* kp = B0 + (size_t)(b * S + s) * 1024 + 512;
            float lg[8];
            for (int h = 0; h < 8; ++h) lg[h] = 0.f;
            for (int d = 0; d < 128; ++d) { const float kv = bf2f(kp[d]); for (int h = 0; h < 8; ++h) lg[h] += s_q[h * 128 + d] * kv; }
            const int bk = t5_bucket(t - s);
            for (int h = 0; h < 8; ++h) s_p[h * 256 + j] = lg[h] + rel_bias[bk * 8 + h];
        } else for (int h = 0; h < 8; ++h) s_p[h * 256 + j] = -INFINITY;
    }
    __syncthreads();
    for (int hh = 0; hh < 2; ++hh) {
        const int h = wv * 2 + hh;
        float v[4]; float mx = -INFINITY;
        for (int i = 0; i < 4; ++i) { v[i] = s_p[h * 256 + lane + 64 * i]; mx = fmaxf(mx, v[i]); }
        for (int o = 32; o > 0; o >>= 1) mx = fmaxf(mx, __shfl_xor(mx, o));
        float sm = 0.f;
        for (int i = 0; i < 4; ++i) { v[i] = __expf(v[i] - mx); sm += v[i]; }
        for (int o = 32; o > 0; o >>= 1) sm += __shfl_xor(sm, o);
        const float inv = 1.f / sm;
        for (int i = 0; i < 4; ++i) s_p[h * 256 + lane + 64 * i] = v[i] * inv;
    }
    __syncthreads();
    float ov[4]; float ss = 0.f;
    for (int i = 0; i < 4; ++i) {
        const int e = tid + 256 * i, h = e >> 7, d = e & 127;
        float a = 0.f;
        for (int j = 0; j < cnt; ++j) a += s_p[h * 256 + j] * bf2f(B0[(size_t)(b * S + s_sel[j]) * 1024 + 640 + d]);
        ov[i] = a; ss += a * a;
    }
    ss = block_sum(ss, s_red);
    const float rstd = rsqrtf(ss * (1.f / 1024.f) + EPS);
    for (int i = 0; i < 4; ++i) { const int e = tid + 256 * i; O[(size_t)m * D + e] = f2bf(ov[i] * rstd * gn_a[e]); }
}

__global__ void __launch_bounds__(256) k_sb(const bf16_t* __restrict__ QB, const bf16_t* __restrict__ KB, const bf16_t* __restrict__ VB, float* __restrict__ OBRAW) {
    __shared__ float s_q[128];
    __shared__ float s_lm[4096];
    __shared__ float s_a[4096];
    __shared__ float s_tot[256];
    __shared__ float s_o[128];
    const int tid = threadIdx.x;
    const int m = blockIdx.x >> 3, h = blockIdx.x & 7, b = m >> 12, t = m & 4095;
    if (tid < 128) s_q[tid] = bf2f(QB[(size_t)m * 1024 + h * 128 + tid]);
    __syncthreads();
    for (int s = tid; s < t; s += 256) {
        const bf16_t* kp = KB + (size_t)(b * S + s) * 1024 + h * 128;
        float z = 0.f;
        for (int d = 0; d < 128; ++d) z += s_q[d] * bf2f(kp[d]);
        const float sp = fmaxf(z, 0.f) + log1pf(__expf(-fabsf(z)));
        s_lm[s] = -sp;
        s_a[s] = z - sp;
    }
    __syncthreads();
    const int L = (t + 255) >> 8;
    const int lo = tid * L, hi = (lo + L < t) ? lo + L : t;
    float tot = 0.f;
    for (int s = lo; s < hi; ++s) tot += s_lm[s];
    s_tot[tid] = tot;
    __syncthreads();
    float run = 0.f;
    for (int c = tid + 1; c < 256; ++c) run += s_tot[c];
    for (int s = hi - 1; s >= lo; --s) { const float a = __expf(s_a[s] + run); run += s_lm[s]; s_a[s] = a; }
    __syncthreads();
    const int d = tid & 127, half = tid >> 7;
    const int mid = t >> 1;
    const int s0 = half ? mid : 0, s1 = half ? t : mid;
    float acc = 0.f;
    for (int s = s0; s < s1; ++s) acc += s_a[s] * bf2f(VB[(size_t)(b * S + s) * 1024 + h * 128 + d]);
    if (half) s_o[d] = acc;
    __syncthreads();
    if (!half) OBRAW[(size_t)m * 1024 + h * 128 + d] = acc + s_o[d];
}
__global__ void __launch_bounds__(256) k_gnb(const float* __restrict__ OBRAW, const float* __restrict__ gn_b, bf16_t* __restrict__ O) {
    __shared__ float sh[8];
    const int m = blockIdx.x;
    float v[4]; float ss = 0.f;
    for (int i = 0; i < 4; ++i) { v[i] = OBRAW[(size_t)m * 1024 + threadIdx.x + 256 * i]; ss += v[i] * v[i]; }
    ss = block_sum(ss, sh);
    const float rstd = rsqrtf(ss * (1.f / 1024.f) + EPS);
    for (int i = 0; i < 4; ++i) { const int e = threadIdx.x + 256 * i; O[(size_t)m * D + 1024 + e] = f2bf(v[i] * rstd * gn_b[e]); }
}

__global__ void __launch_bounds__(256) k_h2route(const float* __restrict__ x1, const float* __restrict__ g, const float* __restrict__ mod, const float* __restrict__ router_g, const float* __restrict__ router_e,
                                                 bf16_t* __restrict__ H2, int* __restrict__ EID, float* __restrict__ GW) {
    __shared__ float sh[8];
    __shared__ float s_h[D];
    __shared__ float s_lg[36];
    const int m = blockIdx.x, b = m >> 12, tid = threadIdx.x, lane = tid & 63, wv = tid >> 6;
    const float* xr = x1 + (size_t)m * D;
    float v[8]; float ss = 0.f;
    for (int i = 0; i < 8; ++i) { v[i] = xr[tid + 256 * i]; ss += v[i] * v[i]; }
    ss = block_sum(ss, sh);
    const float rstd = rsqrtf(ss * (1.f / D) + EPS);
    const float* mb = mod + (size_t)b * NMOD;
    for (int i = 0; i < 8; ++i) { const int k = tid + 256 * i; const float hv = v[i] * rstd * g[k] * (1.f + mb[4 * D + k]) + mb[3 * D + k]; s_h[k] = hv; H2[(size_t)m * D + k] = f2bf(hv); }
    __syncthreads();
    for (int o = wv * 9; o < wv * 9 + 9; ++o) {
        float a = 0.f;
        if (o < 4) { for (int k = lane; k < D; k += 64) a += s_h[k] * router_g[k * 4 + o]; }
        else { for (int k = lane; k < D; k += 64) a += s_h[k] * router_e[k * 32 + (o - 4)]; }
        for (int of = 32; of > 0; of >>= 1) a += __shfl_xor(a, of);
        if (lane == 0) s_lg[o] = a;
    }
    __syncthreads();
    if (tid == 0) {
        int gi = 0; float gm = s_lg[0];
        for (int i = 1; i < 4; ++i) if (s_lg[i] > gm) { gm = s_lg[i]; gi = i; }
        float gs = 0.f;
        for (int i = 0; i < 4; ++i) gs += __expf(s_lg[i] - gm);
        const float gw = 1.f / gs;
        const float* le = s_lg + 4 + gi * 8;
        float em = le[0];
        for (int i = 1; i < 8; ++i) em = fmaxf(em, le[i]);
        float es = 0.f;
        for (int i = 0; i < 8; ++i) es += __expf(le[i] - em);
        int i0 = 0; float p0 = -1.f;
        for (int i = 0; i < 8; ++i) { const float p = __expf(le[i] - em) / es; if (p > p0) { p0 = p; i0 = i; } }
        int i1 = 0; float p1 = -1.f;
        for (int i = 0; i < 8; ++i) { const float p = __expf(le[i] - em) / es; if (i != i0 && p > p1) { p1 = p; i1 = i; } }
        const float den = p0 + p1;
        EID[m * 2] = gi * 8 + i0; EID[m * 2 + 1] = gi * 8 + i1;
        GW[m * 2] = gw * p0 / den; GW[m * 2 + 1] = gw * p1 / den;
    }
}

__global__ void __launch_bounds__(512) k_moe(const bf16_t* __restrict__ H2, const int* __restrict__ EID, const float* __restrict__ GW, const float* __restrict__ w_gate, const float* __restrict__ w_up,
                                             const float* __restrict__ w_down, const float* __restrict__ mod, float* __restrict__ out) {
    __shared__ float s_h[D];
    __shared__ float s_u[512];
    const int m = blockIdx.x, b = m >> 12, tid = threadIdx.x;
    for (int i = tid; i < D; i += 512) s_h[i] = bf2f(H2[(size_t)m * D + i]);
    float yt[4] = {0.f, 0.f, 0.f, 0.f};
    for (int sl = 0; sl < 2; ++sl) {
        const int e = EID[m * 2 + sl]; const float gw = GW[m * 2 + sl];
        __syncthreads();
        const float* wg = w_gate + (size_t)e * D * 512 + tid; const float* wu = w_up + (size_t)e * D * 512 + tid;
        float ga = 0.f, ua = 0.f;
        for (int k = 0; k < D; ++k) { const float hv = s_h[k]; ga += hv * wg[(size_t)k * 512]; ua += hv * wu[(size_t)k * 512]; }
        s_u[tid] = silu_f(ga) * ua;
        __syncthreads();
        const float* wd = w_down + (size_t)e * 512 * D;
        for (int i = 0; i < 4; ++i) { const int n = tid + 512 * i; float y = 0.f; for (int j = 0; j < 512; ++j) y += s_u[j] * wd[(size_t)j * D + n]; yt[i] += gw * y; }
    }
    const float* mb = mod + (size_t)b * NMOD;
    for (int i = 0; i < 4; ++i) { const int n = tid + 512 * i; out[(size_t)m * D + n] += mb[5 * D + n] * yt[i]; }
}

extern "C" void kernel_launch(void* const* d_in, const int* in_sizes, int n_in, void* d_out, int out_size, void* d_ws, size_t ws_size, hipStream_t stream) {
    const float* x = (const float*)d_in[0]; const float* c = (const float*)d_in[1]; const float* w_mod = (const float*)d_in[2]; const float* b_mod = (const float*)d_in[3];
    const float* ln1_g = (const float*)d_in[4]; const float* w_in = (const float*)d_in[5]; const float* q_norm_g = (const float*)d_in[6]; const float* w_q_up = (const float*)d_in[7];
    const float* q_gain = (const float*)d_in[8]; const float* k_gain = (const float*)d_in[9]; const float* rel_bias = (const float*)d_in[10]; const float* gn_a = (const float*)d_in[11];
    const float* gn_b = (const float*)d_in[12]; const float* w_out = (const float*)d_in[13]; const float* ln2_g = (const float*)d_in[14]; const float* router_g = (const float*)d_in[15];
    const float* router_e = (const float*)d_in[16]; const float* w_gate = (const float*)d_in[17]; const float* w_up = (const float*)d_in[18]; const float* w_down = (const float*)d_in[19];
    float* out = (float*)d_out; unsigned char* ws = (unsigned char*)d_ws;
    if (ws_size < WS_END) return;
    float* mod = (float*)(ws + WS_MOD); float* RC = (float*)(ws + WS_RC); int* EID = (int*)(ws + WS_EID); float* GW = (float*)(ws + WS_GW);
    bf16_t* XN = (bf16_t*)(ws + WS_XN); bf16_t* B0 = (bf16_t*)(ws + WS_B0); bf16_t* QB = (bf16_t*)(ws + WS_QB); bf16_t* KB = (bf16_t*)(ws + WS_KB); bf16_t* VB = (bf16_t*)(ws + WS_VB);
    bf16_t* QA = (bf16_t*)(ws + WS_QA); bf16_t* QI = (bf16_t*)(ws + WS_QI); bf16_t* SEL = (bf16_t*)(ws + WS_SEL); bf16_t* O = (bf16_t*)(ws + WS_O); float* OBRAW = (float*)(ws + WS_OBRAW);
    bf16_t* H2 = XN;

    hipLaunchKernelGGL(k_mod, dim3(NMOD / 256), dim3(256), 0, stream, c, w_mod, b_mod, mod);
    hipLaunchKernelGGL(k_xn, dim3(M), dim3(256), 0, stream, x, ln1_g, mod, XN);
    hipLaunchKernelGGL(k_gemm<EpiIn>, dim3((DIN + 255) / 256, M / 8), dim3(256), 0, stream, XN, D, w_in, DIN, (const float*)nullptr, D, DIN, EpiIn{B0, QB, KB, VB});
    hipLaunchKernelGGL(k_cqk, dim3(M), dim3(64), 0, stream, B0, k_gain, RC);
    hipLaunchKernelGGL(k_gemm<EpiQup>, dim3(2048 / 256, M / 8), dim3(256), 0, stream, B0, 1024, w_q_up, 2048, q_norm_g, 512, 2048, EpiQup{RC, QA, QI});
    hipLaunchKernelGGL(k_dsa, dim3(M), dim3(256), 0, stream, B0, QI, QA, q_gain, rel_bias, gn_a, SEL, O);
    hipLaunchKernelGGL(k_sb, dim3(M * 8), dim3(256), 0, stream, QB, KB, VB, OBRAW);
    hipLaunchKernelGGL(k_gnb, dim3(M), dim3(256), 0, stream, OBRAW, gn_b, O);
    hipLaunchKernelGGL(k_gemm<EpiOut>, dim3(D / 256, M / 8), dim3(256), 0, stream, O, D, w_out, D, (const float*)nullptr, D, D, EpiOut{x, mod, out});
    hipLaunchKernelGGL(k_h2route, dim3(M), dim3(256), 0, stream, out, ln2_g, mod, router_g, router_e, H2, EID, GW);
    hipLaunchKernelGGL(k_moe, dim3(M), dim3(512), 0, stream, H2, EID, GW, w_gate, w_up, w_down, mod, out);
}
```

```cpp
#include <hip/hip_runtime.h>
#include <hip/hip_cooperative_groups.h>
#include <stdint.h>
#include <cstdio>
namespace cg = cooperative_groups;

typedef unsigned short bf16_t;
#define LAS __attribute__((address_space(3)))

constexpr int D = 2048, NB = 4, S = 4096, M = NB * S;
constexpr int NMOD = 6 * D;
constexpr int DIN = 3920;
constexpr float EPS = 1e-6f;
constexpr size_t MiB = 1ull << 20;
constexpr size_t WS_CTL = 0;
constexpr size_t WS_MOD = 1 * MiB;
constexpr size_t WS_RC = 2 * MiB;
constexpr size_t WS_EID = 3 * MiB;
constexpr size_t WS_GW = 4 * MiB;
constexpr size_t WS_SSQ = 5 * MiB;
constexpr size_t WS_XN = 8 * MiB;
constexpr size_t WS_B0 = 72 * MiB;
constexpr size_t WS_QB = 104 * MiB;
constexpr size_t WS_KB = 136 * MiB;
constexpr size_t WS_VB = 168 * MiB;
constexpr size_t WS_QA = 200 * MiB;
constexpr size_t WS_QI = 232 * MiB;
constexpr size_t WS_SEL = 264 * MiB;
constexpr size_t WS_O = 272 * MiB;
constexpr size_t WS_OBRAW = 336 * MiB;
constexpr size_t WS_MODP = 400 * MiB;
constexpr size_t WS_WTIN = 408 * MiB;
constexpr size_t WS_WTQUP = 424 * MiB;
constexpr size_t WS_WTOUT = 426 * MiB;
constexpr size_t WS_WTGU = 434 * MiB;
constexpr size_t WS_WTDN = 562 * MiB;
constexpr size_t WS_RT = 6 * MiB;
constexpr size_t WS_LIST = WS_B0;
constexpr size_t WS_U = WS_QA;
constexpr int CW_CNT = 8192;
constexpr size_t WS_END = 626 * MiB;

__device__ __forceinline__ float bf2f(bf16_t v) { return __uint_as_float(((unsigned)v) << 16); }
__device__ __forceinline__ bf16_t f2bf(float f) { unsigned u = __float_as_uint(f); u += 0x7fffu + ((u >> 16) & 1u); return (bf16_t)(u >> 16); }
__device__ __forceinline__ float silu_f(float v) { return v / (1.f + __expf(-v)); }
__device__ __forceinline__ unsigned fkey(float f) { const unsigned u = __float_as_uint(f); return (u & 0x80000000u) ? ~u : (u | 0x80000000u); }
__device__ __forceinline__ int t5_bucket(int dist) {
    if (dist < 16) return dist;
    int large = 16 + (int)(__logf((float)dist * (1.f / 16.f)) / 2.0794415416798357f * 16.f);
    return large < 31 ? large : 31;
}

namespace pg8 {
#define PG8_LAS __attribute__((address_space(3)))
typedef short bf16x8 __attribute__((ext_vector_type(8)));
typedef float f32x4 __attribute__((ext_vector_type(4)));
typedef unsigned u32x4 __attribute__((ext_vector_type(4)));
constexpr int BM = 256, BK = 64, HALF = 128, HTB = HALF * BK * 2, STAGE_BYTES = 8 * HTB, NXCD = 8, WGM = 8;
__host__ __device__ __forceinline__ int lds_byte(int r, int c) { const int st = (r >> 4) * 2 + (c >> 5), rr = r & 15, cc = c & 31, ob = rr * 64 + cc * 2; return st * 1024 + (ob ^ (((ob >> 9) & 1) << 5)); }
__host__ __device__ __forceinline__ void stage_rc(int b, int& R, int& C) { const int st = b / 1024, sb = b % 1024, swz = sb ^ (((sb >> 9) & 1) << 5); R = (st >> 1) * 16 + swz / 64; C = (st & 1) * 32 + (swz % 64) / 2; }
__host__ __device__ __forceinline__ int perm32(int rho) { const int n = rho >> 4, i = rho & 15; return 8 * (i >> 2) + 4 * n + (i & 3); }
__device__ __forceinline__ unsigned cvt_pk_bf16(float lo, float hi) { unsigned r; asm volatile("v_cvt_pk_bf16_f32 %0, %1, %2" : "=v"(r) : "v"(lo), "v"(hi)); return r; }

struct Unit { int pm, pn, aux; const char* a; const char* b; unsigned va[2][2]; };
struct Gemm { const bf16_t* A; const bf16_t* Bt; int M, N, K, lda, ldb; };

struct StaticOrder {
    int nM, nN, nwg, G, c; const char* A; const char* Bt; size_t tstepA, tstepB; unsigned vb[2][2];
    __device__ void init(const Gemm& g, int G_, int c_) { nM = g.M / BM; nN = g.N / BM; nwg = nM * nN; G = G_; c = c_; A = (const char*)g.A; Bt = (const char*)g.Bt; tstepA = (size_t)BM * g.lda * 2; tstepB = (size_t)BM * g.ldb * 2;
#pragma unroll
        for (int i = 0; i < 2; ++i) { int R, C; stage_rc((int)threadIdx.x * 16 + i * 8192, R, C); vb[0][i] = (unsigned)(R * g.lda + C) * 2u; vb[1][i] = (unsigned)((HALF + R) * g.lda + C) * 2u; } }
    __device__ bool next(int i, Unit& u) const {
        const long L = (long)i * G + c; if (L >= nwg) return false;
        int wgid = (int)L; { const int q = nwg / NXCD, r = nwg % NXCD, xcd = wgid % NXCD, off = wgid / NXCD; wgid = (xcd < r ? xcd * (q + 1) : r * (q + 1) + (xcd - r) * q) + off; }
        const int nig = WGM * nN, gid = wgid / nig, fm = gid * WGM, gsz = (nM - fm) < WGM ? (nM - fm) : WGM;
        u.pm = fm + ((wgid % nig) % gsz); u.pn = (wgid % nig) / gsz;
        u.a = A + (size_t)u.pm * tstepA; u.b = Bt + (size_t)u.pn * tstepB; u.aux = 0; u.va[0][0] = vb[0][0]; u.va[0][1] = vb[0][1]; u.va[1][0] = vb[1][0]; u.va[1][1] = vb[1][1]; return true;
    }
};

template <class Epi, class Sched>
__device__ __forceinline__ void gemm_phase(PG8_LAS unsigned char* lds, const Gemm g, const Sched& S, const Epi& E) {
    const int tid = threadIdx.x, wid = __builtin_amdgcn_readfirstlane(tid >> 6), lane = tid & 63, wr = wid >> 2, wc = wid & 3, fr = lane & 15, fq = lane >> 4;
    const int K = g.K, nt = K / BK;
    unsigned voffB[2];
#pragma unroll
    for (int i = 0; i < 2; ++i) { int R, C; stage_rc(tid * 16 + i * 8192, R, C); const int Rb = Epi::PERM ? ((R & ~31) + perm32(R & 31)) : R;
        voffB[i] = (unsigned)(Rb * g.ldb + C) * 2u; }
    const size_t kstep = (size_t)(BK * 2);
    const size_t hstepB = (size_t)HALF * g.ldb * 2;
    const unsigned ldsw = (unsigned)wid * 1024u;
    const int aoff = lds_byte(wr * 64 + fr, fq * 8), boff = lds_byte(wc * 32 + fr, fq * 8);
#define PG8_SA(b, h) (((b) * 2 + (h)) * HTB)
#define PG8_SB(b, h) ((4 + (b) * 2 + (h)) * HTB)
#define PG8_STAGE(bufoff, gbase, voff) do { _Pragma("unroll") for (int _i = 0; _i < 2; ++_i) \
        __builtin_amdgcn_global_load_lds((const unsigned*)((const char*)(gbase) + (voff)[_i]), (PG8_LAS unsigned*)(lds + (bufoff) + ldsw + _i * 8192), 16, 0, 0); } while (0)
#define PG8_LDA(dst, b, h) do { _Pragma("unroll") for (int m = 0; m < 4; ++m) _Pragma("unroll") for (int k = 0; k < 2; ++k) dst[m][k] = *(const PG8_LAS bf16x8*)(lds + PG8_SA(b, h) + aoff + m * 2048 + k * 1024); } while (0)
#define PG8_LDB(dst, b, h) do { _Pragma("unroll") for (int n = 0; n < 2; ++n) _Pragma("unroll") for (int k = 0; k < 2; ++k) dst[n][k] = *(const PG8_LAS bf16x8*)(lds + PG8_SB(b, h) + boff + n * 2048 + k * 1024); } while (0)
#define PG8_MMA(ai, bj, At, Bt) do { __builtin_amdgcn_s_setprio(1); _Pragma("unroll") for (int m = 0; m < 4; ++m) _Pragma("unroll") for (int n = 0; n < 2; ++n) _Pragma("unroll") for (int k = 0; k < 2; ++k) \
        acc[ai][bj][m][n] = __builtin_amdgcn_mfma_f32_16x16x32_bf16(Bt[n][k], At[m][k], acc[ai][bj][m][n], 0, 0, 0); __builtin_amdgcn_s_setprio(0); } while (0)
#define PG8_WAIT_V(n) asm volatile("s_waitcnt vmcnt(" #n ")" ::: "memory")
#define PG8_WAIT_L(n) asm volatile("s_waitcnt lgkmcnt(" #n ")" ::: "memory")
#define PG8_BAR __builtin_amdgcn_s_barrier()
#define PG8_SCHED __builtin_amdgcn_sched_barrier(0)
    Unit cur, nxt; int ui = 0;
    if (!S.next(0, cur)) return;
    f32x4 acc[2][2][4][2];
#pragma unroll
    for (int a = 0; a < 2; ++a)
#pragma unroll
        for (int b = 0; b < 2; ++b)
#pragma unroll
            for (int m = 0; m < 4; ++m)
#pragma unroll
                for (int n = 0; n < 2; ++n) acc[a][b][m][n] = (f32x4){0.f, 0.f, 0.f, 0.f};
    bf16x8 At[4][2], B0[2][2], B1[2][2];
    const char* cA = cur.a; const char* cB = cur.b;
    PG8_STAGE(PG8_SB(0, 0), cB, voffB); PG8_STAGE(PG8_SB(0, 1), cB + hstepB, voffB); PG8_STAGE(PG8_SA(0, 0), cA, cur.va[0]); PG8_STAGE(PG8_SA(0, 1), cA, cur.va[1]);
    if (wr == 1) PG8_BAR;
    PG8_WAIT_V(2); PG8_BAR;
    PG8_STAGE(PG8_SB(1, 0), cB + kstep, voffB); PG8_STAGE(PG8_SA(1, 0), cA + kstep, cur.va[0]); PG8_STAGE(PG8_SB(1, 1), cB + hstepB + kstep, voffB);
    PG8_WAIT_V(6); PG8_BAR;
    for (;;) {
        const bool has_next = S.next(ui + 1, nxt);
        if (!has_next) nxt = cur;
        const char* nA = has_next ? nxt.a : cA; const char* nB = has_next ? nxt.b : cB;
        for (int t = 0; t < nt; t += 2) {
            const bool last = (t == nt - 2);
            const char* a1 = cA + (size_t)(t + 1) * kstep;
            const char* a2 = last ? nA : cA + (size_t)(t + 2) * kstep; const char* b2 = last ? nB : cB + (size_t)(t + 2) * kstep;
            const char* a3 = a2 + kstep; const char* b3 = b2 + kstep;
            unsigned vn0[2], vn1[2];
            vn0[0] = last ? nxt.va[0][0] : cur.va[0][0]; vn0[1] = last ? nxt.va[0][1] : cur.va[0][1]; vn1[0] = last ? nxt.va[1][0] : cur.va[1][0]; vn1[1] = last ? nxt.va[1][1] : cur.va[1][1];
            PG8_LDB(B0, 0, 0); PG8_LDB(B1, 0, 1); PG8_SCHED; PG8_LDA(At, 0, 0); PG8_STAGE(PG8_SA(1, 1), a1, cur.va[1]);
            PG8_WAIT_V(8); PG8_WAIT_L(0); PG8_BAR; PG8_MMA(0, 0, At, B0); PG8_MMA(0, 1, At, B1); PG8_BAR; PG8_SCHED;
            PG8_LDA(At, 0, 1); PG8_STAGE(PG8_SB(0, 0), b2, voffB); PG8_STAGE(PG8_SB(0, 1), b2 + hstepB, voffB); PG8_STAGE(PG8_SA(0, 0), a2, vn0);
            PG8_WAIT_V(8); PG8_WAIT_L(0); PG8_BAR; PG8_MMA(1, 0, At, B0); PG8_MMA(1, 1, At, B1); PG8_BAR; PG8_SCHED;
            PG8_LDB(B0, 1, 0); PG8_LDB(B1, 1, 1); PG8_SCHED; PG8_LDA(At, 1, 0); PG8_STAGE(PG8_SA(0, 1), a2, vn1);
            PG8_WAIT_V(8); PG8_WAIT_L(0); PG8_BAR; PG8_MMA(0, 0, At, B0); PG8_MMA(0, 1, At, B1); PG8_BAR; PG8_SCHED;
            PG8_LDA(At, 1, 1); PG8_STAGE(PG8_SB(1, 0), b3, voffB); PG8_STAGE(PG8_SB(1, 1), b3 + hstepB, voffB); PG8_STAGE(PG8_SA(1, 0), a3, vn0);
            PG8_WAIT_V(8); PG8_WAIT_L(0); PG8_BAR; PG8_MMA(1, 0, At, B0); PG8_MMA(1, 1, At, B1); PG8_BAR; PG8_SCHED;
        }
        if (wr == 0) PG8_BAR;
        E(acc, cur, wr, wc, fr, fq);
        if (!has_next) break;
#pragma unroll
        for (int a = 0; a < 2; ++a)
#pragma unroll
            for (int b = 0; b < 2; ++b)
#pragma unroll
                for (int m = 0; m < 4; ++m)
#pragma unroll
                    for (int n = 0; n < 2; ++n) acc[a][b][m][n] = (f32x4){0.f, 0.f, 0.f, 0.f};
        cur = nxt; cA = nA; cB = nB; ++ui;
        if (wr == 1) PG8_BAR;
    }
    PG8_WAIT_V(0);
    PG8_BAR;
#undef PG8_SA
#undef PG8_SB
#undef PG8_STAGE
#undef PG8_LDA
#undef PG8_LDB
#undef PG8_MMA
#undef PG8_WAIT_V
#undef PG8_WAIT_L
#undef PG8_BAR
#undef PG8_SCHED
}
}

#define XB_TMO      128
#define XB_XCNT(j)  (256  + 64 * (j))
#define XB_XSUB(j)  (1280 + 64 * (j))
#define XB_XGEN(j)  (2304 + 64 * (j))
#define XB_TOP      3328
#define XB_TOPGEN   3392
#define XCD_BAR_WORDS 3456
#define XB_SPIN_CAP (1u << 18)
__device__ __forceinline__ unsigned xb_ld(unsigned* p)              { return __hip_atomic_load(p, __ATOMIC_RELAXED, __HIP_MEMORY_SCOPE_AGENT); }
__device__ __forceinline__ unsigned xb_add(unsigned* p, unsigned v) { return __hip_atomic_fetch_add(p, v, __ATOMIC_RELAXED, __HIP_MEMORY_SCOPE_AGENT); }
__device__ __forceinline__ unsigned xb_xcc_id() { return (unsigned)__builtin_amdgcn_s_getreg((3 << 11) | 20) & 0xFu; }
#define XB_SPIN(cond, bar) do { unsigned _sp = 0; while (cond) { __builtin_amdgcn_s_sleep(1); \
    if ((++_sp & 255u) == 0u) { if (xb_ld(&(bar)[XB_TMO])) break; if (_sp > XB_SPIN_CAP) { atomicAdd(&(bar)[XB_TMO], 1u); break; } } } } while (0)
struct XcdBarrier { unsigned* bar; unsigned x; volatile LAS unsigned* st; };
__device__ __forceinline__ XcdBarrier xcd_barrier_post(unsigned* bar, volatile LAS unsigned* st) {
    XcdBarrier b; b.bar = bar; b.x = xb_xcc_id(); b.st = st;
    if (threadIdx.x == 0) (void)xb_add(&bar[XB_XCNT(b.x)], 1u);
    return b;
}
__device__ __forceinline__ void xcd_barrier_complete(unsigned* bar, unsigned x, unsigned& nloc, unsigned& nx) {
    const unsigned G = gridDim.x * gridDim.y * gridDim.z;
    unsigned sum, cnt, mine, sp = 0u;
    for (;;) {
        sum = 0u; cnt = 0u; mine = 0u;
#pragma unroll
        for (unsigned j = 0; j < 16; ++j) { const unsigned c = xb_ld(&bar[XB_XCNT(j)]); sum += c; cnt += (c > 0u) ? 1u : 0u; mine = (j == x) ? c : mine; }
        if (sum == G) break;
        __builtin_amdgcn_s_sleep(1);
        if ((++sp & 255u) == 0u) { if (xb_ld(&bar[XB_TMO])) break; if (sp > XB_SPIN_CAP) { atomicAdd(&bar[XB_TMO], 1u); break; } }
    }
    nloc = mine > 0u ? mine : 1u; nx = cnt > 0u ? cnt : 1u;
}
__device__ __forceinline__ void xcd_barrier(const XcdBarrier& b) {
    asm volatile("s_waitcnt vmcnt(0)" ::: "memory");
    __syncthreads();
    if (threadIdx.x == 0) {
        unsigned* bar = b.bar;
        __builtin_amdgcn_s_waitcnt(0);
        unsigned nloc = b.st[0], nx = b.st[1];
        if (nloc == 0u) { xcd_barrier_complete(bar, b.x, nloc, nx); b.st[0] = nloc; b.st[1] = nx; }
        const unsigned old = xb_add(&bar[XB_XSUB(b.x)], 1u);
        const unsigned gen = old / nloc;
        if (old + 1u == (gen + 1u) * nloc) {
            __builtin_amdgcn_fence(__ATOMIC_RELEASE, "agent");
            asm volatile("s_waitcnt vmcnt(0)" ::: "memory");
            const unsigned og = xb_add(&bar[XB_TOP], 1u);
            const unsigned tg = og / nx;
            if (og + 1u == (tg + 1u) * nx) xb_add(&bar[XB_TOPGEN], 1u);
            else XB_SPIN(xb_ld(&bar[XB_TOPGEN]) == tg, bar);
            __builtin_amdgcn_fence(__ATOMIC_ACQUIRE, "agent");
            xb_add(&bar[XB_XGEN(b.x)], 1u);
            asm volatile("s_waitcnt vmcnt(0)" ::: "memory");
        } else {
            XB_SPIN(xb_ld(&bar[XB_XGEN(b.x)]) == gen, bar);
            __builtin_amdgcn_fence(__ATOMIC_ACQUIRE, "agent");
            asm volatile("s_waitcnt vmcnt(0)" ::: "memory");
        }
    }
    __syncthreads();
}

constexpr int MK_THREADS = 512, MK_LDS = 147456, MK_MISC_OFF = 135168, MK_MOE_OFF = 135168 + 256;
struct MkArgs { const float* in[20]; float* out; unsigned char* ws; int ph_lo, ph_hi; };
typedef float f32x4 __attribute__((ext_vector_type(4)));
typedef unsigned u32x4 __attribute__((ext_vector_type(4)));
typedef unsigned u32x2 __attribute__((ext_vector_type(2)));
#define LDS_WAIT() asm volatile("s_waitcnt lgkmcnt(0)" ::: "memory")
__device__ __forceinline__ unsigned pk2(float lo, float hi) { return (unsigned)f2bf(lo) | ((unsigned)f2bf(hi) << 16); }
__device__ __forceinline__ float wave_sum(float v) {
#pragma unroll
    for (int o = 1; o < 64; o <<= 1) v += __shfl_xor(v, o);
    return v;
}

template <class RowMap>
__device__ __forceinline__ void tr_item(const float* __restrict__ W, int K, int N, bf16_t* __restrict__ WT, LAS float* scr, int item, int lane, const float* __restrict__ kscale, RowMap rm) {
    const int nblk = (N + 31) / 32, kb = item / nblk, nb = item % nblk, k0 = 64 * kb, n0 = 32 * nb;
    const int nn = n0 + (lane & 31);
#pragma unroll 8
    for (int i = 0; i < 32; ++i) { const int kk = 2 * i + (lane >> 5); float v = nn < N ? W[(size_t)(k0 + kk) * N + nn] : 0.f; if (kscale) v *= kscale[k0 + kk]; scr[kk * 33 + (lane & 31)] = v; }
    LDS_WAIT(); asm volatile("" ::: "memory");
    const int c = lane & 7;
#pragma unroll
    for (int j = 0; j < 4; ++j) { const int nl = (lane >> 3) + 8 * j; const int n = n0 + nl;
        if (n < N) { float sc = 1.f; const int r = rm(n, sc); const LAS float* s = scr + (8 * c) * 33 + nl;
            u32x4 o; o.x = pk2(s[0 * 33] * sc, s[1 * 33] * sc); o.y = pk2(s[2 * 33] * sc, s[3 * 33] * sc); o.z = pk2(s[4 * 33] * sc, s[5 * 33] * sc); o.w = pk2(s[6 * 33] * sc, s[7 * 33] * sc);
            *(u32x4*)(WT + (size_t)r * K + k0 + 8 * c) = o; } }
    LDS_WAIT(); asm volatile("" ::: "memory");
}

__device__ __forceinline__ void p0_prep(const MkArgs& a, LAS unsigned char* lds) {
    const int tid = threadIdx.x, lane = tid & 63, wave = __builtin_amdgcn_readfirstlane(tid >> 6);
    const float* c = a.in[1]; const float* w_mod = a.in[2];
    float* MODP = (float*)(a.ws + WS_MODP);
    LAS float* s_c = (LAS float*)lds;
    for (int item = blockIdx.x; item < 256; item += gridDim.x) {
        const int kc = item >> 3, cc = item & 7;
        __syncthreads();
        if (tid < 256) { const int b = tid >> 6, k = tid & 63; s_c[tid] = silu_f(c[b * D + kc * 64 + k]); }
        __syncthreads();
        float acc[4][3];
#pragma unroll
        for (int b = 0; b < 4; ++b)
#pragma unroll
            for (int j = 0; j < 3; ++j) acc[b][j] = 0.f;
        const int col0 = cc * 1536 + tid;
        for (int k = 0; k < 64; ++k) {
            const float* wr = w_mod + (size_t)(kc * 64 + k) * NMOD + col0;
            const float w0 = wr[0], w1 = wr[512], w2 = wr[1024];
#pragma unroll
            for (int b = 0; b < 4; ++b) { const float sv = s_c[b * 64 + k]; acc[b][0] += sv * w0; acc[b][1] += sv * w1; acc[b][2] += sv * w2; }
        }
#pragma unroll
        for (int b = 0; b < 4; ++b)
#pragma unroll
            for (int j = 0; j < 3; ++j) MODP[(size_t)(kc * 4 + b) * NMOD + col0 + 512 * j] = acc[b][j];
    }
    __syncthreads();
    LAS float* scr = (LAS float*)(lds + wave * 16384);
    const int gw = blockIdx.x * 8 + wave, NGW = gridDim.x * 8;
    constexpr int I_IN = 32 * 123, I_QUP = 8 * 64, I_OUT = 32 * 64;
    bf16_t* Wt_in = (bf16_t*)(a.ws + WS_WTIN); bf16_t* Wt_qup = (bf16_t*)(a.ws + WS_WTQUP); bf16_t* Wt_out = (bf16_t*)(a.ws + WS_WTOUT);
    for (int it = gw; it < I_IN + I_QUP + I_OUT; it += NGW) {
        int r = it;
        if (r < I_IN) { tr_item(a.in[5], D, DIN, Wt_in, scr, r, lane, (const float*)nullptr, [](int n, float& sc) { if (n >= 832 && n < 848) sc = 0.25f; else if (n >= 848 && n < 1872) sc = 0.08838834764831845f; return n < 848 ? n : n + 176; }); continue; }
        r -= I_IN;
        if (r < I_QUP) { tr_item(a.in[7], 512, 2048, Wt_qup, scr, r, lane, a.in[6], [](int n, float& sc) { if (n >= 1024) sc = 0.125f; return n; }); continue; }
        r -= I_QUP;
        tr_item(a.in[13], D, D, Wt_out, scr, r, lane, (const float*)nullptr, [](int n, float& sc) { return n; });
    }
    {
        bf16_t* Wt_gu = (bf16_t*)(a.ws + WS_WTGU); bf16_t* Wt_dn = (bf16_t*)(a.ws + WS_WTDN);
        for (int it = gw; it < 32 * 1536; it += NGW) {
            const int e = it / 1536; int r = it % 1536;
            if (r < 512) { tr_item(a.in[17] + (size_t)e * D * 512, D, 512, Wt_gu + (size_t)e * 1024 * D, scr, r, lane, (const float*)nullptr, [](int n, float& sc) { return 8 * (n >> 2) + (n & 3); }); continue; }
            r -= 512;
            if (r < 512) { tr_item(a.in[18] + (size_t)e * D * 512, D, 512, Wt_gu + (size_t)e * 1024 * D, scr, r, lane, (const float*)nullptr, [](int n, float& sc) { return 8 * (n >> 2) + 4 + (n & 3); }); continue; }
            r -= 512;
            tr_item(a.in[19] + (size_t)e * 512 * D, 512, D, Wt_dn + (size_t)e * D * 512, scr, r, lane, (const float*)nullptr, [](int n, float& sc) { return n; });
        }
        bf16_t* RT = (bf16_t*)(a.ws + WS_RT); const float* rg = a.in[15]; const float* re = a.in[16];
        for (int i = blockIdx.x * MK_THREADS + tid; i < 48 * D; i += gridDim.x * MK_THREADS) { const int o = i >> 11, k = i & 2047; RT[i] = f2bf(o < 4 ? rg[k * 4 + o] : (o < 36 ? re[k * 32 + (o - 4)] : 0.f)); }
    }
    u32x4* z = (u32x4*)(Wt_in + (size_t)848 * D);
    for (int i = blockIdx.x * MK_THREADS + tid; i < 176 * 256; i += gridDim.x * MK_THREADS) z[i] = (u32x4){0u, 0u, 0u, 0u};
}

__device__ __forceinline__ void p1_xn(const MkArgs& a, LAS unsigned char* lds) {
    const int tid = threadIdx.x, lane = tid & 63, wave = __builtin_amdgcn_readfirstlane(tid >> 6);
    const float* x = a.in[0]; const float* b_mod = a.in[3]; const float* ln1_g = a.in[4];
    const float* MODP = (const float*)(a.ws + WS_MODP); float* MOD = (float*)(a.ws + WS_MOD); bf16_t* XN = (bf16_t*)(a.ws + WS_XN);
    LAS float* s_gs = (LAS float*)lds; LAS float* s_sh = s_gs + D;
    for (int i = blockIdx.x * MK_THREADS + tid; i < NB * NMOD; i += gridDim.x * MK_THREADS) {
        const int b = i / NMOD, n = i % NMOD; float s = b_mod[n];
        for (int kc = 0; kc < 32; ++kc) s += MODP[(size_t)(kc * 4 + b) * NMOD + n];
        MOD[i] = s;
    }
    for (int chunk = blockIdx.x; chunk < M / 64; chunk += gridDim.x) {
        const int b = chunk >> 6;
        __syncthreads();
        for (int k = tid; k < D; k += MK_THREADS) {
            float sh = b_mod[k], sc = b_mod[D + k];
            for (int kc = 0; kc < 32; ++kc) { sh += MODP[(size_t)(kc * 4 + b) * NMOD + k]; sc += MODP[(size_t)(kc * 4 + b) * NMOD + D + k]; }
            s_sh[k] = sh; s_gs[k] = ln1_g[k] * (1.f + sc);
        }
        __syncthreads();
        for (int r = wave; r < 64; r += 8) {
            const int m = chunk * 64 + r;
            const f32x4* xr = (const f32x4*)(x + (size_t)m * D) + lane;
            f32x4 v[8]; float ss = 0.f;
#pragma unroll
            for (int j = 0; j < 8; ++j) { v[j] = xr[64 * j]; ss += (v[j].x * v[j].x + v[j].y * v[j].y) + (v[j].z * v[j].z + v[j].w * v[j].w); }
            const float rstd = rsqrtf(wave_sum(ss) * (1.f / D) + EPS);
            u32x2* o8 = (u32x2*)(XN + (size_t)m * D) + lane;
#pragma unroll
            for (int j = 0; j < 8; ++j) { const int k = 4 * (lane + 64 * j); const f32x4 gs = *(const LAS f32x4*)(s_gs + k), sh = *(const LAS f32x4*)(s_sh + k);
                const f32x4 y = v[j] * rstd * gs + sh; u32x2 w; w.x = pk2(y.x, y.y); w.y = pk2(y.z, y.w); o8[64 * j] = w; }
        }
    }
}

struct EpiInProj {
    static constexpr bool PERM = true;
    bf16_t* B0; bf16_t* QB; bf16_t* KB; bf16_t* VB; float* SSQ;
    __device__ __forceinline__ void operator()(const pg8::f32x4 (&acc)[2][2][4][2], const pg8::Unit& u, int wr, int wc, int fr, int fq) const {
        const int t = u.pn >> 2; bf16_t* base = t == 0 ? B0 : (t == 1 ? QB : (t == 2 ? KB : VB));
        const int row0 = u.pm * 256 + wr * 64 + fr, col0 = (u.pn & 3) * 256 + wc * 32 + 8 * fq;
#pragma unroll
        for (int ai = 0; ai < 2; ++ai)
#pragma unroll
            for (int m = 0; m < 4; ++m) { const int row = row0 + ai * 128 + m * 16; bf16_t* rowp = base + (size_t)row * 1024 + col0; float ss = 0.f;
#pragma unroll
                for (int bj = 0; bj < 2; ++bj) { const pg8::f32x4 v0 = acc[ai][bj][m][0], v1 = acc[ai][bj][m][1];
                    ss += (v0[0] * v0[0] + v0[1] * v0[1]) + (v0[2] * v0[2] + v0[3] * v0[3]) + (v1[0] * v1[0] + v1[1] * v1[1]) + (v1[2] * v1[2] + v1[3] * v1[3]);
                    pg8::u32x4 w; w.x = pg8::cvt_pk_bf16(v0[0], v0[1]); w.y = pg8::cvt_pk_bf16(v0[2], v0[3]); w.z = pg8::cvt_pk_bf16(v1[0], v1[1]); w.w = pg8::cvt_pk_bf16(v1[2], v1[3]);
                    *(pg8::u32x4*)(rowp + bj * 128) = w; }
                if (u.pn < 2) { ss += __shfl_xor(ss, 16); ss += __shfl_xor(ss, 32); if (fq == 0) SSQ[(size_t)row * 8 + u.pn * 4 + wc] = ss; } }
    }
};


struct EpiQupG {
    static constexpr bool PERM = true;
    const float* SSQ; bf16_t* QA; bf16_t* QI;
    __device__ __forceinline__ void operator()(const pg8::f32x4 (&acc)[2][2][4][2], const pg8::Unit& u, int wr, int wc, int fr, int fq) const {
        bf16_t* base = (u.pn >> 2) ? QI : QA;
        const int row0 = u.pm * 256 + wr * 64 + fr, col0 = (u.pn & 3) * 256 + wc * 32 + 8 * fq;
#pragma unroll
        for (int ai = 0; ai < 2; ++ai)
#pragma unroll
            for (int m = 0; m < 4; ++m) { const int row = row0 + ai * 128 + m * 16; bf16_t* rowp = base + (size_t)row * 1024 + col0;
                const pg8::f32x4 s0 = *(const pg8::f32x4*)(SSQ + (size_t)row * 8), s1 = *(const pg8::f32x4*)(SSQ + (size_t)row * 8 + 4);
                const float rs = rsqrtf(((s0[0] + s0[1]) + (s0[2] + s0[3]) + (s1[0] + s1[1]) + (s1[2] + s1[3])) * (1.f / 512.f) + EPS);
#pragma unroll
                for (int bj = 0; bj < 2; ++bj) { const pg8::f32x4 v0 = acc[ai][bj][m][0] * rs, v1 = acc[ai][bj][m][1] * rs;
                    pg8::u32x4 w; w.x = pg8::cvt_pk_bf16(v0[0], v0[1]); w.y = pg8::cvt_pk_bf16(v0[2], v0[3]); w.z = pg8::cvt_pk_bf16(v1[0], v1[1]); w.w = pg8::cvt_pk_bf16(v1[2], v1[3]);
                    *(pg8::u32x4*)(rowp + bj * 128) = w; } }
    }
};
struct EpiOutProj {
    static constexpr bool PERM = true;
    const float* x; const float* MOD; float* out;
    __device__ __forceinline__ void operator()(const pg8::f32x4 (&acc)[2][2][4][2], const pg8::Unit& u, int wr, int wc, int fr, int fq) const {
        const int b = (u.pm * 256) >> 12;
        const int row0 = u.pm * 256 + wr * 64 + fr, col0 = u.pn * 256 + wc * 32 + 8 * fq;
        const float* gp = MOD + (size_t)b * NMOD + 2 * D + col0;
        pg8::f32x4 g[2][2];
#pragma unroll
        for (int bj = 0; bj < 2; ++bj) { g[bj][0] = *(const pg8::f32x4*)(gp + bj * 128); g[bj][1] = *(const pg8::f32x4*)(gp + bj * 128 + 4); }
#pragma unroll
        for (int ai = 0; ai < 2; ++ai)
#pragma unroll
            for (int m = 0; m < 4; ++m) { const size_t off = (size_t)(row0 + ai * 128 + m * 16) * D + col0;
#pragma unroll
                for (int bj = 0; bj < 2; ++bj) { const pg8::f32x4 x0 = *(const pg8::f32x4*)(x + off + bj * 128), x1 = *(const pg8::f32x4*)(x + off + bj * 128 + 4);
                    *(pg8::f32x4*)(out + off + bj * 128) = x0 + g[bj][0] * acc[ai][bj][m][0]; *(pg8::f32x4*)(out + off + bj * 128 + 4) = x1 + g[bj][1] * acc[ai][bj][m][1]; } }
    }
};
__device__ __forceinline__ void kanorm_pass(const MkArgs& a) {
    const int tid = threadIdx.x, lane = tid & 63, wave = __builtin_amdgcn_readfirstlane(tid >> 6);
    bf16_t* B0 = (bf16_t*)(a.ws + WS_B0); const float* k_gain = a.in[9];
    const float g0 = k_gain[2 * lane], g1 = k_gain[2 * lane + 1];
    for (int m = blockIdx.x * 8 + wave; m < M; m += gridDim.x * 8) {
        unsigned* p = (unsigned*)(B0 + (size_t)m * 1024 + 512) + lane;
        const unsigned v = *p; const float k0 = __uint_as_float(v << 16), k1 = __uint_as_float(v & 0xffff0000u);
        const float rs = rsqrtf(wave_sum(k0 * k0 + k1 * k1) * (1.f / 128.f) + EPS);
        *p = pk2(k0 * rs * g0, k1 * rs * g1);
    }
}

typedef short bf16x8_t __attribute__((ext_vector_type(8)));
__device__ __forceinline__ void p8_route(const MkArgs& a, LAS unsigned char* lds) {
    const int tid = threadIdx.x, lane = tid & 63, wave = __builtin_amdgcn_readfirstlane(tid >> 6);
    const float* x1 = a.out; const float* ln2_g = a.in[14]; const float* MOD = (const float*)(a.ws + WS_MOD);
    bf16_t* H2 = (bf16_t*)(a.ws + WS_XN); const bf16_t* RT = (const bf16_t*)(a.ws + WS_RT);
    int* EID = (int*)(a.ws + WS_EID); float* GW = (float*)(a.ws + WS_GW);
    unsigned* cnt = (unsigned*)(a.ws + WS_CTL) + CW_CNT; int* list = (int*)(a.ws + WS_LIST);
    constexpr int RS = 4112;
    LAS float* s_part = (LAS float*)lds;
    LAS float* s_lg = (LAS float*)(lds + 49152);
    for (int item = blockIdx.x; item < M / 32; item += gridDim.x) {
        const int m0 = item * 32, b = m0 >> 12;
        const float* mb = MOD + (size_t)b * NMOD;
        __syncthreads();
        for (int rr = 0; rr < 4; ++rr) {
            const int r = wave * 4 + rr, m = m0 + r;
            const f32x4* xr = (const f32x4*)(x1 + (size_t)m * D) + lane;
            f32x4 v[8]; float ss = 0.f;
#pragma unroll
            for (int j = 0; j < 8; ++j) { v[j] = xr[64 * j]; ss += (v[j].x * v[j].x + v[j].y * v[j].y) + (v[j].z * v[j].z + v[j].w * v[j].w); }
            const float rstd = rsqrtf(wave_sum(ss) * (1.f / D) + EPS);
            u32x2* o8 = (u32x2*)(H2 + (size_t)m * D) + lane;
#pragma unroll
            for (int j = 0; j < 8; ++j) { const int k = 4 * (lane + 64 * j);
                const f32x4 g = *(const f32x4*)(ln2_g + k), sc = *(const f32x4*)(mb + 4 * D + k), sh = *(const f32x4*)(mb + 3 * D + k);
                const f32x4 y = v[j] * rstd * g * (sc + 1.f) + sh; u32x2 w; w.x = pk2(y.x, y.y); w.y = pk2(y.z, y.w); o8[64 * j] = w;
                *(LAS u32x2*)(lds + r * RS + k * 2) = w; }
        }
        __syncthreads();
        f32x4 acc[2][3];
#pragma unroll
        for (int rt = 0; rt < 2; ++rt)
#pragma unroll
            for (int ct = 0; ct < 3; ++ct) acc[rt][ct] = (f32x4){0.f, 0.f, 0.f, 0.f};
        const int fr = lane & 15, fq = lane >> 4;
#pragma unroll 2
        for (int kk = 0; kk < 8; ++kk) {
            const int k0 = 32 * (wave * 8 + kk) + 8 * fq;
            bf16x8_t af[2], bfr[3];
#pragma unroll
            for (int rt = 0; rt < 2; ++rt) af[rt] = *(const LAS bf16x8_t*)(lds + (16 * rt + fr) * RS + k0 * 2);
#pragma unroll
            for (int ct = 0; ct < 3; ++ct) bfr[ct] = *(const bf16x8_t*)(RT + (size_t)(16 * ct + fr) * D + k0);
#pragma unroll
            for (int rt = 0; rt < 2; ++rt)
#pragma unroll
                for (int ct = 0; ct < 3; ++ct) acc[rt][ct] = __builtin_amdgcn_mfma_f32_16x16x32_bf16(af[rt], bfr[ct], acc[rt][ct], 0, 0, 0);
        }
        __syncthreads();
#pragma unroll
        for (int rt = 0; rt < 2; ++rt)
#pragma unroll
            for (int ct = 0; ct < 3; ++ct)
#pragma unroll
                for (int i = 0; i < 4; ++i) s_part[(wave * 32 + 16 * rt + 4 * fq + i) * 48 + 16 * ct + fr] = acc[rt][ct][i];
        __syncthreads();
        for (int i = tid; i < 32 * 36; i += MK_THREADS) { const int r = i / 36, o = i % 36; float s = 0.f;
#pragma unroll
            for (int w = 0; w < 8; ++w) s += s_part[(w * 32 + r) * 48 + o];
            s_lg[i] = s; }
        __syncthreads();
        if (tid < 32) {
            const LAS float* lg = s_lg + tid * 36; const int m = m0 + tid;
            int gi = 0; float gm = lg[0];
            for (int i = 1; i < 4; ++i) if (lg[i] > gm) { gm = lg[i]; gi = i; }
            float gs = 0.f;
            for (int i = 0; i < 4; ++i) gs += __expf(lg[i] - gm);
            const float gw = 1.f / gs;
            const LAS float* le = lg + 4 + gi * 8;
            float em = le[0];
            for (int i = 1; i < 8; ++i) em = fmaxf(em, le[i]);
            float es = 0.f;
            for (int i = 0; i < 8; ++i) es += __expf(le[i] - em);
            int i0 = 0; float p0 = -1.f;
            for (int i = 0; i < 8; ++i) { const float p = __expf(le[i] - em) / es; if (p > p0) { p0 = p; i0 = i; } }
            int i1 = 0; float p1 = -1.f;
            for (int i = 0; i < 8; ++i) { const float p = __expf(le[i] - em) / es; if (i != i0 && p > p1) { p1 = p; i1 = i; } }
            const float den = p0 + p1;
            const int e0 = gi * 8 + i0, e1 = gi * 8 + i1;
            EID[m * 2] = e0; EID[m * 2 + 1] = e1; GW[m * 2] = gw * p0 / den; GW[m * 2 + 1] = gw * p1 / den;
            const unsigned q0 = __hip_atomic_fetch_add(cnt + e0, 1u, __ATOMIC_RELAXED, __HIP_MEMORY_SCOPE_AGENT);
            const unsigned q1 = __hip_atomic_fetch_add(cnt + 32 + e1, 1u, __ATOMIC_RELAXED, __HIP_MEMORY_SCOPE_AGENT);
            list[(size_t)e0 * 16384 + q0] = m; list[(size_t)(32 + e1) * 16384 + q1] = m;
        }
    }
}

__device__ __forceinline__ int rfl(int v) { return __builtin_amdgcn_readfirstlane(v); }
struct MoeTab { LAS int* tsm; LAS int* c0; LAS int* c1; LAS int* ts0; LAS int* ts1; };
__device__ __forceinline__ MoeTab moe_tab_build(const MkArgs& a, LAS unsigned char* lds) {
    MoeTab t; LAS int* p = (LAS int*)(lds + MK_MOE_OFF); t.tsm = p; t.c0 = p + 40; t.c1 = p + 80; t.ts0 = p + 120; t.ts1 = p + 160;
    const unsigned* cnt = (const unsigned*)(a.ws + WS_CTL) + CW_CNT;
    __syncthreads();
    if (threadIdx.x == 0) {
        int am = 0, a0 = 0, a1 = 0;
        for (int e = 0; e < 32; ++e) { const int n0 = (int)__hip_atomic_load(cnt + e, __ATOMIC_RELAXED, __HIP_MEMORY_SCOPE_AGENT), n1 = (int)__hip_atomic_load(cnt + 32 + e, __ATOMIC_RELAXED, __HIP_MEMORY_SCOPE_AGENT);
            t.c0[e] = n0; t.c1[e] = n1; t.tsm[e] = am; t.ts0[e] = a0; t.ts1[e] = a1; am += (n0 + n1 + 255) >> 8; a0 += (n0 + 255) >> 8; a1 += (n1 + 255) >> 8; }
        t.tsm[32] = am; t.ts0[32] = a0; t.ts1[32] = a1;
    }
    __syncthreads();
    return t;
}
struct SchedGU {
    MoeTab t; const int* list; const char* H2; const char* Wt; int G, c, nunit; int R[2], C[2];
    __device__ void init(const MoeTab& t_, const MkArgs& a, int G_, int c_) { t = t_; list = (const int*)(a.ws + WS_LIST); H2 = (const char*)(a.ws + WS_XN); Wt = (const char*)(a.ws + WS_WTGU); G = G_; c = c_; nunit = rfl(t.tsm[32]) * 4;
#pragma unroll
        for (int i = 0; i < 2; ++i) pg8::stage_rc((int)threadIdx.x * 16 + i * 8192, R[i], C[i]); }
    __device__ bool next(int i, pg8::Unit& u) const {
        const int L = i * G + c; if (L >= nunit) return false;
        const int mt = L >> 2, pn = L & 3; int e = 0;
        for (int j = 1; j < 32; ++j) e += (mt >= t.tsm[j]) ? 1 : 0;
        e = rfl(e);
        u.pm = mt; u.pn = pn; u.aux = e; u.a = H2; u.b = Wt + ((size_t)(e * 1024 + pn * 256) * D) * 2;
        const int n0 = rfl(t.c0[e]), n1 = rfl(t.c1[e]), rb = (mt - rfl(t.tsm[e])) * 256;
#pragma unroll
        for (int h = 0; h < 2; ++h)
#pragma unroll
            for (int j = 0; j < 2; ++j) { const int r = rb + h * 128 + R[j]; int tok = 0;
                if (r < n0) tok = list[(size_t)e * 16384 + r]; else if (r - n0 < n1) tok = list[(size_t)(32 + e) * 16384 + (r - n0)];
                u.va[h][j] = (unsigned)(tok * D + C[j]) * 2u; }
        return true;
    }
};
struct EpiGU {
    static constexpr bool PERM = true;
    bf16_t* U;
    __device__ __forceinline__ void operator()(const pg8::f32x4 (&acc)[2][2][4][2], const pg8::Unit& u, int wr, int wc, int fr, int fq) const {
        const int row0 = u.pm * 256 + wr * 64 + fr, j0 = u.pn * 128 + wc * 16 + 4 * fq;
#pragma unroll
        for (int ai = 0; ai < 2; ++ai)
#pragma unroll
            for (int m = 0; m < 4; ++m) { bf16_t* rowp = U + (size_t)(row0 + ai * 128 + m * 16) * 512 + j0;
#pragma unroll
                for (int bj = 0; bj < 2; ++bj) { const pg8::f32x4 gv = acc[ai][bj][m][0], uv = acc[ai][bj][m][1]; float o[4];
#pragma unroll
                    for (int i = 0; i < 4; ++i) o[i] = gv[i] / (1.f + __expf(-gv[i])) * uv[i];
                    u32x2 w; w.x = pg8::cvt_pk_bf16(o[0], o[1]); w.y = pg8::cvt_pk_bf16(o[2], o[3]); *(u32x2*)(rowp + bj * 64) = w; } }
    }
};
struct SchedDN {
    MoeTab t; int slot; const char* U; const char* Wt; int G, c, nunit; unsigned vb[2][2];
    __device__ void init(const MoeTab& t_, const MkArgs& a, int slot_, int G_, int c_) { t = t_; slot = slot_; U = (const char*)(a.ws + WS_U); Wt = (const char*)(a.ws + WS_WTDN); G = G_; c = c_; nunit = rfl(slot ? t.ts1[32] : t.ts0[32]) * 8;
#pragma unroll
        for (int i = 0; i < 2; ++i) { int R, C; pg8::stage_rc((int)threadIdx.x * 16 + i * 8192, R, C); vb[0][i] = (unsigned)(R * 512 + C) * 2u; vb[1][i] = (unsigned)((128 + R) * 512 + C) * 2u; } }
    __device__ bool next(int i, pg8::Unit& u) const {
        const int L = i * G + c; if (L >= nunit) return false;
        const int tl = L >> 3, pn = L & 7; const LAS int* ts = slot ? t.ts1 : t.ts0; int e = 0;
        for (int j = 1; j < 32; ++j) e += (tl >= ts[j]) ? 1 : 0;
        e = rfl(e);
        const int lt = tl - rfl(ts[e]);
        u.pm = lt; u.pn = pn; u.aux = e;
        u.a = U + ((size_t)(rfl(t.tsm[e]) * 256 + (slot ? rfl(t.c0[e]) : 0) + lt * 256) * 512) * 2; u.b = Wt + ((size_t)(e * D + pn * 256) * 512) * 2;
        u.va[0][0] = vb[0][0]; u.va[0][1] = vb[0][1]; u.va[1][0] = vb[1][0]; u.va[1][1] = vb[1][1];
        return true;
    }
};
struct EpiDown {
    static constexpr bool PERM = true;
    MoeTab t; int slot; const int* list; const float* GW; const float* MOD; float* out;
    __device__ __forceinline__ void operator()(const pg8::f32x4 (&acc)[2][2][4][2], const pg8::Unit& u, int wr, int wc, int fr, int fq) const {
        const int e = u.aux, nv = rfl(slot ? t.c1[e] : t.c0[e]) - u.pm * 256;
        const int* lp = list + (size_t)(slot * 32 + e) * 16384 + u.pm * 256;
        const int col0 = u.pn * 256 + wc * 32 + 8 * fq;
#pragma unroll
        for (int ai = 0; ai < 2; ++ai)
#pragma unroll
            for (int m = 0; m < 4; ++m) { const int r = ai * 128 + wr * 64 + m * 16 + fr;
                if (r < nv) { const int tok = lp[r]; const float gw = GW[tok * 2 + slot]; const float* gp = MOD + (size_t)(tok >> 12) * NMOD + 5 * D + col0; float* op = out + (size_t)tok * D + col0;
#pragma unroll
                    for (int bj = 0; bj < 2; ++bj)
#pragma unroll
                        for (int n = 0; n < 2; ++n) { const pg8::f32x4 g0 = *(const pg8::f32x4*)(gp + bj * 128 + 4 * n); pg8::f32x4 o0 = *(pg8::f32x4*)(op + bj * 128 + 4 * n);
                            o0 += g0 * gw * acc[ai][bj][m][n]; *(pg8::f32x4*)(op + bj * 128 + 4 * n) = o0; } }
                asm volatile("" ::: "memory"); }
    }
};

typedef float f32x16 __attribute__((ext_vector_type(16)));
typedef short s16x4 __attribute__((ext_vector_type(4)));
__device__ __forceinline__ s16x4 tr_read(unsigned lds_addr) { s16x4 r; asm volatile("ds_read_b64_tr_b16 %0, %1\n\ts_waitcnt lgkmcnt(0)" : "=&v"(r) : "v"(lds_addr) : "memory"); return r; }
__device__ __forceinline__ unsigned off_b(unsigned row, unsigned ch) { return 256u * row + 16u * (ch ^ (((row & 3) << 2) | ((row >> 2) & 3))); }
__device__ __forceinline__ int crow(int reg, int h) { return (reg & 3) + 8 * (reg >> 2) + 4 * h; }
constexpr float SB_STOP = -104.0f;

__device__ __forceinline__ void sb_wave(const bf16_t* __restrict__ QB, const bf16_t* __restrict__ KB, const bf16_t* __restrict__ VB, int b, int h, int q0, LAS unsigned char* vt, f32x16 (&o)[4]) {
    const int lane = threadIdx.x & 63, r32 = lane & 31, hi = lane >> 5;
    bf16x8_t bq[8];
    { const bf16_t* qp = QB + (size_t)(b * S + q0 + r32) * 1024 + h * 128 + 64 * hi;
#pragma unroll
      for (int s = 0; s < 8; ++s) bq[s] = *(const bf16x8_t*)(qp + 8 * s); }
#pragma unroll
    for (int c = 0; c < 4; ++c)
#pragma unroll
        for (int i = 0; i < 16; ++i) o[c][i] = 0.f;
    float carry = 0.f;
    const unsigned vbase = (unsigned)(uintptr_t)vt;
    const int q16 = lane & 15, tq = q16 >> 2, tp = q16 & 3, blk = (lane >> 4) & 1;
    for (int kt = q0 >> 5; kt >= 0; --kt) {
        const int k0 = kt * 32;
        { const bf16_t* vp = VB + (size_t)(b * S + k0) * 1024 + h * 128;
#pragma unroll
          for (int i = 0; i < 8; ++i) { const int n = lane + 64 * i, row = n >> 4, ch = n & 15; const u32x4 v = *(const u32x4*)(vp + (size_t)row * 1024 + 8 * ch); *(LAS u32x4*)(vt + off_b(row, ch)) = v; } }
        f32x16 z;
#pragma unroll
        for (int i = 0; i < 16; ++i) z[i] = 0.f;
        { const bf16_t* kp = KB + (size_t)(b * S + k0 + r32) * 1024 + h * 128 + 64 * hi;
#pragma unroll
          for (int s = 0; s < 8; ++s) { const bf16x8_t kf = *(const bf16x8_t*)(kp + 8 * s); z = __builtin_amdgcn_mfma_f32_32x32x16_bf16(kf, bq[s], z, 0, 0, 0); } }
        const bool diag = (k0 == q0);
        float lm[16], sg[4];
#pragma unroll
        for (int g = 0; g < 4; ++g) sg[g] = 0.f;
#pragma unroll
        for (int i = 0; i < 16; ++i) { const float zz = z[i]; const float sp = fmaxf(zz, 0.f) + __logf(1.f + __expf(-fabsf(zz)));
            const bool valid = !diag || (crow(i, hi) < r32);
            lm[i] = valid ? -sp : 0.f; z[i] = valid ? (zz - sp) : -INFINITY; sg[i >> 2] += lm[i]; }
        float psg[4];
#pragma unroll
        for (int g = 0; g < 4; ++g) psg[g] = __shfl_xor(sg[g], 32);
        float aft[4];
        { float run = carry;
#pragma unroll
          for (int g = 3; g >= 0; --g) { if (hi == 0) { run += psg[g]; aft[g] = run; run += sg[g]; } else { aft[g] = run; run += sg[g]; run += psg[g]; } }
          carry = run; }
        float av[16];
#pragma unroll
        for (int g = 0; g < 4; ++g) { float run = aft[g];
#pragma unroll
            for (int r = 3; r >= 0; --r) { const int i = 4 * g + r; av[i] = __expf(z[i] + run); run += lm[i]; } }
        bf16x8_t pa[2];
#pragma unroll
        for (int s = 0; s < 2; ++s) { u32x4 p; p.x = pg8::cvt_pk_bf16(av[8 * s], av[8 * s + 1]); p.y = pg8::cvt_pk_bf16(av[8 * s + 2], av[8 * s + 3]); p.z = pg8::cvt_pk_bf16(av[8 * s + 4], av[8 * s + 5]); p.w = pg8::cvt_pk_bf16(av[8 * s + 6], av[8 * s + 7]); pa[s] = __builtin_bit_cast(bf16x8_t, p); }
        LDS_WAIT();
#pragma unroll
        for (int c = 0; c < 4; ++c)
#pragma unroll
            for (int s = 0; s < 2; ++s) {
                const unsigned rb0 = 16 * s + 4 * hi, rb1 = rb0 + 8;
                const s16x4 lo = tr_read(vbase + off_b(rb0 + tq, 4 * c + 2 * blk + (tp >> 1)) + 8 * (tp & 1));
                const s16x4 hv = tr_read(vbase + off_b(rb1 + tq, 4 * c + 2 * blk + (tp >> 1)) + 8 * (tp & 1));
                const bf16x8_t vf = __builtin_shufflevector(lo, hv, 0, 1, 2, 3, 4, 5, 6, 7);
                o[c] = __builtin_amdgcn_mfma_f32_32x32x16_bf16(vf, pa[s], o[c], 0, 0, 0);
            }
        if (__all(carry <= SB_STOP)) break;
    }
}
__device__ __forceinline__ void p6_sb(const MkArgs& a, LAS unsigned char* lds) {
    const int tid = threadIdx.x, lane = tid & 63, wave = __builtin_amdgcn_readfirstlane(tid >> 6), r32 = lane & 31, hi = lane >> 5;
    const bf16_t* QB = (const bf16_t*)(a.ws + WS_QB); const bf16_t* KB = (const bf16_t*)(a.ws + WS_KB); const bf16_t* VB = (const bf16_t*)(a.ws + WS_VB);
    bf16_t* O = (bf16_t*)(a.ws + WS_O); const float* gn_b = a.in[12];
    LAS float* s_ss = (LAS float*)(lds + 65536);
    for (int item = blockIdx.x; item < M / 32; item += gridDim.x) {
        const int b = item >> 7, q0 = (item & 127) * 32;
        f32x16 o[4];
        sb_wave(QB, KB, VB, b, wave, q0, lds + wave * 8192, o);
        float ss = 0.f;
#pragma unroll
        for (int c = 0; c < 4; ++c)
#pragma unroll
            for (int i = 0; i < 16; ++i) ss += o[c][i] * o[c][i];
        ss += __shfl_xor(ss, 32);
        __syncthreads();
        if (hi == 0) s_ss[wave * 32 + r32] = ss;
        __syncthreads();
        float tot = 0.f;
#pragma unroll
        for (int w = 0; w < 8; ++w) tot += s_ss[w * 32 + r32];
        const float rstd = rsqrtf(tot * (1.f / 1024.f) + EPS);
        bf16_t* op = O + (size_t)(b * S + q0 + r32) * D + 1024 + wave * 128;
        const float* gp = gn_b + wave * 128;
#pragma unroll
        for (int c = 0; c < 4; ++c)
#pragma unroll
            for (int g = 0; g < 4; ++g) { const int d = 32 * c + 8 * g + 4 * hi; const f32x4 gv = *(const f32x4*)(gp + d);
                u32x2 w; w.x = pk2(o[c][4 * g] * rstd * gv.x, o[c][4 * g + 1] * rstd * gv.y); w.y = pk2(o[c][4 * g + 2] * rstd * gv.z, o[c][4 * g + 3] * rstd * gv.w);
                *(u32x2*)(op + d) = w; }
    }
}

__device__ __forceinline__ void tr_read2(unsigned a0, unsigned a1, s16x4& r0, s16x4& r1) {
    asm volatile("ds_read_b64_tr_b16 %0, %2\n\tds_read_b64_tr_b16 %1, %3\n\ts_waitcnt lgkmcnt(0)" : "=&v"(r0), "=&v"(r1) : "v"(a0), "v"(a1) : "memory"); }
template <int NR>
__device__ __forceinline__ void topk_row(const float* __restrict__ row, int n, LAS unsigned short* sel, int lane) {
    unsigned key[NR];
#pragma unroll
    for (int i = 0; i < NR; ++i) { const int s = lane + 64 * i; const float v = __hip_atomic_load(row + s, __ATOMIC_RELAXED, __HIP_MEMORY_SCOPE_AGENT); key[i] = s < n ? fkey(v) : 0u; }
    unsigned T = 0u; bool exact = false;
    for (int bit = 31; bit >= 0; --bit) {
        const unsigned cand = T | (1u << bit);
        int c = 0;
#pragma unroll
        for (int i = 0; i < NR; ++i) c += __popcll(__ballot(key[i] >= cand));
        if (c >= 256) { T = cand; if (c == 256) { exact = true; break; } }
    }
    const unsigned Tg = exact ? T - 1u : T;
    int need = 0;
    if (!exact) { int cg = 0;
#pragma unroll
        for (int i = 0; i < NR; ++i) cg += __popcll(__ballot(key[i] > T));
        need = 256 - cg; }
    const unsigned long long ltm = (1ull << lane) - 1ull;
    int base = 0, run_eq = 0;
#pragma unroll
    for (int i = 0; i < NR; ++i) {
        const bool gt = key[i] > Tg, eq = (!exact) && (key[i] == T);
        const unsigned long long meq = __ballot(eq);
        const bool take = gt || (eq && (run_eq + __popcll(meq & ltm)) < need);
        const unsigned long long mt = __ballot(take);
        if (take) sel[base + __popcll(mt & ltm)] = (unsigned short)(lane + 64 * i);
        base += __popcll(mt); run_eq += __popcll(meq);
    }
}
__device__ __forceinline__ void dsa_token(const bf16_t* __restrict__ B0, const bf16_t* __restrict__ QA, const float* __restrict__ q_gain, const float* __restrict__ gn_a, bf16_t* __restrict__ O,
                                          int b, int t, int cnt, const LAS unsigned short* sel, const LAS float* s_bias, LAS unsigned char* vt) {
    int lane = threadIdx.x & 63; asm volatile("" : "+v"(lane));
    const int fr = lane & 15, g = lane >> 4, hd = fr & 7;
    const size_t m = (size_t)b * S + t;
    bf16x8_t bqa[4];
    {
        const bf16_t* qp = QA + m * 1024 + hd * 128 + 32 * g;
        float qf[32]; float ss = 0.f;
#pragma unroll
        for (int kk = 0; kk < 4; ++kk) { const u32x4 v = *(const u32x4*)(qp + 8 * kk);
#pragma unroll
            for (int j = 0; j < 4; ++j) { const unsigned w = v[j]; qf[8 * kk + 2 * j] = __uint_as_float(w << 16); qf[8 * kk + 2 * j + 1] = __uint_as_float(w & 0xffff0000u); } }
#pragma unroll
        for (int j = 0; j < 32; ++j) ss += qf[j] * qf[j];
        ss += __shfl_xor(ss, 16); ss += __shfl_xor(ss, 32);
        const float rs = (fr < 8) ? rsqrtf(ss * (1.f / 128.f) + EPS) * 0.08838834764831845f : 0.f;
        const float* gp = q_gain + 32 * g;
#pragma unroll
        for (int kk = 0; kk < 4; ++kk) { u32x4 p;
#pragma unroll
            for (int j = 0; j < 4; ++j) p[j] = pg8::cvt_pk_bf16(qf[8 * kk + 2 * j] * rs * gp[8 * kk + 2 * j], qf[8 * kk + 2 * j + 1] * rs * gp[8 * kk + 2 * j + 1]);
            bqa[kk] = __builtin_bit_cast(bf16x8_t, p); }
    }
    f32x4 lg[16];
    const bf16_t* kbase = B0 + (size_t)b * S * 1024 + 512 + 32 * g;
#pragma unroll
    for (int i = 0; i < 16; ++i) {
        const int s = sel[16 * i + fr];
        const bf16_t* kp = kbase + (size_t)s * 1024;
        f32x4 acc = (f32x4){0.f, 0.f, 0.f, 0.f};
#pragma unroll
        for (int kk = 0; kk < 4; ++kk) { const bf16x8_t ka = *(const bf16x8_t*)(kp + 8 * kk); acc = __builtin_amdgcn_mfma_f32_16x16x32_bf16(ka, bqa[kk], acc, 0, 0, 0); }
        lg[i] = acc;
        if ((i & 3) == 3) asm volatile("" ::: "memory");
    }
    float mx = -INFINITY;
#pragma unroll
    for (int i = 0; i < 16; ++i) {
        const u32x2 sv = *(const LAS u32x2*)(sel + 16 * i + 4 * g);
#pragma unroll
        for (int r = 0; r < 4; ++r) { const int j = 16 * i + 4 * g + r; const int sj = (int)((r & 1) ? (sv[r >> 1] >> 16) : (sv[r >> 1] & 0xffffu));
            int d = t - sj; d = d < 0 ? 0 : (d > 127 ? 127 : d);
            const float v = (j < cnt) ? lg[i][r] + s_bias[d * 8 + hd] : -INFINITY; lg[i][r] = v; mx = fmaxf(mx, v); }
    }
    mx = fmaxf(mx, __shfl_xor(mx, 16)); mx = fmaxf(mx, __shfl_xor(mx, 32));
    float sm = 0.f;
#pragma unroll
    for (int i = 0; i < 16; ++i)
#pragma unroll
        for (int r = 0; r < 4; ++r) { const float p = __expf(lg[i][r] - mx); lg[i][r] = p; sm += p; }
    sm += __shfl_xor(sm, 16); sm += __shfl_xor(sm, 32);
    const float inv = 1.f / sm;
    bf16x8_t pa[8];
#pragma unroll
    for (int ks = 0; ks < 8; ++ks) { u32x4 p; const f32x4 p0 = lg[2 * ks], p1 = lg[2 * ks + 1];
        p.x = pg8::cvt_pk_bf16(p0[0], p0[1]); p.y = pg8::cvt_pk_bf16(p0[2], p0[3]); p.z = pg8::cvt_pk_bf16(p1[0], p1[1]); p.w = pg8::cvt_pk_bf16(p1[2], p1[3]);
        pa[ks] = __builtin_bit_cast(bf16x8_t, p); }
    f32x4 out[8];
#pragma unroll
    for (int c = 0; c < 8; ++c) out[c] = (f32x4){0.f, 0.f, 0.f, 0.f};
    const unsigned vbase = (unsigned)(uintptr_t)vt;
    const int tq = fr >> 2, tp = fr & 3;
    const bf16_t* vb0 = B0 + (size_t)b * S * 1024 + 640;
#pragma unroll
    for (int ks = 0; ks < 8; ++ks) {
#pragma unroll
        for (int i = 0; i < 8; ++i) { const int n = lane + 64 * i, row = n >> 4, ch = n & 15; const int s = sel[32 * ks + row];
            const u32x4 v = *(const u32x4*)(vb0 + (size_t)s * 1024 + 8 * ch); *(LAS u32x4*)(vt + off_b(row, ch)) = v; }
        LDS_WAIT();
#pragma unroll
        for (int c = 0; c < 8; ++c) {
            s16x4 lo, hv;
            tr_read2(vbase + off_b(4 * g + tq, 2 * c + (tp >> 1)) + 8 * (tp & 1), vbase + off_b(16 + 4 * g + tq, 2 * c + (tp >> 1)) + 8 * (tp & 1), lo, hv);
            const bf16x8_t vf = __builtin_shufflevector(lo, hv, 0, 1, 2, 3, 4, 5, 6, 7);
            out[c] = __builtin_amdgcn_mfma_f32_16x16x32_bf16(pa[ks], vf, out[c], 0, 0, 0);
        }
        asm volatile("" ::: "memory");
    }
    float invh[4];
#pragma unroll
    for (int r = 0; r < 4; ++r) invh[r] = __shfl(inv, 4 * (g & 1) + r);
    float ss = 0.f;
#pragma unroll
    for (int c = 0; c < 8; ++c)
#pragma unroll
        for (int r = 0; r < 4; ++r) { const float v = out[c][r] * invh[r]; out[c][r] = v; ss += (g < 2) ? v * v : 0.f; }
    const float rstd = rsqrtf(wave_sum(ss) * (1.f / 1024.f) + EPS);
    if (g < 2) {
#pragma unroll
        for (int c = 0; c < 8; ++c)
#pragma unroll
            for (int r = 0; r < 4; ++r) { const int e = (4 * g + r) * 128 + 16 * c + fr; O[m * D + e] = f2bf(out[c][r] * rstd * gn_a[e]); }
    }
}
__device__ __forceinline__ void p5_dsa(const MkArgs& a, LAS unsigned char* lds) {
    const int tid = threadIdx.x, lane = tid & 63, wave = __builtin_amdgcn_readfirstlane(tid >> 6);
    const bf16_t* B0 = (const bf16_t*)(a.ws + WS_B0); const bf16_t* QI = (const bf16_t*)(a.ws + WS_QI); const bf16_t* QA = (const bf16_t*)(a.ws + WS_QA);
    bf16_t* O = (bf16_t*)(a.ws + WS_O); const float* rel_bias = a.in[10];
    float* SC = (float*)(a.ws + WS_OBRAW) + (size_t)blockIdx.x * (16 * 4096);
    LAS unsigned char* s_kt = lds;
    LAS float* s_bias = (LAS float*)(lds + 18432);
    LAS unsigned short* s_sel = (LAS unsigned short*)(lds + 22528 + wave * 1024);
    LAS unsigned char* s_vt = lds + 32768 + wave * 8192;
    for (int i = tid; i < 1024; i += MK_THREADS) s_bias[i] = rel_bias[t5_bucket(i >> 3) * 8 + (i & 7)];
    __syncthreads();
    const int Gd = gridDim.x;
    for (int it = blockIdx.x; it < 1024; it += Gd) {
        const int jj = it / Gd, kk_ = it % Gd; int gi = (jj & 1) ? (jj * Gd + (Gd - 1 - kk_)) : it; if (gi >= 1024) gi = it;
        const int b = gi & 3, t0 = (gi >> 2) * 16;
        const int tA = t0 + 2 * wave;
        int ln = lane; asm volatile("" : "+v"(ln));
        const int r32 = ln & 31, hi = ln >> 5;
        bf16x8_t aq[4]; float wv[16];
        { const int tt = (r32 >> 2) & 1, hh = (r32 & 3) + 4 * (r32 >> 3);
          const bf16_t* qp = QI + (size_t)(b * S + tA + tt) * 1024 + hh * 64 + 32 * hi;
#pragma unroll
          for (int kk = 0; kk < 4; ++kk) aq[kk] = *(const bf16x8_t*)(qp + 8 * kk);
          const bf16_t* wp = B0 + (size_t)(b * S + tA + hi) * 1024 + 832;
          const u32x4 w0 = *(const u32x4*)wp, w1 = *(const u32x4*)(wp + 8);
#pragma unroll
          for (int j = 0; j < 4; ++j) { wv[2 * j] = __uint_as_float(w0[j] << 16); wv[2 * j + 1] = __uint_as_float(w0[j] & 0xffff0000u); wv[8 + 2 * j] = __uint_as_float(w1[j] << 16); wv[8 + 2 * j + 1] = __uint_as_float(w1[j] & 0xffff0000u); } }
        const int nkb = (t0 + 15) / 128 + 1;
        for (int kb = 0; kb < nkb; ++kb) {
            __syncthreads();
            { const int key = tid >> 2, q4 = tid & 3; const bf16_t* src = B0 + (size_t)(b * S + kb * 128 + key) * 1024 + 768 + 16 * q4;
              const u32x4 v0 = *(const u32x4*)src, v1 = *(const u32x4*)(src + 8);
              *(LAS u32x4*)(s_kt + key * 144 + q4 * 32) = v0; *(LAS u32x4*)(s_kt + key * 144 + q4 * 32 + 16) = v1; }
            __syncthreads();
#pragma unroll
            for (int sub = 0; sub < 4; ++sub) {
                f32x16 sc;
#pragma unroll
                for (int i = 0; i < 16; ++i) sc[i] = 0.f;
#pragma unroll
                for (int kk = 0; kk < 4; ++kk) { const bf16x8_t bk = *(const LAS bf16x8_t*)(s_kt + (32 * sub + r32) * 144 + (32 * hi + 8 * kk) * 2); sc = __builtin_amdgcn_mfma_f32_32x32x16_bf16(aq[kk], bk, sc, 0, 0, 0); }
                float score = 0.f;
#pragma unroll
                for (int i = 0; i < 16; ++i) score += wv[i] * fmaxf(sc[i], 0.f);
                SC[(size_t)(2 * wave + hi) * 4096 + kb * 128 + sub * 32 + r32] = score;
            }
        }
        asm volatile("s_waitcnt vmcnt(0)" ::: "memory");
        for (int tt = 0; tt < 2; ++tt) {
            const int t = tA + tt, n = t + 1; const float* row = SC + (size_t)(2 * wave + tt) * 4096; LAS unsigned short* sel = s_sel + tt * 256;
            if (n <= 256) { for (int i = 0; i < 4; ++i) { const int j = lane + 64 * i; sel[j] = (unsigned short)(j < n ? j : 0); } }
            else if (n <= 1024) topk_row<16>(row, n, sel, lane);
            else if (n <= 2048) topk_row<32>(row, n, sel, lane);
            else if (n <= 3072) topk_row<48>(row, n, sel, lane);
            else topk_row<64>(row, n, sel, lane);
        }
        LDS_WAIT();
        for (int tt = 0; tt < 2; ++tt) {
            const int t = tA + tt;
            dsa_token(B0, QA, a.in[8], a.in[11], O, b, t, t + 1 < 256 ? t + 1 : 256, s_sel + tt * 256, s_bias, s_vt);
        }
    }
}

constexpr int CW_BAR = 4096;
__global__ void __launch_bounds__(MK_THREADS, 2) mk_fwd(MkArgs a) {
    extern __shared__ __attribute__((aligned(16))) unsigned char lds_raw[];
    LAS unsigned char* lds = (LAS unsigned char*)lds_raw;
    const int lo = a.ph_lo, hi = a.ph_hi;
    const bool fused = (hi - lo) > 1;
    volatile LAS unsigned* misc = (volatile LAS unsigned*)(lds + MK_MISC_OFF);
    XcdBarrier bar; bar.bar = (unsigned*)(a.ws + WS_CTL) + CW_BAR; bar.x = 0; bar.st = misc + 8;
    if (fused) {
        if (threadIdx.x < 32) misc[threadIdx.x] = 0u;
        __syncthreads();
        bar = xcd_barrier_post((unsigned*)(a.ws + WS_CTL) + CW_BAR, misc + 8);
    }
    int nbar = 0;
#define IN(k) (lo <= (k) && (k) < hi)
#define SEAM() do { if (fused) { if (nbar == 0) cg::this_grid().sync(); else xcd_barrier(bar); ++nbar; } } while (0)
    if (IN(0)) { p0_prep(a, lds); SEAM(); }
    if (IN(1)) { p1_xn(a, lds); SEAM(); }
    if (IN(2)) {
        pg8::Gemm g{(const bf16_t*)(a.ws + WS_XN), (const bf16_t*)(a.ws + WS_WTIN), M, 4096, D, D, D};
        pg8::StaticOrder S; S.init(g, (int)gridDim.x, (int)blockIdx.x);
        EpiInProj E{(bf16_t*)(a.ws + WS_B0), (bf16_t*)(a.ws + WS_QB), (bf16_t*)(a.ws + WS_KB), (bf16_t*)(a.ws + WS_VB), (float*)(a.ws + WS_SSQ)};
        pg8::gemm_phase<EpiInProj, pg8::StaticOrder>(lds, g, S, E);
        SEAM();
    }
    if (IN(3)) {
        kanorm_pass(a);
        pg8::Gemm g{(const bf16_t*)(a.ws + WS_B0), (const bf16_t*)(a.ws + WS_WTQUP), M, 2048, 512, 1024, 512};
        pg8::StaticOrder S; S.init(g, (int)gridDim.x, (int)blockIdx.x);
        EpiQupG E{(const float*)(a.ws + WS_SSQ), (bf16_t*)(a.ws + WS_QA), (bf16_t*)(a.ws + WS_QI)};
        pg8::gemm_phase<EpiQupG, pg8::StaticOrder>(lds, g, S, E);
        SEAM();
    }
    if (IN(5)) { p5_dsa(a, lds); __syncthreads(); }
    if (IN(6)) { p6_sb(a, lds); SEAM(); }
    if (IN(7)) {
        pg8::Gemm g{(const bf16_t*)(a.ws + WS_O), (const bf16_t*)(a.ws + WS_WTOUT), M, D, D, D, D};
        pg8::StaticOrder S; S.init(g, (int)gridDim.x, (int)blockIdx.x);
        EpiOutProj E{a.in[0], (const float*)(a.ws + WS_MOD), a.out};
        pg8::gemm_phase<EpiOutProj, pg8::StaticOrder>(lds, g, S, E);
        SEAM();
    }
    if (IN(8)) { p8_route(a, lds); SEAM(); }
    if (IN(9)) {
        const MoeTab t = moe_tab_build(a, lds);
        pg8::Gemm g{(const bf16_t*)(a.ws + WS_XN), (const bf16_t*)(a.ws + WS_WTGU), 0, 0, D, D, D};
        SchedGU S; S.init(t, a, (int)gridDim.x, (int)blockIdx.x);
        EpiGU E{(bf16_t*)(a.ws + WS_U)};
        pg8::gemm_phase<EpiGU, SchedGU>(lds, g, S, E);
        SEAM();
    }
    for (int slot = 0; slot < 2; ++slot) if (IN(10 + slot)) {
        const MoeTab t = moe_tab_build(a, lds);
        pg8::Gemm g{(const bf16_t*)(a.ws + WS_U), (const bf16_t*)(a.ws + WS_WTDN), 0, 0, 512, 512, 512};
        SchedDN S; S.init(t, a, slot, (int)gridDim.x, (int)blockIdx.x);
        EpiDown E{t, slot, (const int*)(a.ws + WS_LIST), (const float*)(a.ws + WS_GW), (const float*)(a.ws + WS_MOD), a.out};
        pg8::gemm_phase<EpiDown, SchedDN>(lds, g, S, E);
        if (slot == 0) SEAM();
    }
#undef IN
#undef SEAM
}

#ifndef MK_ONE_LAUNCH
#define MK_ONE_LAUNCH 1
#endif
extern "C" void kernel_launch(void* const* d_in, const int* in_sizes, int n_in, void* d_out, int out_size, void* d_ws, size_t ws_size, hipStream_t stream) {
    static int grid = 0;
    if (grid == 0) {
        if (ws_size < WS_END || n_in != 20 || out_size != M * D) { fprintf(stderr, "kernel_launch: unexpected sizes: ws %zu (need %zu), n_in %d, out %d\n", ws_size, (size_t)WS_END, n_in, out_size); grid = -1; return; }
        int dev = 0, cus = 0, per_cu = 0;
        if (hipGetDevice(&dev) != hipSuccess || hipDeviceGetAttribute(&cus, hipDeviceAttributeMultiprocessorCount, dev) != hipSuccess) { grid = -1; return; }
        if (hipFuncSetAttribute((const void*)mk_fwd, hipFuncAttributeMaxDynamicSharedMemorySize, MK_LDS) != hipSuccess) { fprintf(stderr, "kernel_launch: hipFuncSetAttribute failed\n"); grid = -1; return; }
        if (hipOccupancyMaxActiveBlocksPerMultiprocessor(&per_cu, (const void*)mk_fwd, MK_THREADS, MK_LDS) != hipSuccess || per_cu < 1) { fprintf(stderr, "kernel_launch: occupancy query failed (%d)\n", per_cu); grid = -1; return; }
        grid = cus < 256 ? cus : 256;
        fprintf(stderr, "kernel_launch: cus %d per_cu %d grid %d\n", cus, per_cu, grid);
    }
    if (grid < 0) return;
    if (hipMemsetAsync(d_ws, 0, 1 * MiB, stream) != hipSuccess) return;
    MkArgs a{};
    for (int i = 0; i < 20; ++i) a.in[i] = (const float*)d_in[i];
    a.out = (float*)d_out; a.ws = (unsigned char*)d_ws;
#if MK_ONE_LAUNCH
    a.ph_lo = 0; a.ph_hi = 12;
    void* args[] = {&a};
    const hipError_t e = hipLaunchCooperativeKernel((const void*)mk_fwd, dim3(grid), dim3(MK_THREADS), args, MK_LDS, stream);
    if (e != hipSuccess) fprintf(stderr, "kernel_launch: cooperative launch failed: %s (grid %d)\n", hipGetErrorString(e), grid);
#else
    const int phases[] = {0, 1, 2, 3, 5, 6, 7, 8, 9, 10, 11};
    for (int ph : phases) { a.ph_lo = ph; a.ph_hi = ph + 1; hipLaunchKernelGGL(mk_fwd, dim3(grid), dim3(MK_THREADS), MK_LDS, stream, a); }
#endif
}
```

```cpp
#include <hip/hip_runtime.h>
#include <hip/hip_cooperative_groups.h>
#include <stdint.h>
#include <cstdio>
namespace cg = cooperative_groups;

typedef unsigned short bf16_t;
#define LAS __attribute__((address_space(3)))

constexpr int D = 2048, NB = 4, S = 4096, M = NB * S;
constexpr int NMOD = 6 * D;
constexpr int DIN = 3920;
constexpr float EPS = 1e-6f;
constexpr size_t MiB = 1ull << 20;
constexpr size_t WS_CTL = 0;
constexpr size_t WS_MOD = 1 * MiB;
constexpr size_t WS_RC = 2 * MiB;
constexpr size_t WS_EID = 3 * MiB;
constexpr size_t WS_GW = 4 * MiB;
constexpr size_t WS_SSQ = 5 * MiB;
constexpr size_t WS_XN = 8 * MiB;
constexpr size_t WS_B0 = 72 * MiB;
constexpr size_t WS_QB = 104 * MiB;
constexpr size_t WS_KB = 136 * MiB;
constexpr size_t WS_VB = 168 * MiB;
constexpr size_t WS_QA = 200 * MiB;
constexpr size_t WS_QI = 232 * MiB;
constexpr size_t WS_SEL = 264 * MiB;
constexpr size_t WS_O = 272 * MiB;
constexpr size_t WS_OBRAW = 336 * MiB;
constexpr size_t WS_MODP = 400 * MiB;
constexpr size_t WS_WTIN = 408 * MiB;
constexpr size_t WS_WTQUP = 424 * MiB;
constexpr size_t WS_WTOUT = 426 * MiB;
constexpr size_t WS_WTGU = 434 * MiB;
constexpr size_t WS_WTDN = 562 * MiB;
constexpr size_t WS_RT = 6 * MiB;
constexpr size_t WS_LIST = WS_B0;
constexpr size_t WS_U = WS_QA;
constexpr int CW_CNT = 8192;
constexpr size_t WS_END = 626 * MiB;

__device__ __forceinline__ float bf2f(bf16_t v) { return __uint_as_float(((unsigned)v) << 16); }
__device__ __forceinline__ bf16_t f2bf(float f) { unsigned u = __float_as_uint(f); u += 0x7fffu + ((u >> 16) & 1u); return (bf16_t)(u >> 16); }
__device__ __forceinline__ float silu_f(float v) { return v / (1.f + __expf(-v)); }
__device__ __forceinline__ unsigned fkey(float f) { const unsigned u = __float_as_uint(f); return (u & 0x80000000u) ? ~u : (u | 0x80000000u); }
__device__ __forceinline__ int t5_bucket(int dist) {
    if (dist < 16) return dist;
    int large = 16 + (int)(__logf((float)dist * (1.f / 16.f)) / 2.0794415416798357f * 16.f);
    return large < 31 ? large : 31;
}

namespace pg8 {
#define PG8_LAS __attribute__((address_space(3)))
typedef short bf16x8 __attribute__((ext_vector_type(8)));
typedef float f32x4 __attribute__((ext_vector_type(4)));
typedef unsigned u32x4 __attribute__((ext_vector_type(4)));
constexpr int BM = 256, BK = 64, HALF = 128, HTB = HALF * BK * 2, STAGE_BYTES = 8 * HTB, NXCD = 8, WGM = 8;
__host__ __device__ __forceinline__ int lds_byte(int r, int c) { const int st = (r >> 4) * 2 + (c >> 5), rr = r & 15, cc = c & 31, ob = rr * 64 + cc * 2; return st * 1024 + (ob ^ (((ob >> 9) & 1) << 5)); }
__host__ __device__ __forceinline__ void stage_rc(int b, int& R, int& C) { const int st = b / 1024, sb = b % 1024, swz = sb ^ (((sb >> 9) & 1) << 5); R = (st >> 1) * 16 + swz / 64; C = (st & 1) * 32 + (swz % 64) / 2; }
__host__ __device__ __forceinline__ int perm32(int rho) { const int n = rho >> 4, i = rho & 15; return 8 * (i >> 2) + 4 * n + (i & 3); }
__device__ __forceinline__ unsigned cvt_pk_bf16(float lo, float hi) { unsigned r; asm volatile("v_cvt_pk_bf16_f32 %0, %1, %2" : "=v"(r) : "v"(lo), "v"(hi)); return r; }

struct Unit { int pm, pn, aux; const char* a; const char* b; unsigned va[2][2]; };
struct Gemm { const bf16_t* A; const bf16_t* Bt; int M, N, K, lda, ldb; };

struct StaticOrder {
    int nM, nN, nwg, G, c; const char* A; const char* Bt; size_t tstepA, tstepB; unsigned vb[2][2];
    __device__ void init(const Gemm& g, int G_, int c_) { nM = g.M / BM; nN = g.N / BM; nwg = nM * nN; G = G_; c = c_; A = (const char*)g.A; Bt = (const char*)g.Bt; tstepA = (size_t)BM * g.lda * 2; tstepB = (size_t)BM * g.ldb * 2;
#pragma unroll
        for (int i = 0; i < 2; ++i) { int R, C; stage_rc((int)threadIdx.x * 16 + i * 8192, R, C); vb[0][i] = (unsigned)(R * g.lda + C) * 2u; vb[1][i] = (unsigned)((HALF + R) * g.lda + C) * 2u; } }
    __device__ bool next(int i, Unit& u) const {
        const long L = (long)i * G + c; if (L >= nwg) return false;
        int wgid = (int)L; { const int q = nwg / NXCD, r = nwg % NXCD, xcd = wgid % NXCD, off = wgid / NXCD; wgid = (xcd < r ? xcd * (q + 1) : r * (q + 1) + (xcd - r) * q) + off; }
        const int nig = WGM * nN, gid = wgid / nig, fm = gid * WGM, gsz = (nM - fm) < WGM ? (nM - fm) : WGM;
        u.pm = fm + ((wgid % nig) % gsz); u.pn = (wgid % nig) / gsz;
        u.a = A + (size_t)u.pm * tstepA; u.b = Bt + (size_t)u.pn * tstepB; u.aux = 0; u.va[0][0] = vb[0][0]; u.va[0][1] = vb[0][1]; u.va[1][0] = vb[1][0]; u.va[1][1] = vb[1][1]; return true;
    }
};

template <class Epi, class Sched>
__device__ __forceinline__ void gemm_phase(PG8_LAS unsigned char* lds, const Gemm g, const Sched& S, const Epi& E) {
    const int tid = threadIdx.x, wid = __builtin_amdgcn_readfirstlane(tid >> 6), lane = tid & 63, wr = wid >> 2, wc = wid & 3, fr = lane & 15, fq = lane >> 4;
    const int K = g.K, nt = K / BK;
    unsigned voffB[2];
#pragma unroll
    for (int i = 0; i < 2; ++i) { int R, C; stage_rc(tid * 16 + i * 8192, R, C); const int Rb = Epi::PERM ? ((R & ~31) + perm32(R & 31)) : R;
        voffB[i] = (unsigned)(Rb * g.ldb + C) * 2u; }
    const size_t kstep = (size_t)(BK * 2);
    const size_t hstepB = (size_t)HALF * g.ldb * 2;
    const unsigned ldsw = (unsigned)wid * 1024u;
    const int aoff = lds_byte(wr * 64 + fr, fq * 8), boff = lds_byte(wc * 32 + fr, fq * 8);
#define PG8_SA(b, h) (((b) * 2 + (h)) * HTB)
#define PG8_SB(b, h) ((4 + (b) * 2 + (h)) * HTB)
#define PG8_STAGE(bufoff, gbase, voff) do { _Pragma("unroll") for (int _i = 0; _i < 2; ++_i) \
        __builtin_amdgcn_global_load_lds((const unsigned*)((const char*)(gbase) + (voff)[_i]), (PG8_LAS unsigned*)(lds + (bufoff) + ldsw + _i * 8192), 16, 0, 0); } while (0)
#define PG8_LDA(dst, b, h) do { _Pragma("unroll") for (int m = 0; m < 4; ++m) _Pragma("unroll") for (int k = 0; k < 2; ++k) dst[m][k] = *(const PG8_LAS bf16x8*)(lds + PG8_SA(b, h) + aoff + m * 2048 + k * 1024); } while (0)
#define PG8_LDB(dst, b, h) do { _Pragma("unroll") for (int n = 0; n < 2; ++n) _Pragma("unroll") for (int k = 0; k < 2; ++k) dst[n][k] = *(const PG8_LAS bf16x8*)(lds + PG8_SB(b, h) + boff + n * 2048 + k * 1024); } while (0)
#define PG8_MMA(ai, bj, At, Bt) do { __builtin_amdgcn_s_setprio(1); _Pragma("unroll") for (int m = 0; m < 4; ++m) _Pragma("unroll") for (int n = 0; n < 2; ++n) _Pragma("unroll") for (int k = 0; k < 2; ++k) \
        acc[ai][bj][m][n] = __builtin_amdgcn_mfma_f32_16x16x32_bf16(Bt[n][k], At[m][k], acc[ai][bj][m][n], 0, 0, 0); __builtin_amdgcn_s_setprio(0); } while (0)
#define PG8_WAIT_V(n) asm volatile("s_waitcnt vmcnt(" #n ")" ::: "memory")
#define PG8_WAIT_L(n) asm volatile("s_waitcnt lgkmcnt(" #n ")" ::: "memory")
#define PG8_BAR __builtin_amdgcn_s_barrier()
#define PG8_SCHED __builtin_amdgcn_sched_barrier(0)
    Unit cur, nxt; int ui = 0;
    if (!S.next(0, cur)) return;
    f32x4 acc[2][2][4][2];
#pragma unroll
    for (int a = 0; a < 2; ++a)
#pragma unroll
        for (int b = 0; b < 2; ++b)
#pragma unroll
            for (int m = 0; m < 4; ++m)
#pragma unroll
                for (int n = 0; n < 2; ++n) acc[a][b][m][n] = (f32x4){0.f, 0.f, 0.f, 0.f};
    bf16x8 At[4][2], B0[2][2], B1[2][2];
    const char* cA = cur.a; const char* cB = cur.b;
    PG8_STAGE(PG8_SB(0, 0), cB, voffB); PG8_STAGE(PG8_SB(0, 1), cB + hstepB, voffB); PG8_STAGE(PG8_SA(0, 0), cA, cur.va[0]); PG8_STAGE(PG8_SA(0, 1), cA, cur.va[1]);
    if (wr == 1) PG8_BAR;
    PG8_WAIT_V(2); PG8_BAR;
    PG8_STAGE(PG8_SB(1, 0), cB + kstep, voffB); PG8_STAGE(PG8_SA(1, 0), cA + kstep, cur.va[0]); PG8_STAGE(PG8_SB(1, 1), cB + hstepB + kstep, voffB);
    PG8_WAIT_V(6); PG8_BAR;
    for (;;) {
        const bool has_next = S.next(ui + 1, nxt);
        if (!has_next) nxt = cur;
        const char* nA = has_next ? nxt.a : cA; const char* nB = has_next ? nxt.b : cB;
        for (int t = 0; t < nt; t += 2) {
            const bool last = (t == nt - 2);
            const char* a1 = cA + (size_t)(t + 1) * kstep;
            const char* a2 = last ? nA : cA + (size_t)(t + 2) * kstep; const char* b2 = last ? nB : cB + (size_t)(t + 2) * kstep;
            const char* a3 = a2 + kstep; const char* b3 = b2 + kstep;
            unsigned vn0[2], vn1[2];
            vn0[0] = last ? nxt.va[0][0] : cur.va[0][0]; vn0[1] = last ? nxt.va[0][1] : cur.va[0][1]; vn1[0] = last ? nxt.va[1][0] : cur.va[1][0]; vn1[1] = last ? nxt.va[1][1] : cur.va[1][1];
            PG8_LDB(B0, 0, 0); PG8_LDB(B1, 0, 1); PG8_SCHED; PG8_LDA(At, 0, 0); PG8_STAGE(PG8_SA(1, 1), a1, cur.va[1]);
            PG8_WAIT_V(8); PG8_WAIT_L(0); PG8_BAR; PG8_MMA(0, 0, At, B0); PG8_MMA(0, 1, At, B1); PG8_BAR; PG8_SCHED;
            PG8_LDA(At, 0, 1); PG8_STAGE(PG8_SB(0, 0), b2, voffB); PG8_STAGE(PG8_SB(0, 1), b2 + hstepB, voffB); PG8_STAGE(PG8_SA(0, 0), a2, vn0);
            PG8_WAIT_V(8); PG8_WAIT_L(0); PG8_BAR; PG8_MMA(1, 0, At, B0); PG8_MMA(1, 1, At, B1); PG8_BAR; PG8_SCHED;
            PG8_LDB(B0, 1, 0); PG8_LDB(B1, 1, 1); PG8_SCHED; PG8_LDA(At, 1, 0); PG8_STAGE(PG8_SA(0, 1), a2, vn1);
            PG8_WAIT_V(8); PG8_WAIT_L(0); PG8_BAR; PG8_MMA(0, 0, At, B0); PG8_MMA(0, 1, At, B1); PG8_BAR; PG8_SCHED;
            PG8_LDA(At, 1, 1); PG8_STAGE(PG8_SB(1, 0), b3, voffB); PG8_STAGE(PG8_SB(1, 1), b3 + hstepB, voffB); PG8_STAGE(PG8_SA(1, 0), a3, vn0);
            PG8_WAIT_V(8); PG8_WAIT_L(0); PG8_BAR; PG8_MMA(1, 0, At, B0); PG8_MMA(1, 1, At, B1); PG8_BAR; PG8_SCHED;
        }
        if (wr == 0) PG8_BAR;
        E(acc, cur, wr, wc, fr, fq);
        if (!has_next) break;
#pragma unroll
        for (int a = 0; a < 2; ++a)
#pragma unroll
            for (int b = 0; b < 2; ++b)
#pragma unroll
                for (int m = 0; m < 4; ++m)
#pragma unroll
                    for (int n = 0; n < 2; ++n) acc[a][b][m][n] = (f32x4){0.f, 0.f, 0.f, 0.f};
        cur = nxt; cA = nA; cB = nB; ++ui;
        if (wr == 1) PG8_BAR;
    }
    PG8_WAIT_V(0);
    PG8_BAR;
#undef PG8_SA
#undef PG8_SB
#undef PG8_STAGE
#undef PG8_LDA
#undef PG8_LDB
#undef PG8_MMA
#undef PG8_WAIT_V
#undef PG8_WAIT_L
#undef PG8_BAR
#undef PG8_SCHED
}
}
#ifndef MK_DUP
#define MK_DUP -1
#endif
#define REP(k) for (int rep_ = 0; rep_ < ((MK_DUP) == (k) ? 2 : 1); ++rep_)

#define XB_TMO      128
#define XB_XCNT(j)  (256  + 64 * (j))
#define XB_XSUB(j)  (1280 + 64 * (j))
#define XB_XGEN(j)  (2304 + 64 * (j))
#define XB_TOP      3328
#define XB_TOPGEN   3392
#define XCD_BAR_WORDS 3456
#define XB_SPIN_CAP (1u << 18)
__device__ __forceinline__ unsigned xb_ld(unsigned* p)              { return __hip_atomic_load(p, __ATOMIC_RELAXED, __HIP_MEMORY_SCOPE_AGENT); }
__device__ __forceinline__ unsigned xb_add(unsigned* p, unsigned v) { return __hip_atomic_fetch_add(p, v, __ATOMIC_RELAXED, __HIP_MEMORY_SCOPE_AGENT); }
__device__ __forceinline__ unsigned xb_xcc_id() { return (unsigned)__builtin_amdgcn_s_getreg((3 << 11) | 20) & 0xFu; }
#define XB_SPIN(cond, bar) do { unsigned _sp = 0; while (cond) { __builtin_amdgcn_s_sleep(1); \
    if ((++_sp & 255u) == 0u) { if (xb_ld(&(bar)[XB_TMO])) break; if (_sp > XB_SPIN_CAP) { atomicAdd(&(bar)[XB_TMO], 1u); break; } } } } while (0)
struct XcdBarrier { unsigned* bar; unsigned x; volatile LAS unsigned* st; };
__device__ __forceinline__ XcdBarrier xcd_barrier_post(unsigned* bar, volatile LAS unsigned* st) {
    XcdBarrier b; b.bar = bar; b.x = xb_xcc_id(); b.st = st;
    if (threadIdx.x == 0) (void)xb_add(&bar[XB_XCNT(b.x)], 1u);
    return b;
}
__device__ __forceinline__ void xcd_barrier_complete(unsigned* bar, unsigned x, unsigned& nloc, unsigned& nx) {
    const unsigned G = gridDim.x * gridDim.y * gridDim.z;
    unsigned sum, cnt, mine, sp = 0u;
    for (;;) {
        sum = 0u; cnt = 0u; mine = 0u;
#pragma unroll
        for (unsigned j = 0; j < 16; ++j) { const unsigned c = xb_ld(&bar[XB_XCNT(j)]); sum += c; cnt += (c > 0u) ? 1u : 0u; mine = (j == x) ? c : mine; }
        if (sum == G) break;
        __builtin_amdgcn_s_sleep(1);
        if ((++sp & 255u) == 0u) { if (xb_ld(&bar[XB_TMO])) break; if (sp > XB_SPIN_CAP) { atomicAdd(&bar[XB_TMO], 1u); break; } }
    }
    nloc = mine > 0u ? mine : 1u; nx = cnt > 0u ? cnt : 1u;
}
__device__ __forceinline__ void xcd_barrier(const XcdBarrier& b) {
    asm volatile("s_waitcnt vmcnt(0)" ::: "memory");
    __syncthreads();
    if (threadIdx.x == 0) {
        unsigned* bar = b.bar;
        __builtin_amdgcn_s_waitcnt(0);
        unsigned nloc = b.st[0], nx = b.st[1];
        if (nloc == 0u) { xcd_barrier_complete(bar, b.x, nloc, nx); b.st[0] = nloc; b.st[1] = nx; }
        const unsigned old = xb_add(&bar[XB_XSUB(b.x)], 1u);
        const unsigned gen = old / nloc;
        if (old + 1u == (gen + 1u) * nloc) {
            __builtin_amdgcn_fence(__ATOMIC_RELEASE, "agent");
            asm volatile("s_waitcnt vmcnt(0)" ::: "memory");
            const unsigned og = xb_add(&bar[XB_TOP], 1u);
            const unsigned tg = og / nx;
            if (og + 1u == (tg + 1u) * nx) xb_add(&bar[XB_TOPGEN], 1u);
            else XB_SPIN(xb_ld(&bar[XB_TOPGEN]) == tg, bar);
            __builtin_amdgcn_fence(__ATOMIC_ACQUIRE, "agent");
            xb_add(&bar[XB_XGEN(b.x)], 1u);
            asm volatile("s_waitcnt vmcnt(0)" ::: "memory");
        } else {
            XB_SPIN(xb_ld(&bar[XB_XGEN(b.x)]) == gen, bar);
            __builtin_amdgcn_fence(__ATOMIC_ACQUIRE, "agent");
            asm volatile("s_waitcnt vmcnt(0)" ::: "memory");
        }
    }
    __syncthreads();
}

constexpr int MK_THREADS = 512, MK_LDS = 147456, MK_MISC_OFF = 135168, MK_MOE_OFF = 135168 + 256;
struct MkArgs { const float* in[20]; float* out; unsigned char* ws; int ph_lo, ph_hi; };
typedef float f32x4 __attribute__((ext_vector_type(4)));
typedef unsigned u32x4 __attribute__((ext_vector_type(4)));
typedef unsigned u32x2 __attribute__((ext_vector_type(2)));
#define LDS_WAIT() asm volatile("s_waitcnt lgkmcnt(0)" ::: "memory")
__device__ __forceinline__ unsigned pk2(float lo, float hi) { return (unsigned)f2bf(lo) | ((unsigned)f2bf(hi) << 16); }
__device__ __forceinline__ float wave_sum(float v) {
#pragma unroll
    for (int o = 1; o < 64; o <<= 1) v += __shfl_xor(v, o);
    return v;
}

template <class RowMap>
__device__ __forceinline__ void tr_item(const float* __restrict__ W, int K, int N, bf16_t* __restrict__ WT, LAS float* scr, int item, int lane, const float* __restrict__ kscale, RowMap rm) {
    const int nblk = (N + 31) / 32, kb = item / nblk, nb = item % nblk, k0 = 64 * kb, n0 = 32 * nb;
    const int nn = n0 + (lane & 31);
#pragma unroll 8
    for (int i = 0; i < 32; ++i) { const int kk = 2 * i + (lane >> 5); float v = nn < N ? W[(size_t)(k0 + kk) * N + nn] : 0.f; if (kscale) v *= kscale[k0 + kk]; scr[kk * 33 + (lane & 31)] = v; }
    LDS_WAIT(); asm volatile("" ::: "memory");
    const int c = lane & 7;
#pragma unroll
    for (int j = 0; j < 4; ++j) { const int nl = (lane >> 3) + 8 * j; const int n = n0 + nl;
        if (n < N) { float sc = 1.f; const int r = rm(n, sc); const LAS float* s = scr + (8 * c) * 33 + nl;
            u32x4 o; o.x = pk2(s[0 * 33] * sc, s[1 * 33] * sc); o.y = pk2(s[2 * 33] * sc, s[3 * 33] * sc); o.z = pk2(s[4 * 33] * sc, s[5 * 33] * sc); o.w = pk2(s[6 * 33] * sc, s[7 * 33] * sc);
            *(u32x4*)(WT + (size_t)r * K + k0 + 8 * c) = o; } }
    LDS_WAIT(); asm volatile("" ::: "memory");
}

__device__ __forceinline__ void p0_prep(const MkArgs& a, LAS unsigned char* lds) {
    const int tid = threadIdx.x, lane = tid & 63, wave = __builtin_amdgcn_readfirstlane(tid >> 6);
    const float* c = a.in[1]; const float* w_mod = a.in[2];
    float* MODP = (float*)(a.ws + WS_MODP);
    LAS float* s_c = (LAS float*)lds;
    for (int item = blockIdx.x; item < 256; item += gridDim.x) {
        const int kc = item >> 3, cc = item & 7;
        __syncthreads();
        if (tid < 256) { const int b = tid >> 6, k = tid & 63; s_c[tid] = silu_f(c[b * D + kc * 64 + k]); }
        __syncthreads();
        float acc[4][3];
#pragma unroll
        for (int b = 0; b < 4; ++b)
#pragma unroll
            for (int j = 0; j < 3; ++j) acc[b][j] = 0.f;
        const int col0 = cc * 1536 + tid;
        for (int k = 0; k < 64; ++k) {
            const float* wr = w_mod + (size_t)(kc * 64 + k) * NMOD + col0;
            const float w0 = wr[0], w1 = wr[512], w2 = wr[1024];
#pragma unroll
            for (int b = 0; b < 4; ++b) { const float sv = s_c[b * 64 + k]; acc[b][0] += sv * w0; acc[b][1] += sv * w1; acc[b][2] += sv * w2; }
        }
#pragma unroll
        for (int b = 0; b < 4; ++b)
#pragma unroll
            for (int j = 0; j < 3; ++j) MODP[(size_t)(kc * 4 + b) * NMOD + col0 + 512 * j] = acc[b][j];
    }
    __syncthreads();
    LAS float* scr = (LAS float*)(lds + wave * 16384);
    const int gw = blockIdx.x * 8 + wave, NGW = gridDim.x * 8;
    constexpr int I_IN = 32 * 123, I_QUP = 8 * 64, I_OUT = 32 * 64;
    bf16_t* Wt_in = (bf16_t*)(a.ws + WS_WTIN); bf16_t* Wt_qup = (bf16_t*)(a.ws + WS_WTQUP); bf16_t* Wt_out = (bf16_t*)(a.ws + WS_WTOUT);
    for (int it = gw; it < I_IN + I_QUP + I_OUT; it += NGW) {
        int r = it;
        if (r < I_IN) { tr_item(a.in[5], D, DIN, Wt_in, scr, r, lane, (const float*)nullptr, [](int n, float& sc) { if (n >= 832 && n < 848) sc = 0.25f; else if (n >= 848 && n < 1872) sc = 0.08838834764831845f; return n < 848 ? n : n + 176; }); continue; }
        r -= I_IN;
        if (r < I_QUP) { tr_item(a.in[7], 512, 2048, Wt_qup, scr, r, lane, a.in[6], [](int n, float& sc) { if (n >= 1024) sc = 0.125f; return n; }); continue; }
        r -= I_QUP;
        tr_item(a.in[13], D, D, Wt_out, scr, r, lane, (const float*)nullptr, [](int n, float& sc) { return n; });
    }
    {
        bf16_t* Wt_gu = (bf16_t*)(a.ws + WS_WTGU); bf16_t* Wt_dn = (bf16_t*)(a.ws + WS_WTDN);
        for (int it = gw; it < 32 * 1536; it += NGW) {
            const int e = it / 1536; int r = it % 1536;
            if (r < 512) { tr_item(a.in[17] + (size_t)e * D * 512, D, 512, Wt_gu + (size_t)e * 1024 * D, scr, r, lane, (const float*)nullptr, [](int n, float& sc) { return 8 * (n >> 2) + (n & 3); }); continue; }
            r -= 512;
            if (r < 512) { tr_item(a.in[18] + (size_t)e * D * 512, D, 512, Wt_gu + (size_t)e * 1024 * D, scr, r, lane, (const float*)nullptr, [](int n, float& sc) { return 8 * (n >> 2) + 4 + (n & 3); }); continue; }
            r -= 512;
            tr_item(a.in[19] + (size_t)e * 512 * D, 512, D, Wt_dn + (size_t)e * D * 512, scr, r, lane, (const float*)nullptr, [](int n, float& sc) { return n; });
        }
        bf16_t* RT = (bf16_t*)(a.ws + WS_RT); const float* rg = a.in[15]; const float* re = a.in[16];
        for (int i = blockIdx.x * MK_THREADS + tid; i < 48 * D; i += gridDim.x * MK_THREADS) { const int o = i >> 11, k = i & 2047; RT[i] = f2bf(o < 4 ? rg[k * 4 + o] : (o < 36 ? re[k * 32 + (o - 4)] : 0.f)); }
    }
    u32x4* z = (u32x4*)(Wt_in + (size_t)848 * D);
    for (int i = blockIdx.x * MK_THREADS + tid; i < 176 * 256; i += gridDim.x * MK_THREADS) z[i] = (u32x4){0u, 0u, 0u, 0u};
}

__device__ __forceinline__ void p1_xn(const MkArgs& a, LAS unsigned char* lds) {
    const int tid = threadIdx.x, lane = tid & 63, wave = __builtin_amdgcn_readfirstlane(tid >> 6);
    const float* x = a.in[0]; const float* b_mod = a.in[3]; const float* ln1_g = a.in[4];
    const float* MODP = (const float*)(a.ws + WS_MODP); float* MOD = (float*)(a.ws + WS_MOD); bf16_t* XN = (bf16_t*)(a.ws + WS_XN);
    LAS float* s_gs = (LAS float*)lds; LAS float* s_sh = s_gs + D;
    for (int i = blockIdx.x * MK_THREADS + tid; i < NB * NMOD; i += gridDim.x * MK_THREADS) {
        const int b = i / NMOD, n = i % NMOD; float s = b_mod[n];
        for (int kc = 0; kc < 32; ++kc) s += MODP[(size_t)(kc * 4 + b) * NMOD + n];
        MOD[i] = s;
    }
    for (int chunk = blockIdx.x; chunk < M / 64; chunk += gridDim.x) {
        const int b = chunk >> 6;
        __syncthreads();
        for (int k = tid; k < D; k += MK_THREADS) {
            float sh = b_mod[k], sc = b_mod[D + k];
            for (int kc = 0; kc < 32; ++kc) { sh += MODP[(size_t)(kc * 4 + b) * NMOD + k]; sc += MODP[(size_t)(kc * 4 + b) * NMOD + D + k]; }
            s_sh[k] = sh; s_gs[k] = ln1_g[k] * (1.f + sc);
        }
        __syncthreads();
        for (int r = wave; r < 64; r += 8) {
            const int m = chunk * 64 + r;
            const f32x4* xr = (const f32x4*)(x + (size_t)m * D) + lane;
            f32x4 v[8]; float ss = 0.f;
#pragma unroll
            for (int j = 0; j < 8; ++j) { v[j] = xr[64 * j]; ss += (v[j].x * v[j].x + v[j].y * v[j].y) + (v[j].z * v[j].z + v[j].w * v[j].w); }
            const float rstd = rsqrtf(wave_sum(ss) * (1.f / D) + EPS);
            u32x2* o8 = (u32x2*)(XN + (size_t)m * D) + lane;
#pragma unroll
            for (int j = 0; j < 8; ++j) { const int k = 4 * (lane + 64 * j); const f32x4 gs = *(const LAS f32x4*)(s_gs + k), sh = *(const LAS f32x4*)(s_sh + k);
                const f32x4 y = v[j] * rstd * gs + sh; u32x2 w; w.x = pk2(y.x, y.y); w.y = pk2(y.z, y.w); o8[64 * j] = w; }
        }
    }
}

struct EpiInProj {
    static constexpr bool PERM = true;
    bf16_t* B0; bf16_t* QB; bf16_t* KB; bf16_t* VB; float* SSQ;
    __device__ __forceinline__ void operator()(const pg8::f32x4 (&acc)[2][2][4][2], const pg8::Unit& u, int wr, int wc, int fr, int fq) const {
        const int t = u.pn >> 2; bf16_t* base = t == 0 ? B0 : (t == 1 ? QB : (t == 2 ? KB : VB));
        const int row0 = u.pm * 256 + wr * 64 + fr, col0 = (u.pn & 3) * 256 + wc * 32 + 8 * fq;
#pragma unroll
        for (int ai = 0; ai < 2; ++ai)
#pragma unroll
            for (int m = 0; m < 4; ++m) { const int row = row0 + ai * 128 + m * 16; bf16_t* rowp = base + (size_t)row * 1024 + col0; float ss = 0.f;
#pragma unroll
                for (int bj = 0; bj < 2; ++bj) { const pg8::f32x4 v0 = acc[ai][bj][m][0], v1 = acc[ai][bj][m][1];
                    ss += (v0[0] * v0[0] + v0[1] * v0[1]) + (v0[2] * v0[2] + v0[3] * v0[3]) + (v1[0] * v1[0] + v1[1] * v1[1]) + (v1[2] * v1[2] + v1[3] * v1[3]);
                    pg8::u32x4 w; w.x = pg8::cvt_pk_bf16(v0[0], v0[1]); w.y = pg8::cvt_pk_bf16(v0[2], v0[3]); w.z = pg8::cvt_pk_bf16(v1[0], v1[1]); w.w = pg8::cvt_pk_bf16(v1[2], v1[3]);
                    *(pg8::u32x4*)(rowp + bj * 128) = w; }
                if (u.pn < 2) { ss += __shfl_xor(ss, 16); ss += __shfl_xor(ss, 32); if (fq == 0) SSQ[(size_t)row * 8 + u.pn * 4 + wc] = ss; } }
    }
};


struct EpiQupG {
    static constexpr bool PERM = true;
    const float* SSQ; bf16_t* QA; bf16_t* QI;
    __device__ __forceinline__ void operator()(const pg8::f32x4 (&acc)[2][2][4][2], const pg8::Unit& u, int wr, int wc, int fr, int fq) const {
        bf16_t* base = (u.pn >> 2) ? QI : QA;
        const int row0 = u.pm * 256 + wr * 64 + fr, col0 = (u.pn & 3) * 256 + wc * 32 + 8 * fq;
#pragma unroll
        for (int ai = 0; ai < 2; ++ai)
#pragma unroll
            for (int m = 0; m < 4; ++m) { const int row = row0 + ai * 128 + m * 16; bf16_t* rowp = base + (size_t)row * 1024 + col0;
                const pg8::f32x4 s0 = *(const pg8::f32x4*)(SSQ + (size_t)row * 8), s1 = *(const pg8::f32x4*)(SSQ + (size_t)row * 8 + 4);
                const float rs = rsqrtf(((s0[0] + s0[1]) + (s0[2] + s0[3]) + (s1[0] + s1[1]) + (s1[2] + s1[3])) * (1.f / 512.f) + EPS);
#pragma unroll
                for (int bj = 0; bj < 2; ++bj) { const pg8::f32x4 v0 = acc[ai][bj][m][0] * rs, v1 = acc[ai][bj][m][1] * rs;
                    pg8::u32x4 w; w.x = pg8::cvt_pk_bf16(v0[0], v0[1]); w.y = pg8::cvt_pk_bf16(v0[2], v0[3]); w.z = pg8::cvt_pk_bf16(v1[0], v1[1]); w.w = pg8::cvt_pk_bf16(v1[2], v1[3]);
                    *(pg8::u32x4*)(rowp + bj * 128) = w; } }
    }
};
struct EpiOutProj {
    static constexpr bool PERM = true;
    const float* x; const float* MOD; float* out;
    __device__ __forceinline__ void operator()(const pg8::f32x4 (&acc)[2][2][4][2], const pg8::Unit& u, int wr, int wc, int fr, int fq) const {
        const int b = (u.pm * 256) >> 12;
        const int row0 = u.pm * 256 + wr * 64 + fr, col0 = u.pn * 256 + wc * 32 + 8 * fq;
        const float* gp = MOD + (size_t)b * NMOD + 2 * D + col0;
        pg8::f32x4 g[2][2];
#pragma unroll
        for (int bj = 0; bj < 2; ++bj) { g[bj][0] = *(const pg8::f32x4*)(gp + bj * 128); g[bj][1] = *(const pg8::f32x4*)(gp + bj * 128 + 4); }
#pragma unroll
        for (int ai = 0; ai < 2; ++ai)
#pragma unroll
            for (int m = 0; m < 4; ++m) { const size_t off = (size_t)(row0 + ai * 128 + m * 16) * D + col0;
#pragma unroll
                for (int bj = 0; bj < 2; ++bj) { const pg8::f32x4 x0 = *(const pg8::f32x4*)(x + off + bj * 128), x1 = *(const pg8::f32x4*)(x + off + bj * 128 + 4);
                    *(pg8::f32x4*)(out + off + bj * 128) = x0 + g[bj][0] * acc[ai][bj][m][0]; *(pg8::f32x4*)(out + off + bj * 128 + 4) = x1 + g[bj][1] * acc[ai][bj][m][1]; } }
    }
};
__device__ __forceinline__ void kanorm_pass(const MkArgs& a) {
    const int tid = threadIdx.x, lane = tid & 63, wave = __builtin_amdgcn_readfirstlane(tid >> 6);
    bf16_t* B0 = (bf16_t*)(a.ws + WS_B0); const float* k_gain = a.in[9];
    const float g0 = k_gain[2 * lane], g1 = k_gain[2 * lane + 1];
    for (int m = blockIdx.x * 8 + wave; m < M; m += gridDim.x * 8) {
        unsigned* p = (unsigned*)(B0 + (size_t)m * 1024 + 512) + lane;
        const unsigned v = *p; const float k0 = __uint_as_float(v << 16), k1 = __uint_as_float(v & 0xffff0000u);
        const float rs = rsqrtf(wave_sum(k0 * k0 + k1 * k1) * (1.f / 128.f) + EPS);
        *p = pk2(k0 * rs * g0, k1 * rs * g1);
    }
}

typedef short bf16x8_t __attribute__((ext_vector_type(8)));
__device__ __forceinline__ void p8_route(const MkArgs& a, LAS unsigned char* lds) {
    const int tid = threadIdx.x, lane = tid & 63, wave = __builtin_amdgcn_readfirstlane(tid >> 6);
    const float* x1 = a.out; const float* ln2_g = a.in[14]; const float* MOD = (const float*)(a.ws + WS_MOD);
    bf16_t* H2 = (bf16_t*)(a.ws + WS_XN); const bf16_t* RT = (const bf16_t*)(a.ws + WS_RT);
    int* EID = (int*)(a.ws + WS_EID); float* GW = (float*)(a.ws + WS_GW);
    unsigned* cnt = (unsigned*)(a.ws + WS_CTL) + CW_CNT; int* list = (int*)(a.ws + WS_LIST);
    constexpr int RS = 4112;
    LAS float* s_part = (LAS float*)lds;
    LAS float* s_lg = (LAS float*)(lds + 49152);
    for (int item = blockIdx.x; item < M / 32; item += gridDim.x) {
        const int m0 = item * 32, b = m0 >> 12;
        const float* mb = MOD + (size_t)b * NMOD;
        __syncthreads();
        for (int rr = 0; rr < 4; ++rr) {
            const int r = wave * 4 + rr, m = m0 + r;
            const f32x4* xr = (const f32x4*)(x1 + (size_t)m * D) + lane;
            f32x4 v[8]; float ss = 0.f;
#pragma unroll
            for (int j = 0; j < 8; ++j) { v[j] = xr[64 * j]; ss += (v[j].x * v[j].x + v[j].y * v[j].y) + (v[j].z * v[j].z + v[j].w * v[j].w); }
            const float rstd = rsqrtf(wave_sum(ss) * (1.f / D) + EPS);
            u32x2* o8 = (u32x2*)(H2 + (size_t)m * D) + lane;
#pragma unroll
            for (int j = 0; j < 8; ++j) { const int k = 4 * (lane + 64 * j);
                const f32x4 g = *(const f32x4*)(ln2_g + k), sc = *(const f32x4*)(mb + 4 * D + k), sh = *(const f32x4*)(mb + 3 * D + k);
                const f32x4 y = v[j] * rstd * g * (sc + 1.f) + sh; u32x2 w; w.x = pk2(y.x, y.y); w.y = pk2(y.z, y.w); o8[64 * j] = w;
                *(LAS u32x2*)(lds + r * RS + k * 2) = w; }
        }
        __syncthreads();
        f32x4 acc[2][3];
#pragma unroll
        for (int rt = 0; rt < 2; ++rt)
#pragma unroll
            for (int ct = 0; ct < 3; ++ct) acc[rt][ct] = (f32x4){0.f, 0.f, 0.f, 0.f};
        const int fr = lane & 15, fq = lane >> 4;
#pragma unroll 2
        for (int kk = 0; kk < 8; ++kk) {
            const int k0 = 32 * (wave * 8 + kk) + 8 * fq;
            bf16x8_t af[2], bfr[3];
#pragma unroll
            for (int rt = 0; rt < 2; ++rt) af[rt] = *(const LAS bf16x8_t*)(lds + (16 * rt + fr) * RS + k0 * 2);
#pragma unroll
            for (int ct = 0; ct < 3; ++ct) bfr[ct] = *(const bf16x8_t*)(RT + (size_t)(16 * ct + fr) * D + k0);
#pragma unroll
            for (int rt = 0; rt < 2; ++rt)
#pragma unroll
                for (int ct = 0; ct < 3; ++ct) acc[rt][ct] = __builtin_amdgcn_mfma_f32_16x16x32_bf16(af[rt], bfr[ct], acc[rt][ct], 0, 0, 0);
        }
        __syncthreads();
#pragma unroll
        for (int rt = 0; rt < 2; ++rt)
#pragma unroll
            for (int ct = 0; ct < 3; ++ct)
#pragma unroll
                for (int i = 0; i < 4; ++i) s_part[(wave * 32 + 16 * rt + 4 * fq + i) * 48 + 16 * ct + fr] = acc[rt][ct][i];
        __syncthreads();
        for (int i = tid; i < 32 * 36; i += MK_THREADS) { const int r = i / 36, o = i % 36; float s = 0.f;
#pragma unroll
            for (int w = 0; w < 8; ++w) s += s_part[(w * 32 + r) * 48 + o];
            s_lg[i] = s; }
        __syncthreads();
        if (tid < 32) {
            const LAS float* lg = s_lg + tid * 36; const int m = m0 + tid;
            int gi = 0; float gm = lg[0];
            for (int i = 1; i < 4; ++i) if (lg[i] > gm) { gm = lg[i]; gi = i; }
            float gs = 0.f;
            for (int i = 0; i < 4; ++i) gs += __expf(lg[i] - gm);
            const float gw = 1.f / gs;
            const LAS float* le = lg + 4 + gi * 8;
            float em = le[0];
            for (int i = 1; i < 8; ++i) em = fmaxf(em, le[i]);
            float es = 0.f;
            for (int i = 0; i < 8; ++i) es += __expf(le[i] - em);
            int i0 = 0; float p0 = -1.f;
            for (int i = 0; i < 8; ++i) { const float p = __expf(le[i] - em) / es; if (p > p0) { p0 = p; i0 = i; } }
            int i1 = 0; float p1 = -1.f;
            for (int i = 0; i < 8; ++i) { const float p = __expf(le[i] - em) / es; if (i != i0 && p > p1) { p1 = p; i1 = i; } }
            const float den = p0 + p1;
            const int e0 = gi * 8 + i0, e1 = gi * 8 + i1;
            EID[m * 2] = e0; EID[m * 2 + 1] = e1; GW[m * 2] = gw * p0 / den; GW[m * 2 + 1] = gw * p1 / den;
            const unsigned q0 = __hip_atomic_fetch_add(cnt + e0, 1u, __ATOMIC_RELAXED, __HIP_MEMORY_SCOPE_AGENT);
            const unsigned q1 = __hip_atomic_fetch_add(cnt + 32 + e1, 1u, __ATOMIC_RELAXED, __HIP_MEMORY_SCOPE_AGENT);
            list[(size_t)e0 * 16384 + q0] = m; list[(size_t)(32 + e1) * 16384 + q1] = m;
        }
    }
}

__device__ __forceinline__ int rfl(int v) { return __builtin_amdgcn_readfirstlane(v); }
struct MoeTab { LAS int* tsm; LAS int* c0; LAS int* c1; LAS int* ts0; LAS int* ts1; };
__device__ __forceinline__ MoeTab moe_tab_build(const MkArgs& a, LAS unsigned char* lds) {
    MoeTab t; LAS int* p = (LAS int*)(lds + MK_MOE_OFF); t.tsm = p; t.c0 = p + 40; t.c1 = p + 80; t.ts0 = p + 120; t.ts1 = p + 160;
    const unsigned* cnt = (const unsigned*)(a.ws + WS_CTL) + CW_CNT;
    __syncthreads();
    if (threadIdx.x == 0) {
        int am = 0, a0 = 0, a1 = 0;
        for (int e = 0; e < 32; ++e) { const int n0 = (int)__hip_atomic_load(cnt + e, __ATOMIC_RELAXED, __HIP_MEMORY_SCOPE_AGENT), n1 = (int)__hip_atomic_load(cnt + 32 + e, __ATOMIC_RELAXED, __HIP_MEMORY_SCOPE_AGENT);
            t.c0[e] = n0; t.c1[e] = n1; t.tsm[e] = am; t.ts0[e] = a0; t.ts1[e] = a1; am += (n0 + n1 + 255) >> 8; a0 += (n0 + 255) >> 8; a1 += (n1 + 255) >> 8; }
        t.tsm[32] = am; t.ts0[32] = a0; t.ts1[32] = a1;
    }
    __syncthreads();
    return t;
}
struct SchedGU {
    MoeTab t; const int* list; const char* H2; const char* Wt; int G, c, nunit; int R[2], C[2];
    __device__ void init(const MoeTab& t_, const MkArgs& a, int G_, int c_) { t = t_; list = (const int*)(a.ws + WS_LIST); H2 = (const char*)(a.ws + WS_XN); Wt = (const char*)(a.ws + WS_WTGU); G = G_; c = c_; nunit = rfl(t.tsm[32]) * 4;
#pragma unroll
        for (int i = 0; i < 2; ++i) pg8::stage_rc((int)threadIdx.x * 16 + i * 8192, R[i], C[i]); }
    __device__ bool next(int i, pg8::Unit& u) const {
        const int L = i * G + c; if (L >= nunit) return false;
        const int mt = L >> 2, pn = L & 3; int e = 0;
        for (int j = 1; j < 32; ++j) e += (mt >= t.tsm[j]) ? 1 : 0;
        e = rfl(e);
        u.pm = mt; u.pn = pn; u.aux = e; u.a = H2; u.b = Wt + ((size_t)(e * 1024 + pn * 256) * D) * 2;
        const int n0 = rfl(t.c0[e]), n1 = rfl(t.c1[e]), rb = (mt - rfl(t.tsm[e])) * 256;
#pragma unroll
        for (int h = 0; h < 2; ++h)
#pragma unroll
            for (int j = 0; j < 2; ++j) { const int r = rb + h * 128 + R[j]; int tok = 0;
                if (r < n0) tok = list[(size_t)e * 16384 + r]; else if (r - n0 < n1) tok = list[(size_t)(32 + e) * 16384 + (r - n0)];
                u.va[h][j] = (unsigned)(tok * D + C[j]) * 2u; }
        return true;
    }
};
struct EpiGU {
    static constexpr bool PERM = true;
    bf16_t* U;
    __device__ __forceinline__ void operator()(const pg8::f32x4 (&acc)[2][2][4][2], const pg8::Unit& u, int wr, int wc, int fr, int fq) const {
        const int row0 = u.pm * 256 + wr * 64 + fr, j0 = u.pn * 128 + wc * 16 + 4 * fq;
#pragma unroll
        for (int ai = 0; ai < 2; ++ai)
#pragma unroll
            for (int m = 0; m < 4; ++m) { bf16_t* rowp = U + (size_t)(row0 + ai * 128 + m * 16) * 512 + j0;
#pragma unroll
                for (int bj = 0; bj < 2; ++bj) { const pg8::f32x4 gv = acc[ai][bj][m][0], uv = acc[ai][bj][m][1]; float o[4];
#pragma unroll
                    for (int i = 0; i < 4; ++i) o[i] = gv[i] / (1.f + __expf(-gv[i])) * uv[i];
                    u32x2 w; w.x = pg8::cvt_pk_bf16(o[0], o[1]); w.y = pg8::cvt_pk_bf16(o[2], o[3]); *(u32x2*)(rowp + bj * 64) = w; } }
    }
};
struct SchedDN {
    MoeTab t; int slot; const char* U; const char* Wt; int G, c, nunit; unsigned vb[2][2];
    __device__ void init(const MoeTab& t_, const MkArgs& a, int slot_, int G_, int c_) { t = t_; slot = slot_; U = (const char*)(a.ws + WS_U); Wt = (const char*)(a.ws + WS_WTDN); G = G_; c = c_; nunit = rfl(slot ? t.ts1[32] : t.ts0[32]) * 8;
#pragma unroll
        for (int i = 0; i < 2; ++i) { int R, C; pg8::stage_rc((int)threadIdx.x * 16 + i * 8192, R, C); vb[0][i] = (unsigned)(R * 512 + C) * 2u; vb[1][i] = (unsigned)((128 + R) * 512 + C) * 2u; } }
    __device__ bool next(int i, pg8::Unit& u) const {
        const int L = i * G + c; if (L >= nunit) return false;
        const int tl = L >> 3, pn = L & 7; const LAS int* ts = slot ? t.ts1 : t.ts0; int e = 0;
        for (int j = 1; j < 32; ++j) e += (tl >= ts[j]) ? 1 : 0;
        e = rfl(e);
        const int lt = tl - rfl(ts[e]);
        u.pm = lt; u.pn = pn; u.aux = e;
        u.a = U + ((size_t)(rfl(t.tsm[e]) * 256 + (slot ? rfl(t.c0[e]) : 0) + lt * 256) * 512) * 2; u.b = Wt + ((size_t)(e * D + pn * 256) * 512) * 2;
        u.va[0][0] = vb[0][0]; u.va[0][1] = vb[0][1]; u.va[1][0] = vb[1][0]; u.va[1][1] = vb[1][1];
        return true;
    }
};
struct EpiDown {
    static constexpr bool PERM = true;
    MoeTab t; int slot; const int* list; const float* GW; const float* MOD; float* out;
    __device__ __forceinline__ void operator()(const pg8::f32x4 (&acc)[2][2][4][2], const pg8::Unit& u, int wr, int wc, int fr, int fq) const {
        const int e = u.aux, nv = rfl(slot ? t.c1[e] : t.c0[e]) - u.pm * 256;
        const int* lp = list + (size_t)(slot * 32 + e) * 16384 + u.pm * 256;
        const int col0 = u.pn * 256 + wc * 32 + 8 * fq;
#pragma unroll
        for (int ai = 0; ai < 2; ++ai)
#pragma unroll
            for (int m = 0; m < 4; ++m) { const int r = ai * 128 + wr * 64 + m * 16 + fr;
                if (r < nv) { const int tok = lp[r]; const float gw = GW[tok * 2 + slot]; const float* gp = MOD + (size_t)(tok >> 12) * NMOD + 5 * D + col0; float* op = out + (size_t)tok * D + col0;
#pragma unroll
                    for (int bj = 0; bj < 2; ++bj)
#pragma unroll
                        for (int n = 0; n < 2; ++n) { const pg8::f32x4 g0 = *(const pg8::f32x4*)(gp + bj * 128 + 4 * n); pg8::f32x4 o0 = *(pg8::f32x4*)(op + bj * 128 + 4 * n);
                            o0 += g0 * gw * acc[ai][bj][m][n]; *(pg8::f32x4*)(op + bj * 128 + 4 * n) = o0; } }
                asm volatile("" ::: "memory"); }
    }
};

typedef float f32x16 __attribute__((ext_vector_type(16)));
typedef short s16x4 __attribute__((ext_vector_type(4)));
__device__ __forceinline__ s16x4 tr_read(unsigned lds_addr) { s16x4 r; asm volatile("ds_read_b64_tr_b16 %0, %1\n\ts_waitcnt lgkmcnt(0)" : "=&v"(r) : "v"(lds_addr) : "memory"); return r; }
__device__ __forceinline__ unsigned off_b(unsigned row, unsigned ch) { return 256u * row + 16u * (ch ^ (((row & 3) << 2) | ((row >> 2) & 3))); }
__device__ __forceinline__ int crow(int reg, int h) { return (reg & 3) + 8 * (reg >> 2) + 4 * h; }
constexpr float SB_STOP = -104.0f;

__device__ __forceinline__ void sb_wave(const bf16_t* __restrict__ QB, const bf16_t* __restrict__ KB, const bf16_t* __restrict__ VB, int b, int h, int q0, LAS unsigned char* vt, f32x16 (&o)[4]) {
    const int lane = threadIdx.x & 63, r32 = lane & 31, hi = lane >> 5;
    bf16x8_t bq[8];
    { const bf16_t* qp = QB + (size_t)(b * S + q0 + r32) * 1024 + h * 128 + 64 * hi;
#pragma unroll
      for (int s = 0; s < 8; ++s) bq[s] = *(const bf16x8_t*)(qp + 8 * s); }
#pragma unroll
    for (int c = 0; c < 4; ++c)
#pragma unroll
        for (int i = 0; i < 16; ++i) o[c][i] = 0.f;
    float carry = 0.f;
    const unsigned vbase = (unsigned)(uintptr_t)vt;
    const int q16 = lane & 15, tq = q16 >> 2, tp = q16 & 3, blk = (lane >> 4) & 1;
    for (int kt = q0 >> 5; kt >= 0; --kt) {
        const int k0 = kt * 32;
        { const bf16_t* vp = VB + (size_t)(b * S + k0) * 1024 + h * 128;
#pragma unroll
          for (int i = 0; i < 8; ++i) { const int n = lane + 64 * i, row = n >> 4, ch = n & 15; const u32x4 v = *(const u32x4*)(vp + (size_t)row * 1024 + 8 * ch); *(LAS u32x4*)(vt + off_b(row, ch)) = v; } }
        f32x16 z;
#pragma unroll
        for (int i = 0; i < 16; ++i) z[i] = 0.f;
        { const bf16_t* kp = KB + (size_t)(b * S + k0 + r32) * 1024 + h * 128 + 64 * hi;
#pragma unroll
          for (int s = 0; s < 8; ++s) { const bf16x8_t kf = *(const bf16x8_t*)(kp + 8 * s); z = __builtin_amdgcn_mfma_f32_32x32x16_bf16(kf, bq[s], z, 0, 0, 0); } }
        const bool diag = (k0 == q0);
        float lm[16], sg[4];
#pragma unroll
        for (int g = 0; g < 4; ++g) sg[g] = 0.f;
#pragma unroll
        for (int i = 0; i < 16; ++i) { const float zz = z[i]; const float sp = fmaxf(zz, 0.f) + __logf(1.f + __expf(-fabsf(zz)));
            const bool valid = !diag || (crow(i, hi) < r32);
            lm[i] = valid ? -sp : 0.f; z[i] = valid ? (zz - sp) : -INFINITY; sg[i >> 2] += lm[i]; }
        float psg[4];
#pragma unroll
        for (int g = 0; g < 4; ++g) psg[g] = __shfl_xor(sg[g], 32);
        float aft[4];
        { float run = carry;
#pragma unroll
          for (int g = 3; g >= 0; --g) { if (hi == 0) { run += psg[g]; aft[g] = run; run += sg[g]; } else { aft[g] = run; run += sg[g]; run += psg[g]; } }
          carry = run; }
        float av[16];
#pragma unroll
        for (int g = 0; g < 4; ++g) { float run = aft[g];
#pragma unroll
            for (int r = 3; r >= 0; --r) { const int i = 4 * g + r; av[i] = __expf(z[i] + run); run += lm[i]; } }
        bf16x8_t pa[2];
#pragma unroll
        for (int s = 0; s < 2; ++s) { u32x4 p; p.x = pg8::cvt_pk_bf16(av[8 * s], av[8 * s + 1]); p.y = pg8::cvt_pk_bf16(av[8 * s + 2], av[8 * s + 3]); p.z = pg8::cvt_pk_bf16(av[8 * s + 4], av[8 * s + 5]); p.w = pg8::cvt_pk_bf16(av[8 * s + 6], av[8 * s + 7]); pa[s] = __builtin_bit_cast(bf16x8_t, p); }
        LDS_WAIT();
#pragma unroll
        for (int c = 0; c < 4; ++c)
#pragma unroll
            for (int s = 0; s < 2; ++s) {
                const unsigned rb0 = 16 * s + 4 * hi, rb1 = rb0 + 8;
                const s16x4 lo = tr_read(vbase + off_b(rb0 + tq, 4 * c + 2 * blk + (tp >> 1)) + 8 * (tp & 1));
                const s16x4 hv = tr_read(vbase + off_b(rb1 + tq, 4 * c + 2 * blk + (tp >> 1)) + 8 * (tp & 1));
                const bf16x8_t vf = __builtin_shufflevector(lo, hv, 0, 1, 2, 3, 4, 5, 6, 7);
                o[c] = __builtin_amdgcn_mfma_f32_32x32x16_bf16(vf, pa[s], o[c], 0, 0, 0);
            }
        if (__all(carry <= SB_STOP)) break;
    }
}
__device__ __forceinline__ void p6_sb(const MkArgs& a, LAS unsigned char* lds) {
    const int tid = threadIdx.x, lane = tid & 63, wave = __builtin_amdgcn_readfirstlane(tid >> 6), r32 = lane & 31, hi = lane >> 5;
    const bf16_t* QB = (const bf16_t*)(a.ws + WS_QB); const bf16_t* KB = (const bf16_t*)(a.ws + WS_KB); const bf16_t* VB = (const bf16_t*)(a.ws + WS_VB);
    bf16_t* O = (bf16_t*)(a.ws + WS_O); const float* gn_b = a.in[12];
    LAS float* s_ss = (LAS float*)(lds + 65536);
    for (int item = blockIdx.x; item < M / 32; item += gridDim.x) {
        const int b = item >> 7, q0 = (item & 127) * 32;
        f32x16 o[4];
        sb_wave(QB, KB, VB, b, wave, q0, lds + wave * 8192, o);
        float ss = 0.f;
#pragma unroll
        for (int c = 0; c < 4; ++c)
#pragma unroll
            for (int i = 0; i < 16; ++i) ss += o[c][i] * o[c][i];
        ss += __shfl_xor(ss, 32);
        __syncthreads();
        if (hi == 0) s_ss[wave * 32 + r32] = ss;
        __syncthreads();
        float tot = 0.f;
#pragma unroll
        for (int w = 0; w < 8; ++w) tot += s_ss[w * 32 + r32];
        const float rstd = rsqrtf(tot * (1.f / 1024.f) + EPS);
        bf16_t* op = O + (size_t)(b * S + q0 + r32) * D + 1024 + wave * 128;
        const float* gp = gn_b + wave * 128;
#pragma unroll
        for (int c = 0; c < 4; ++c)
#pragma unroll
            for (int g = 0; g < 4; ++g) { const int d = 32 * c + 8 * g + 4 * hi; const f32x4 gv = *(const f32x4*)(gp + d);
                u32x2 w; w.x = pk2(o[c][4 * g] * rstd * gv.x, o[c][4 * g + 1] * rstd * gv.y); w.y = pk2(o[c][4 * g + 2] * rstd * gv.z, o[c][4 * g + 3] * rstd * gv.w);
                *(u32x2*)(op + d) = w; }
    }
}

__device__ __forceinline__ void tr_read2(unsigned a0, unsigned a1, s16x4& r0, s16x4& r1) {
    asm volatile("ds_read_b64_tr_b16 %0, %2\n\tds_read_b64_tr_b16 %1, %3\n\ts_waitcnt lgkmcnt(0)" : "=&v"(r0), "=&v"(r1) : "v"(a0), "v"(a1) : "memory"); }
__device__ __forceinline__ int wave_sum_i(int v) {
    v += __builtin_amdgcn_update_dpp(0, v, 0xB1, 0xF, 0xF, true);
    v += __builtin_amdgcn_update_dpp(0, v, 0x4E, 0xF, 0xF, true);
    v += __builtin_amdgcn_update_dpp(0, v, 0x141, 0xF, 0xF, true);
    v += __builtin_amdgcn_update_dpp(0, v, 0x140, 0xF, 0xF, true);
    return __builtin_amdgcn_readlane(v, 0) + __builtin_amdgcn_readlane(v, 16) + __builtin_amdgcn_readlane(v, 32) + __builtin_amdgcn_readlane(v, 48);
}
template <int NR>
__device__ __forceinline__ void topk_row(const float* __restrict__ row, int n, LAS unsigned short* sel, int lane) {
    unsigned key[NR];
#pragma unroll
    for (int i = 0; i < NR; ++i) { const int s = lane + 64 * i; const float v = __hip_atomic_load(row + s, __ATOMIC_RELAXED, __HIP_MEMORY_SCOPE_AGENT); key[i] = s < n ? fkey(v) : 0u; }
    unsigned T = 0u; bool exact = false;
    for (int bit = 31; bit >= 0; --bit) {
        const unsigned cand = T | (1u << bit);
        int c = 0;
#pragma unroll
        for (int i = 0; i < NR; ++i) c += (key[i] >= cand) ? 1 : 0;
        c = wave_sum_i(c);
        if (c >= 256) { T = cand; if (c == 256) { exact = true; break; } }
    }
    const unsigned long long ltm = (1ull << lane) - 1ull;
    if (exact) {
        int base = 0;
#pragma unroll
        for (int i = 0; i < NR; ++i) {
            const bool take = key[i] >= T;
            const unsigned long long mt = __ballot(take);
            if (take) sel[base + __popcll(mt & ltm)] = (unsigned short)(lane + 64 * i);
            base += __popcll(mt);
        }
    } else {
        int cg = 0;
#pragma unroll
        for (int i = 0; i < NR; ++i) cg += (key[i] > T) ? 1 : 0;
        const int need = 256 - wave_sum_i(cg);
        int base = 0, run_eq = 0;
#pragma unroll 1
        for (int i = 0; i < NR; ++i) {
            unsigned k = key[0];
#pragma unroll
            for (int q = 1; q < NR; ++q) k = (i == q) ? key[q] : k;
            const bool gt = k > T, eq = (k == T);
            const unsigned long long meq = __ballot(eq);
            const bool take = gt || (eq && (run_eq + __popcll(meq & ltm)) < need);
            const unsigned long long mt = __ballot(take);
            if (take) sel[base + __popcll(mt & ltm)] = (unsigned short)(lane + 64 * i);
            base += __popcll(mt); run_eq += __popcll(meq);
        }
    }
}
__device__ __forceinline__ void dsa_token(const bf16_t* __restrict__ B0, const bf16_t* __restrict__ QA, const float* __restrict__ q_gain, const float* __restrict__ gn_a, bf16_t* __restrict__ O,
                                          int b, int t, int cnt, const LAS unsigned short* sel, const LAS float* s_bias, LAS unsigned char* vt) {
    int lane = threadIdx.x & 63; asm volatile("" : "+v"(lane));
    const int fr = lane & 15, g = lane >> 4, hd = fr & 7;
    const size_t m = (size_t)b * S + t;
    bf16x8_t bqa[4];
    {
        const bf16_t* qp = QA + m * 1024 + hd * 128 + 32 * g;
        float qf[32]; float ss = 0.f;
#pragma unroll
        for (int kk = 0; kk < 4; ++kk) { const u32x4 v = *(const u32x4*)(qp + 8 * kk);
#pragma unroll
            for (int j = 0; j < 4; ++j) { const unsigned w = v[j]; qf[8 * kk + 2 * j] = __uint_as_float(w << 16); qf[8 * kk + 2 * j + 1] = __uint_as_float(w & 0xffff0000u); } }
#pragma unroll
        for (int j = 0; j < 32; ++j) ss += qf[j] * qf[j];
        ss += __shfl_xor(ss, 16); ss += __shfl_xor(ss, 32);
        const float rs = (fr < 8) ? rsqrtf(ss * (1.f / 128.f) + EPS) * 0.08838834764831845f : 0.f;
        const float* gp = q_gain + 32 * g;
#pragma unroll
        for (int kk = 0; kk < 4; ++kk) { u32x4 p;
#pragma unroll
            for (int j = 0; j < 4; ++j) p[j] = pg8::cvt_pk_bf16(qf[8 * kk + 2 * j] * rs * gp[8 * kk + 2 * j], qf[8 * kk + 2 * j + 1] * rs * gp[8 * kk + 2 * j + 1]);
            bqa[kk] = __builtin_bit_cast(bf16x8_t, p); }
    }
    f32x4 lg[16];
    const bf16_t* kbase = B0 + (size_t)b * S * 1024 + 512 + 32 * g;
#pragma unroll
    for (int i = 0; i < 16; ++i) {
        const int s = sel[16 * i + fr];
        const bf16_t* kp = kbase + (size_t)s * 1024;
        f32x4 acc = (f32x4){0.f, 0.f, 0.f, 0.f};
#pragma unroll
        for (int kk = 0; kk < 4; ++kk) { const bf16x8_t ka = *(const bf16x8_t*)(kp + 8 * kk); acc = __builtin_amdgcn_mfma_f32_16x16x32_bf16(ka, bqa[kk], acc, 0, 0, 0); }
        lg[i] = acc;
        if ((i & 3) == 3) asm volatile("" ::: "memory");
    }
    float mx = -INFINITY;
#pragma unroll
    for (int i = 0; i < 16; ++i) {
        const u32x2 sv = *(const LAS u32x2*)(sel + 16 * i + 4 * g);
#pragma unroll
        for (int r = 0; r < 4; ++r) { const int j = 16 * i + 4 * g + r; const int sj = (int)((r & 1) ? (sv[r >> 1] >> 16) : (sv[r >> 1] & 0xffffu));
            int d = t - sj; d = d < 0 ? 0 : (d > 127 ? 127 : d);
            const float v = (j < cnt) ? lg[i][r] + s_bias[d * 8 + hd] : -INFINITY; lg[i][r] = v; mx = fmaxf(mx, v); }
    }
    mx = fmaxf(mx, __shfl_xor(mx, 16)); mx = fmaxf(mx, __shfl_xor(mx, 32));
    float sm = 0.f;
#pragma unroll
    for (int i = 0; i < 16; ++i)
#pragma unroll
        for (int r = 0; r < 4; ++r) { const float p = __expf(lg[i][r] - mx); lg[i][r] = p; sm += p; }
    sm += __shfl_xor(sm, 16); sm += __shfl_xor(sm, 32);
    const float inv = 1.f / sm;
    bf16x8_t pa[8];
#pragma unroll
    for (int ks = 0; ks < 8; ++ks) { u32x4 p; const f32x4 p0 = lg[2 * ks], p1 = lg[2 * ks + 1];
        p.x = pg8::cvt_pk_bf16(p0[0], p0[1]); p.y = pg8::cvt_pk_bf16(p0[2], p0[3]); p.z = pg8::cvt_pk_bf16(p1[0], p1[1]); p.w = pg8::cvt_pk_bf16(p1[2], p1[3]);
        pa[ks] = __builtin_bit_cast(bf16x8_t, p); }
    f32x4 out[8];
#pragma unroll
    for (int c = 0; c < 8; ++c) out[c] = (f32x4){0.f, 0.f, 0.f, 0.f};
    const unsigned vbase = (unsigned)(uintptr_t)vt;
    const int tq = fr >> 2, tp = fr & 3;
    const bf16_t* vb0 = B0 + (size_t)b * S * 1024 + 640;
#pragma unroll
    for (int ks = 0; ks < 8; ++ks) {
#pragma unroll
        for (int i = 0; i < 8; ++i) { const int n = lane + 64 * i, row = n >> 4, ch = n & 15; const int s = sel[32 * ks + row];
            const u32x4 v = *(const u32x4*)(vb0 + (size_t)s * 1024 + 8 * ch); *(LAS u32x4*)(vt + off_b(row, ch)) = v; }
        LDS_WAIT();
#pragma unroll
        for (int c = 0; c < 8; ++c) {
            s16x4 lo, hv;
            tr_read2(vbase + off_b(4 * g + tq, 2 * c + (tp >> 1)) + 8 * (tp & 1), vbase + off_b(16 + 4 * g + tq, 2 * c + (tp >> 1)) + 8 * (tp & 1), lo, hv);
            const bf16x8_t vf = __builtin_shufflevector(lo, hv, 0, 1, 2, 3, 4, 5, 6, 7);
            out[c] = __builtin_amdgcn_mfma_f32_16x16x32_bf16(pa[ks], vf, out[c], 0, 0, 0);
        }
        asm volatile("" ::: "memory");
    }
    float invh[4];
#pragma unroll
    for (int r = 0; r < 4; ++r) invh[r] = __shfl(inv, 4 * (g & 1) + r);
    float ss = 0.f;
#pragma unroll
    for (int c = 0; c < 8; ++c)
#pragma unroll
        for (int r = 0; r < 4; ++r) { const float v = out[c][r] * invh[r]; out[c][r] = v; ss += (g < 2) ? v * v : 0.f; }
    const float rstd = rsqrtf(wave_sum(ss) * (1.f / 1024.f) + EPS);
    if (g < 2) {
#pragma unroll
        for (int c = 0; c < 8; ++c)
#pragma unroll
            for (int r = 0; r < 4; ++r) { const int e = (4 * g + r) * 128 + 16 * c + fr; O[m * D + e] = f2bf(out[c][r] * rstd * gn_a[e]); }
    }
}
__device__ __forceinline__ void p5_dsa(const MkArgs& a, LAS unsigned char* lds) {
    const int tid = threadIdx.x, lane = tid & 63, wave = __builtin_amdgcn_readfirstlane(tid >> 6);
    const bf16_t* B0 = (const bf16_t*)(a.ws + WS_B0); const bf16_t* QI = (const bf16_t*)(a.ws + WS_QI); const bf16_t* QA = (const bf16_t*)(a.ws + WS_QA);
    bf16_t* O = (bf16_t*)(a.ws + WS_O); const float* rel_bias = a.in[10];
    float* SC = (float*)(a.ws + WS_OBRAW) + (size_t)blockIdx.x * (16 * 4096);
    constexpr int KT_BYTES = 128 * 144;
    LAS unsigned char* s_kt = lds;
    LAS float* s_bias = (LAS float*)(lds + 36864);
    LAS unsigned short* s_sel = (LAS unsigned short*)(lds + 40960 + wave * 1024);
    LAS unsigned char* s_vt = lds + 49152 + wave * 8192;
    for (int i = tid; i < 1024; i += MK_THREADS) s_bias[i] = rel_bias[t5_bucket(i >> 3) * 8 + (i & 7)];
    __syncthreads();
    const int Gd = gridDim.x;
    for (int it = blockIdx.x; it < 1024; it += Gd) {
        const int jj = it / Gd, kk_ = it % Gd; int gi = (jj & 1) ? (jj * Gd + (Gd - 1 - kk_)) : it; if (gi >= 1024) gi = it;
        const int b = gi & 3, t0 = (gi >> 2) * 16;
        const int tA = t0 + 2 * wave;
        int ln = lane; asm volatile("" : "+v"(ln));
        const int r32 = ln & 31, hi = ln >> 5;
        bf16x8_t aq[4]; float wv[16];
        { const int tt = (r32 >> 2) & 1, hh = (r32 & 3) + 4 * (r32 >> 3);
          const bf16_t* qp = QI + (size_t)(b * S + tA + tt) * 1024 + hh * 64 + 32 * hi;
#pragma unroll
          for (int kk = 0; kk < 4; ++kk) aq[kk] = *(const bf16x8_t*)(qp + 8 * kk);
          const bf16_t* wp = B0 + (size_t)(b * S + tA + hi) * 1024 + 832;
          const u32x4 w0 = *(const u32x4*)wp, w1 = *(const u32x4*)(wp + 8);
#pragma unroll
          for (int j = 0; j < 4; ++j) { wv[2 * j] = __uint_as_float(w0[j] << 16); wv[2 * j + 1] = __uint_as_float(w0[j] & 0xffff0000u); wv[8 + 2 * j] = __uint_as_float(w1[j] << 16); wv[8 + 2 * j + 1] = __uint_as_float(w1[j] & 0xffff0000u); } }
        const int nkb = (t0 + 15) / 128 + 1;
        REP(50) {
            const int key = tid >> 2, q4 = tid & 3;
            const bf16_t* src = B0 + (size_t)(b * S + key) * 1024 + 768 + 16 * q4;
            u32x4 v0 = *(const u32x4*)src, v1 = *(const u32x4*)(src + 8);
            __syncthreads();
            *(LAS u32x4*)(s_kt + key * 144 + q4 * 32) = v0; *(LAS u32x4*)(s_kt + key * 144 + q4 * 32 + 16) = v1;
            __syncthreads();
            for (int kb = 0; kb < nkb; ++kb) {
                LAS unsigned char* cur = s_kt + (kb & 1) * KT_BYTES; LAS unsigned char* nxt = s_kt + ((kb + 1) & 1) * KT_BYTES;
                const bool more = kb + 1 < nkb;
                if (more) { const bf16_t* sn = src + (size_t)(kb + 1) * 128 * 1024; v0 = *(const u32x4*)sn; v1 = *(const u32x4*)(sn + 8); }
#pragma unroll
                for (int sub = 0; sub < 4; ++sub) {
                    f32x16 sc;
#pragma unroll
                    for (int i = 0; i < 16; ++i) sc[i] = 0.f;
#pragma unroll
                    for (int kk = 0; kk < 4; ++kk) { const bf16x8_t bk = *(const LAS bf16x8_t*)(cur + (32 * sub + r32) * 144 + (32 * hi + 8 * kk) * 2); sc = __builtin_amdgcn_mfma_f32_32x32x16_bf16(aq[kk], bk, sc, 0, 0, 0); }
                    float score = 0.f;
#pragma unroll
                    for (int i = 0; i < 16; ++i) score += wv[i] * fmaxf(sc[i], 0.f);
                    SC[(size_t)(2 * wave + hi) * 4096 + kb * 128 + sub * 32 + r32] = score;
                }
                if (more) { *(LAS u32x4*)(nxt + key * 144 + q4 * 32) = v0; *(LAS u32x4*)(nxt + key * 144 + q4 * 32 + 16) = v1; }
                __syncthreads();
            }
        }
        asm volatile("s_waitcnt vmcnt(0)" ::: "memory");
        REP(51) for (int tt = 0; tt < 2; ++tt) {
            const int t = tA + tt, n = t + 1; const float* row = SC + (size_t)(2 * wave + tt) * 4096; LAS unsigned short* sel = s_sel + tt * 256;
            if (n <= 256) { for (int i = 0; i < 4; ++i) { const int j = lane + 64 * i; sel[j] = (unsigned short)(j < n ? j : 0); } }
            else if (n <= 1024) topk_row<16>(row, n, sel, lane);
            else if (n <= 2048) topk_row<32>(row, n, sel, lane);
            else if (n <= 3072) topk_row<48>(row, n, sel, lane);
            else topk_row<64>(row, n, sel, lane);
        }
        LDS_WAIT();
        REP(52) for (int tt = 0; tt < 2; ++tt) {
            const int t = tA + tt;
            dsa_token(B0, QA, a.in[8], a.in[11], O, b, t, t + 1 < 256 ? t + 1 : 256, s_sel + tt * 256, s_bias, s_vt);
        }
    }
}

constexpr int CW_BAR = 4096;
__global__ void __launch_bounds__(MK_THREADS, 2) mk_fwd(MkArgs a) {
    extern __shared__ __attribute__((aligned(16))) unsigned char lds_raw[];
    LAS unsigned char* lds = (LAS unsigned char*)lds_raw;
    const int lo = a.ph_lo, hi = a.ph_hi;
    const bool fused = (hi - lo) > 1;
    volatile LAS unsigned* misc = (volatile LAS unsigned*)(lds + MK_MISC_OFF);
    XcdBarrier bar; bar.bar = (unsigned*)(a.ws + WS_CTL) + CW_BAR; bar.x = 0; bar.st = misc + 8;
    if (fused) {
        if (threadIdx.x < 32) misc[threadIdx.x] = 0u;
        __syncthreads();
        bar = xcd_barrier_post((unsigned*)(a.ws + WS_CTL) + CW_BAR, misc + 8);
    }
    int nbar = 0;
#define IN(k) (lo <= (k) && (k) < hi)
#define SEAM() do { if (fused) { if (nbar == 0) cg::this_grid().sync(); else xcd_barrier(bar); ++nbar; } } while (0)
    if (IN(0)) { REP(0) { p0_prep(a, lds); __syncthreads(); } SEAM(); }
    if (IN(1)) { REP(1) { p1_xn(a, lds); __syncthreads(); } SEAM(); }
    if (IN(2)) {
        pg8::Gemm g{(const bf16_t*)(a.ws + WS_XN), (const bf16_t*)(a.ws + WS_WTIN), M, 4096, D, D, D};
        pg8::StaticOrder S; S.init(g, (int)gridDim.x, (int)blockIdx.x);
        EpiInProj E{(bf16_t*)(a.ws + WS_B0), (bf16_t*)(a.ws + WS_QB), (bf16_t*)(a.ws + WS_KB), (bf16_t*)(a.ws + WS_VB), (float*)(a.ws + WS_SSQ)};
        REP(2) pg8::gemm_phase<EpiInProj, pg8::StaticOrder>(lds, g, S, E);
        SEAM();
    }
    if (IN(3)) {
        kanorm_pass(a);
        pg8::Gemm g{(const bf16_t*)(a.ws + WS_B0), (const bf16_t*)(a.ws + WS_WTQUP), M, 2048, 512, 1024, 512};
        pg8::StaticOrder S; S.init(g, (int)gridDim.x, (int)blockIdx.x);
        EpiQupG E{(const float*)(a.ws + WS_SSQ), (bf16_t*)(a.ws + WS_QA), (bf16_t*)(a.ws + WS_QI)};
        REP(3) pg8::gemm_phase<EpiQupG, pg8::StaticOrder>(lds, g, S, E);
        SEAM();
    }
    if (IN(5)) { REP(5) { p5_dsa(a, lds); __syncthreads(); } }
    if (IN(6)) { REP(6) { p6_sb(a, lds); __syncthreads(); } SEAM(); }
    if (IN(7)) {
        pg8::Gemm g{(const bf16_t*)(a.ws + WS_O), (const bf16_t*)(a.ws + WS_WTOUT), M, D, D, D, D};
        pg8::StaticOrder S; S.init(g, (int)gridDim.x, (int)blockIdx.x);
        EpiOutProj E{a.in[0], (const float*)(a.ws + WS_MOD), a.out};
        REP(7) pg8::gemm_phase<EpiOutProj, pg8::StaticOrder>(lds, g, S, E);
        SEAM();
    }
    if (IN(8)) { p8_route(a, lds); SEAM(); }
    if (IN(9)) {
        const MoeTab t = moe_tab_build(a, lds);
        pg8::Gemm g{(const bf16_t*)(a.ws + WS_XN), (const bf16_t*)(a.ws + WS_WTGU), 0, 0, D, D, D};
        SchedGU S; S.init(t, a, (int)gridDim.x, (int)blockIdx.x);
        EpiGU E{(bf16_t*)(a.ws + WS_U)};
        REP(9) pg8::gemm_phase<EpiGU, SchedGU>(lds, g, S, E);
        SEAM();
    }
    for (int slot = 0; slot < 2; ++slot) if (IN(10 + slot)) {
        const MoeTab t = moe_tab_build(a, lds);
        pg8::Gemm g{(const bf16_t*)(a.ws + WS_U), (const bf16_t*)(a.ws + WS_WTDN), 0, 0, 512, 512, 512};
        SchedDN S; S.init(t, a, slot, (int)gridDim.x, (int)blockIdx.x);
        EpiDown E{t, slot, (const int*)(a.ws + WS_LIST), (const float*)(a.ws + WS_GW), (const float*)(a.ws + WS_MOD), a.out};
        pg8::gemm_phase<EpiDown, SchedDN>(lds, g, S, E);
        if (slot == 0) SEAM();
    }
#undef IN
#undef SEAM
}

#ifndef MK_ONE_LAUNCH
#define MK_ONE_LAUNCH 1
#endif
extern "C" void kernel_launch(void* const* d_in, const int* in_sizes, int n_in, void* d_out, int out_size, void* d_ws, size_t ws_size, hipStream_t stream) {
    static int grid = 0;
    if (grid == 0) {
        if (ws_size < WS_END || n_in != 20 || out_size != M * D) { fprintf(stderr, "kernel_launch: unexpected sizes: ws %zu (need %zu), n_in %d, out %d\n", ws_size, (size_t)WS_END, n_in, out_size); grid = -1; return; }
        int dev = 0, cus = 0, per_cu = 0;
        if (hipGetDevice(&dev) != hipSuccess || hipDeviceGetAttribute(&cus, hipDeviceAttributeMultiprocessorCount, dev) != hipSuccess) { grid = -1; return; }
        if (hipFuncSetAttribute((const void*)mk_fwd, hipFuncAttributeMaxDynamicSharedMemorySize, MK_LDS) != hipSuccess) { fprintf(stderr, "kernel_launch: hipFuncSetAttribute failed\n"); grid = -1; return; }
        if (hipOccupancyMaxActiveBlocksPerMultiprocessor(&per_cu, (const void*)mk_fwd, MK_THREADS, MK_LDS) != hipSuccess || per_cu < 1) { fprintf(stderr, "kernel_launch: occupancy query failed (%d)\n", per_cu); grid = -1; return; }
        grid = cus < 256 ? cus : 256;
        fprintf(stderr, "kernel_launch: cus %d per_cu %d grid %d\n", cus, per_cu, grid);
    }
    if (grid < 0) return;
    if (hipMemsetAsync(d_ws, 0, 1 * MiB, stream) != hipSuccess) return;
    MkArgs a{};
    for (int i = 0; i < 20; ++i) a.in[i] = (const float*)d_in[i];
    a.out = (float*)d_out; a.ws = (unsigned char*)d_ws;
#if MK_ONE_LAUNCH
    a.ph_lo = 0; a.ph_hi = 12;
    void* args[] = {&a};
    const hipError_t e = hipLaunchCooperativeKernel((const void*)mk_fwd, dim3(grid), dim3(MK_THREADS), args, MK_LDS, stream);
    if (e != hipSuccess) fprintf(stderr, "kernel_launch: cooperative launch failed: %s (grid %d)\n", hipGetErrorString(e), grid);
#else
    const int phases[] = {0, 1, 2, 3, 5, 6, 7, 8, 9, 10, 11};
    for (int ph : phases) { a.ph_lo = ph; a.ph_hi = ph + 1; hipLaunchKernelGGL(mk_fwd, dim3(grid), dim3(MK_THREADS), MK_LDS, stream, a); }
#endif
}
```

```cpp
#include <hip/hip_runtime.h>
#include <hip/hip_cooperative_groups.h>
#include <stdint.h>
#include <cstdio>
namespace cg = cooperative_groups;

typedef unsigned short bf16_t;
#define LAS __attribute__((address_space(3)))

constexpr int D = 2048, NB = 4, S = 4096, M = NB * S;
constexpr int NMOD = 6 * D;
constexpr int DIN = 3920;
constexpr float EPS = 1e-6f;
constexpr size_t MiB = 1ull << 20;
constexpr size_t WS_CTL = 0;
constexpr size_t WS_MOD = 1 * MiB;
constexpr size_t WS_RC = 2 * MiB;
constexpr size_t WS_EID = 3 * MiB;
constexpr size_t WS_GW = 4 * MiB;
constexpr size_t WS_SSQ = 5 * MiB;
constexpr size_t WS_XN = 8 * MiB;
constexpr size_t WS_B0 = 72 * MiB;
constexpr size_t WS_QB = 104 * MiB;
constexpr size_t WS_KB = 136 * MiB;
constexpr size_t WS_VB = 168 * MiB;
constexpr size_t WS_QA = 200 * MiB;
constexpr size_t WS_QI = 232 * MiB;
constexpr size_t WS_SEL = 264 * MiB;
constexpr size_t WS_O = 272 * MiB;
constexpr size_t WS_OBRAW = 336 * MiB;
constexpr size_t WS_MODP = 400 * MiB;
constexpr size_t WS_WTIN = 408 * MiB;
constexpr size_t WS_WTQUP = 424 * MiB;
constexpr size_t WS_WTOUT = 426 * MiB;
constexpr size_t WS_WTGU = 434 * MiB;
constexpr size_t WS_WTDN = 562 * MiB;
constexpr size_t WS_RT = 6 * MiB;
constexpr size_t WS_LIST = WS_B0;
constexpr size_t WS_U = WS_QA;
constexpr size_t WS_OBS = 7 * MiB;
constexpr int CW_CNT = 8192;
constexpr size_t WS_END = 626 * MiB;

__device__ __forceinline__ float bf2f(bf16_t v) { return __uint_as_float(((unsigned)v) << 16); }
__device__ __forceinline__ bf16_t f2bf(float f) { unsigned u = __float_as_uint(f); u += 0x7fffu + ((u >> 16) & 1u); return (bf16_t)(u >> 16); }
__device__ __forceinline__ float silu_f(float v) { return v / (1.f + __expf(-v)); }
__device__ __forceinline__ unsigned fkey(float f) { const unsigned u = __float_as_uint(f); return (u & 0x80000000u) ? ~u : (u | 0x80000000u); }
__device__ __forceinline__ int t5_bucket(int dist) {
    if (dist < 16) return dist;
    int large = 16 + (int)(__logf((float)dist * (1.f / 16.f)) / 2.0794415416798357f * 16.f);
    return large < 31 ? large : 31;
}

namespace pg8 {
#define PG8_LAS __attribute__((address_space(3)))
typedef short bf16x8 __attribute__((ext_vector_type(8)));
typedef float f32x4 __attribute__((ext_vector_type(4)));
typedef unsigned u32x4 __attribute__((ext_vector_type(4)));
constexpr int BM = 256, BK = 64, HALF = 128, HTB = HALF * BK * 2, STAGE_BYTES = 8 * HTB, NXCD = 8, WGM = 8;
__host__ __device__ __forceinline__ int lds_byte(int r, int c) { const int st = (r >> 4) * 2 + (c >> 5), rr = r & 15, cc = c & 31, ob = rr * 64 + cc * 2; return st * 1024 + (ob ^ (((ob >> 9) & 1) << 5)); }
__host__ __device__ __forceinline__ void stage_rc(int b, int& R, int& C) { const int st = b / 1024, sb = b % 1024, swz = sb ^ (((sb >> 9) & 1) << 5); R = (st >> 1) * 16 + swz / 64; C = (st & 1) * 32 + (swz % 64) / 2; }
__host__ __device__ __forceinline__ int perm32(int rho) { const int n = rho >> 4, i = rho & 15; return 8 * (i >> 2) + 4 * n + (i & 3); }
__device__ __forceinline__ unsigned cvt_pk_bf16(float lo, float hi) { unsigned r; asm volatile("v_cvt_pk_bf16_f32 %0, %1, %2" : "=v"(r) : "v"(lo), "v"(hi)); return r; }

struct Unit { int pm, pn, aux; const char* a; const char* b; unsigned va[2][2]; };
struct Gemm { const bf16_t* A; const bf16_t* Bt; int M, N, K, lda, ldb; };

struct StaticOrder {
    int nM, nN, nwg, G, c; const char* A; const char* Bt; size_t tstepA, tstepB; unsigned vb[2][2];
    __device__ void init(const Gemm& g, int G_, int c_) { nM = g.M / BM; nN = g.N / BM; nwg = nM * nN; G = G_; c = c_; A = (const char*)g.A; Bt = (const char*)g.Bt; tstepA = (size_t)BM * g.lda * 2; tstepB = (size_t)BM * g.ldb * 2;
#pragma unroll
        for (int i = 0; i < 2; ++i) { int R, C; stage_rc((int)threadIdx.x * 16 + i * 8192, R, C); vb[0][i] = (unsigned)(R * g.lda + C) * 2u; vb[1][i] = (unsigned)((HALF + R) * g.lda + C) * 2u; } }
    __device__ bool next(int i, Unit& u) const {
        const long L = (long)i * G + c; if (L >= nwg) return false;
        int wgid = (int)L; { const int q = nwg / NXCD, r = nwg % NXCD, xcd = wgid % NXCD, off = wgid / NXCD; wgid = (xcd < r ? xcd * (q + 1) : r * (q + 1) + (xcd - r) * q) + off; }
        const int nig = WGM * nN, gid = wgid / nig, fm = gid * WGM, gsz = (nM - fm) < WGM ? (nM - fm) : WGM;
        u.pm = fm + ((wgid % nig) % gsz); u.pn = (wgid % nig) / gsz;
        u.a = A + (size_t)u.pm * tstepA; u.b = Bt + (size_t)u.pn * tstepB; u.aux = 0; u.va[0][0] = vb[0][0]; u.va[0][1] = vb[0][1]; u.va[1][0] = vb[1][0]; u.va[1][1] = vb[1][1]; return true;
    }
};

template <class Epi, class Sched>
__device__ __forceinline__ void gemm_phase(PG8_LAS unsigned char* lds, const Gemm g, const Sched& S, const Epi& E) {
    const int tid = threadIdx.x, wid = __builtin_amdgcn_readfirstlane(tid >> 6), lane = tid & 63, wr = wid >> 2, wc = wid & 3, fr = lane & 15, fq = lane >> 4;
    const int K = g.K, nt = K / BK;
    unsigned voffB[2];
#pragma unroll
    for (int i = 0; i < 2; ++i) { int R, C; stage_rc(tid * 16 + i * 8192, R, C); const int Rb = Epi::PERM ? ((R & ~31) + perm32(R & 31)) : R;
        voffB[i] = (unsigned)(Rb * g.ldb + C) * 2u; }
    const size_t kstep = (size_t)(BK * 2);
    const size_t hstepB = (size_t)HALF * g.ldb * 2;
    const unsigned ldsw = (unsigned)wid * 1024u;
    const int aoff = lds_byte(wr * 64 + fr, fq * 8), boff = lds_byte(wc * 32 + fr, fq * 8);
#define PG8_SA(b, h) (((b) * 2 + (h)) * HTB)
#define PG8_SB(b, h) ((4 + (b) * 2 + (h)) * HTB)
#define PG8_STAGE(bufoff, gbase, voff) do { _Pragma("unroll") for (int _i = 0; _i < 2; ++_i) \
        __builtin_amdgcn_global_load_lds((const unsigned*)((const char*)(gbase) + (voff)[_i]), (PG8_LAS unsigned*)(lds + (bufoff) + ldsw + _i * 8192), 16, 0, 0); } while (0)
#define PG8_LDA(dst, b, h) do { _Pragma("unroll") for (int m = 0; m < 4; ++m) _Pragma("unroll") for (int k = 0; k < 2; ++k) dst[m][k] = *(const PG8_LAS bf16x8*)(lds + PG8_SA(b, h) + aoff + m * 2048 + k * 1024); } while (0)
#define PG8_LDB(dst, b, h) do { _Pragma("unroll") for (int n = 0; n < 2; ++n) _Pragma("unroll") for (int k = 0; k < 2; ++k) dst[n][k] = *(const PG8_LAS bf16x8*)(lds + PG8_SB(b, h) + boff + n * 2048 + k * 1024); } while (0)
#define PG8_MMA(ai, bj, At, Bt) do { __builtin_amdgcn_s_setprio(1); _Pragma("unroll") for (int m = 0; m < 4; ++m) _Pragma("unroll") for (int n = 0; n < 2; ++n) _Pragma("unroll") for (int k = 0; k < 2; ++k) \
        acc[ai][bj][m][n] = __builtin_amdgcn_mfma_f32_16x16x32_bf16(Bt[n][k], At[m][k], acc[ai][bj][m][n], 0, 0, 0); __builtin_amdgcn_s_setprio(0); } while (0)
#define PG8_WAIT_V(n) asm volatile("s_waitcnt vmcnt(" #n ")" ::: "memory")
#define PG8_WAIT_L(n) asm volatile("s_waitcnt lgkmcnt(" #n ")" ::: "memory")
#define PG8_BAR __builtin_amdgcn_s_barrier()
#define PG8_SCHED __builtin_amdgcn_sched_barrier(0)
    Unit cur, nxt; int ui = 0;
    if (!S.next(0, cur)) return;
    f32x4 acc[2][2][4][2];
#pragma unroll
    for (int a = 0; a < 2; ++a)
#pragma unroll
        for (int b = 0; b < 2; ++b)
#pragma unroll
            for (int m = 0; m < 4; ++m)
#pragma unroll
                for (int n = 0; n < 2; ++n) acc[a][b][m][n] = (f32x4){0.f, 0.f, 0.f, 0.f};
    bf16x8 At[4][2], B0[2][2], B1[2][2];
    const char* cA = cur.a; const char* cB = cur.b;
    PG8_STAGE(PG8_SB(0, 0), cB, voffB); PG8_STAGE(PG8_SB(0, 1), cB + hstepB, voffB); PG8_STAGE(PG8_SA(0, 0), cA, cur.va[0]); PG8_STAGE(PG8_SA(0, 1), cA, cur.va[1]);
    if (wr == 1) PG8_BAR;
    PG8_WAIT_V(2); PG8_BAR;
    PG8_STAGE(PG8_SB(1, 0), cB + kstep, voffB); PG8_STAGE(PG8_SA(1, 0), cA + kstep, cur.va[0]); PG8_STAGE(PG8_SB(1, 1), cB + hstepB + kstep, voffB);
    PG8_WAIT_V(6); PG8_BAR;
    for (;;) {
        const bool has_next = S.next(ui + 1, nxt);
        if (!has_next) nxt = cur;
        const char* nA = has_next ? nxt.a : cA; const char* nB = has_next ? nxt.b : cB;
        for (int t = 0; t < nt; t += 2) {
            const bool last = (t == nt - 2);
            const char* a1 = cA + (size_t)(t + 1) * kstep;
            const char* a2 = last ? nA : cA + (size_t)(t + 2) * kstep; const char* b2 = last ? nB : cB + (size_t)(t + 2) * kstep;
            const char* a3 = a2 + kstep; const char* b3 = b2 + kstep;
            unsigned vn0[2], vn1[2];
            vn0[0] = last ? nxt.va[0][0] : cur.va[0][0]; vn0[1] = last ? nxt.va[0][1] : cur.va[0][1]; vn1[0] = last ? nxt.va[1][0] : cur.va[1][0]; vn1[1] = last ? nxt.va[1][1] : cur.va[1][1];
            PG8_LDB(B0, 0, 0); PG8_LDB(B1, 0, 1); PG8_SCHED; PG8_LDA(At, 0, 0); PG8_STAGE(PG8_SA(1, 1), a1, cur.va[1]);
            PG8_WAIT_V(8); PG8_WAIT_L(0); PG8_BAR; PG8_MMA(0, 0, At, B0); PG8_MMA(0, 1, At, B1); PG8_BAR; PG8_SCHED;
            PG8_LDA(At, 0, 1); PG8_STAGE(PG8_SB(0, 0), b2, voffB); PG8_STAGE(PG8_SB(0, 1), b2 + hstepB, voffB); PG8_STAGE(PG8_SA(0, 0), a2, vn0);
            PG8_WAIT_V(8); PG8_WAIT_L(0); PG8_BAR; PG8_MMA(1, 0, At, B0); PG8_MMA(1, 1, At, B1); PG8_BAR; PG8_SCHED;
            PG8_LDB(B0, 1, 0); PG8_LDB(B1, 1, 1); PG8_SCHED; PG8_LDA(At, 1, 0); PG8_STAGE(PG8_SA(0, 1), a2, vn1);
            PG8_WAIT_V(8); PG8_WAIT_L(0); PG8_BAR; PG8_MMA(0, 0, At, B0); PG8_MMA(0, 1, At, B1); PG8_BAR; PG8_SCHED;
            PG8_LDA(At, 1, 1); PG8_STAGE(PG8_SB(1, 0), b3, voffB); PG8_STAGE(PG8_SB(1, 1), b3 + hstepB, voffB); PG8_STAGE(PG8_SA(1, 0), a3, vn0);
            PG8_WAIT_V(8); PG8_WAIT_L(0); PG8_BAR; PG8_MMA(1, 0, At, B0); PG8_MMA(1, 1, At, B1); PG8_BAR; PG8_SCHED;
        }
        if (wr == 0) PG8_BAR;
        E(acc, cur, wr, wc, fr, fq);
        if (!has_next) break;
#pragma unroll
        for (int a = 0; a < 2; ++a)
#pragma unroll
            for (int b = 0; b < 2; ++b)
#pragma unroll
                for (int m = 0; m < 4; ++m)
#pragma unroll
                    for (int n = 0; n < 2; ++n) acc[a][b][m][n] = (f32x4){0.f, 0.f, 0.f, 0.f};
        cur = nxt; cA = nA; cB = nB; ++ui;
        if (wr == 1) PG8_BAR;
    }
    PG8_WAIT_V(0);
    PG8_BAR;
#undef PG8_SA
#undef PG8_SB
#undef PG8_STAGE
#undef PG8_LDA
#undef PG8_LDB
#undef PG8_MMA
#undef PG8_WAIT_V
#undef PG8_WAIT_L
#undef PG8_BAR
#undef PG8_SCHED
}
}
#ifndef MK_DUP
#define MK_DUP -1
#endif
#define REP(k) for (int rep_ = 0; rep_ < ((MK_DUP) == (k) ? 2 : 1); ++rep_)

#define XB_TMO      128
#define XB_XCNT(j)  (256  + 64 * (j))
#define XB_XSUB(j)  (1280 + 64 * (j))
#define XB_XGEN(j)  (2304 + 64 * (j))
#define XB_TOP      3328
#define XB_TOPGEN   3392
#define XCD_BAR_WORDS 3456
#define XB_SPIN_CAP (1u << 18)
__device__ __forceinline__ unsigned xb_ld(unsigned* p)              { return __hip_atomic_load(p, __ATOMIC_RELAXED, __HIP_MEMORY_SCOPE_AGENT); }
__device__ __forceinline__ unsigned xb_add(unsigned* p, unsigned v) { return __hip_atomic_fetch_add(p, v, __ATOMIC_RELAXED, __HIP_MEMORY_SCOPE_AGENT); }
__device__ __forceinline__ unsigned xb_xcc_id() { return (unsigned)__builtin_amdgcn_s_getreg((3 << 11) | 20) & 0xFu; }
#define XB_SPIN(cond, bar) do { unsigned _sp = 0; while (cond) { __builtin_amdgcn_s_sleep(1); \
    if ((++_sp & 255u) == 0u) { if (xb_ld(&(bar)[XB_TMO])) break; if (_sp > XB_SPIN_CAP) { atomicAdd(&(bar)[XB_TMO], 1u); break; } } } } while (0)
struct XcdBarrier { unsigned* bar; unsigned x; volatile LAS unsigned* st; };
__device__ __forceinline__ XcdBarrier xcd_barrier_post(unsigned* bar, volatile LAS unsigned* st) {
    XcdBarrier b; b.bar = bar; b.x = xb_xcc_id(); b.st = st;
    if (threadIdx.x == 0) (void)xb_add(&bar[XB_XCNT(b.x)], 1u);
    return b;
}
__device__ __forceinline__ void xcd_barrier_complete(unsigned* bar, unsigned x, unsigned& nloc, unsigned& nx) {
    const unsigned G = gridDim.x * gridDim.y * gridDim.z;
    unsigned sum, cnt, mine, sp = 0u;
    for (;;) {
        sum = 0u; cnt = 0u; mine = 0u;
#pragma unroll
        for (unsigned j = 0; j < 16; ++j) { const unsigned c = xb_ld(&bar[XB_XCNT(j)]); sum += c; cnt += (c > 0u) ? 1u : 0u; mine = (j == x) ? c : mine; }
        if (sum == G) break;
        __builtin_amdgcn_s_sleep(1);
        if ((++sp & 255u) == 0u) { if (xb_ld(&bar[XB_TMO])) break; if (sp > XB_SPIN_CAP) { atomicAdd(&bar[XB_TMO], 1u); break; } }
    }
    nloc = mine > 0u ? mine : 1u; nx = cnt > 0u ? cnt : 1u;
}
__device__ __forceinline__ void xcd_barrier(const XcdBarrier& b) {
    asm volatile("s_waitcnt vmcnt(0)" ::: "memory");
    __syncthreads();
    if (threadIdx.x == 0) {
        unsigned* bar = b.bar;
        __builtin_amdgcn_s_waitcnt(0);
        unsigned nloc = b.st[0], nx = b.st[1];
        if (nloc == 0u) { xcd_barrier_complete(bar, b.x, nloc, nx); b.st[0] = nloc; b.st[1] = nx; }
        const unsigned old = xb_add(&bar[XB_XSUB(b.x)], 1u);
        const unsigned gen = old / nloc;
        if (old + 1u == (gen + 1u) * nloc) {
            __builtin_amdgcn_fence(__ATOMIC_RELEASE, "agent");
            asm volatile("s_waitcnt vmcnt(0)" ::: "memory");
            const unsigned og = xb_add(&bar[XB_TOP], 1u);
            const unsigned tg = og / nx;
            if (og + 1u == (tg + 1u) * nx) xb_add(&bar[XB_TOPGEN], 1u);
            else XB_SPIN(xb_ld(&bar[XB_TOPGEN]) == tg, bar);
            __builtin_amdgcn_fence(__ATOMIC_ACQUIRE, "agent");
            xb_add(&bar[XB_XGEN(b.x)], 1u);
            asm volatile("s_waitcnt vmcnt(0)" ::: "memory");
        } else {
            XB_SPIN(xb_ld(&bar[XB_XGEN(b.x)]) == gen, bar);
            __builtin_amdgcn_fence(__ATOMIC_ACQUIRE, "agent");
            asm volatile("s_waitcnt vmcnt(0)" ::: "memory");
        }
    }
    __syncthreads();
}

constexpr int MK_THREADS = 512, MK_LDS = 147456, MK_MISC_OFF = 135168, MK_MOE_OFF = 135168 + 256;
struct MkArgs { const float* in[20]; float* out; unsigned char* ws; int ph_lo, ph_hi; };
typedef float f32x4 __attribute__((ext_vector_type(4)));
typedef unsigned u32x4 __attribute__((ext_vector_type(4)));
typedef unsigned u32x2 __attribute__((ext_vector_type(2)));
#define LDS_WAIT() asm volatile("s_waitcnt lgkmcnt(0)" ::: "memory")
__device__ __forceinline__ unsigned pk2(float lo, float hi) { return (unsigned)f2bf(lo) | ((unsigned)f2bf(hi) << 16); }
__device__ __forceinline__ float wave_sum(float v) {
#pragma unroll
    for (int o = 1; o < 64; o <<= 1) v += __shfl_xor(v, o);
    return v;
}

template <class RowMap>
__device__ __forceinline__ void tr_item(const float* __restrict__ W, int K, int N, bf16_t* __restrict__ WT, LAS float* scr, int item, int lane, const float* __restrict__ kscale, RowMap rm) {
    const int nblk = (N + 31) / 32, kb = item / nblk, nb = item % nblk, k0 = 64 * kb, n0 = 32 * nb;
    const int nn = n0 + (lane & 31);
#pragma unroll 8
    for (int i = 0; i < 32; ++i) { const int kk = 2 * i + (lane >> 5); float v = nn < N ? W[(size_t)(k0 + kk) * N + nn] : 0.f; if (kscale) v *= kscale[k0 + kk]; scr[kk * 33 + (lane & 31)] = v; }
    LDS_WAIT(); asm volatile("" ::: "memory");
    const int c = lane & 7;
#pragma unroll
    for (int j = 0; j < 4; ++j) { const int nl = (lane >> 3) + 8 * j; const int n = n0 + nl;
        if (n < N) { float sc = 1.f; const int r = rm(n, sc); const LAS float* s = scr + (8 * c) * 33 + nl;
            u32x4 o; o.x = pk2(s[0 * 33] * sc, s[1 * 33] * sc); o.y = pk2(s[2 * 33] * sc, s[3 * 33] * sc); o.z = pk2(s[4 * 33] * sc, s[5 * 33] * sc); o.w = pk2(s[6 * 33] * sc, s[7 * 33] * sc);
            *(u32x4*)(WT + (size_t)r * K + k0 + 8 * c) = o; } }
    LDS_WAIT(); asm volatile("" ::: "memory");
}

__device__ __forceinline__ void p0_prep(const MkArgs& a, LAS unsigned char* lds) {
    const int tid = threadIdx.x, lane = tid & 63, wave = __builtin_amdgcn_readfirstlane(tid >> 6);
    const float* c = a.in[1]; const float* w_mod = a.in[2];
    float* MODP = (float*)(a.ws + WS_MODP);
    LAS float* s_c = (LAS float*)lds;
    for (int item = blockIdx.x; item < 256; item += gridDim.x) {
        const int kc = item >> 3, cc = item & 7;
        __syncthreads();
        if (tid < 256) { const int b = tid >> 6, k = tid & 63; s_c[tid] = silu_f(c[b * D + kc * 64 + k]); }
        __syncthreads();
        float acc[4][3];
#pragma unroll
        for (int b = 0; b < 4; ++b)
#pragma unroll
            for (int j = 0; j < 3; ++j) acc[b][j] = 0.f;
        const int col0 = cc * 1536 + tid;
        for (int k = 0; k < 64; ++k) {
            const float* wr = w_mod + (size_t)(kc * 64 + k) * NMOD + col0;
            const float w0 = wr[0], w1 = wr[512], w2 = wr[1024];
#pragma unroll
            for (int b = 0; b < 4; ++b) { const float sv = s_c[b * 64 + k]; acc[b][0] += sv * w0; acc[b][1] += sv * w1; acc[b][2] += sv * w2; }
        }
#pragma unroll
        for (int b = 0; b < 4; ++b)
#pragma unroll
            for (int j = 0; j < 3; ++j) MODP[(size_t)(kc * 4 + b) * NMOD + col0 + 512 * j] = acc[b][j];
    }
    __syncthreads();
    LAS float* scr = (LAS float*)(lds + wave * 16384);
    const int gw = blockIdx.x * 8 + wave, NGW = gridDim.x * 8;
    constexpr int I_IN = 32 * 123, I_QUP = 8 * 64, I_OUT = 32 * 64;
    bf16_t* Wt_in = (bf16_t*)(a.ws + WS_WTIN); bf16_t* Wt_qup = (bf16_t*)(a.ws + WS_WTQUP); bf16_t* Wt_out = (bf16_t*)(a.ws + WS_WTOUT);
    for (int it = gw; it < I_IN + I_QUP + I_OUT; it += NGW) {
        int r = it;
        if (r < I_IN) { tr_item(a.in[5], D, DIN, Wt_in, scr, r, lane, (const float*)nullptr, [](int n, float& sc) { if (n >= 832 && n < 848) sc = 0.25f; else if (n >= 848 && n < 1872) sc = 0.08838834764831845f; return n < 848 ? n : n + 176; }); continue; }
        r -= I_IN;
        if (r < I_QUP) { tr_item(a.in[7], 512, 2048, Wt_qup, scr, r, lane, a.in[6], [](int n, float& sc) { if (n >= 1024) sc = 0.125f; return n; }); continue; }
        r -= I_QUP;
        tr_item(a.in[13], D, D, Wt_out, scr, r, lane, (const float*)nullptr, [](int n, float& sc) { return n; });
    }
    {
        bf16_t* Wt_gu = (bf16_t*)(a.ws + WS_WTGU); bf16_t* Wt_dn = (bf16_t*)(a.ws + WS_WTDN);
        for (int it = gw; it < 32 * 1536; it += NGW) {
            const int e = it / 1536; int r = it % 1536;
            if (r < 512) { tr_item(a.in[17] + (size_t)e * D * 512, D, 512, Wt_gu + (size_t)e * 1024 * D, scr, r, lane, (const float*)nullptr, [](int n, float& sc) { return 8 * (n >> 2) + (n & 3); }); continue; }
            r -= 512;
            if (r < 512) { tr_item(a.in[18] + (size_t)e * D * 512, D, 512, Wt_gu + (size_t)e * 1024 * D, scr, r, lane, (const float*)nullptr, [](int n, float& sc) { return 8 * (n >> 2) + 4 + (n & 3); }); continue; }
            r -= 512;
            tr_item(a.in[19] + (size_t)e * 512 * D, 512, D, Wt_dn + (size_t)e * D * 512, scr, r, lane, (const float*)nullptr, [](int n, float& sc) { return n; });
        }
        bf16_t* RT = (bf16_t*)(a.ws + WS_RT); const float* rg = a.in[15]; const float* re = a.in[16];
        for (int i = blockIdx.x * MK_THREADS + tid; i < 48 * D; i += gridDim.x * MK_THREADS) { const int o = i >> 11, k = i & 2047; RT[i] = f2bf(o < 4 ? rg[k * 4 + o] : (o < 36 ? re[k * 32 + (o - 4)] : 0.f)); }
    }
    u32x4* z = (u32x4*)(Wt_in + (size_t)848 * D);
    for (int i = blockIdx.x * MK_THREADS + tid; i < 176 * 256; i += gridDim.x * MK_THREADS) z[i] = (u32x4){0u, 0u, 0u, 0u};
}

__device__ __forceinline__ void p1_xn(const MkArgs& a, LAS unsigned char* lds) {
    const int tid = threadIdx.x, lane = tid & 63, wave = __builtin_amdgcn_readfirstlane(tid >> 6);
    const float* x = a.in[0]; const float* b_mod = a.in[3]; const float* ln1_g = a.in[4];
    const float* MODP = (const float*)(a.ws + WS_MODP); float* MOD = (float*)(a.ws + WS_MOD); bf16_t* XN = (bf16_t*)(a.ws + WS_XN);
    LAS float* s_gs = (LAS float*)lds; LAS float* s_sh = s_gs + D;
    for (int i = blockIdx.x * MK_THREADS + tid; i < NB * NMOD; i += gridDim.x * MK_THREADS) {
        const int b = i / NMOD, n = i % NMOD; float s = b_mod[n];
        for (int kc = 0; kc < 32; ++kc) s += MODP[(size_t)(kc * 4 + b) * NMOD + n];
        MOD[i] = s;
    }
    for (int chunk = blockIdx.x; chunk < M / 64; chunk += gridDim.x) {
        const int b = chunk >> 6;
        __syncthreads();
        for (int k = tid; k < D; k += MK_THREADS) {
            float sh = b_mod[k], sc = b_mod[D + k];
            for (int kc = 0; kc < 32; ++kc) { sh += MODP[(size_t)(kc * 4 + b) * NMOD + k]; sc += MODP[(size_t)(kc * 4 + b) * NMOD + D + k]; }
            s_sh[k] = sh; s_gs[k] = ln1_g[k] * (1.f + sc);
        }
        __syncthreads();
        for (int r = wave; r < 64; r += 8) {
            const int m = chunk * 64 + r;
            const f32x4* xr = (const f32x4*)(x + (size_t)m * D) + lane;
            f32x4 v[8]; float ss = 0.f;
#pragma unroll
            for (int j = 0; j < 8; ++j) { v[j] = xr[64 * j]; ss += (v[j].x * v[j].x + v[j].y * v[j].y) + (v[j].z * v[j].z + v[j].w * v[j].w); }
            const float rstd = rsqrtf(wave_sum(ss) * (1.f / D) + EPS);
            u32x2* o8 = (u32x2*)(XN + (size_t)m * D) + lane;
#pragma unroll
            for (int j = 0; j < 8; ++j) { const int k = 4 * (lane + 64 * j); const f32x4 gs = *(const LAS f32x4*)(s_gs + k), sh = *(const LAS f32x4*)(s_sh + k);
                const f32x4 y = v[j] * rstd * gs + sh; u32x2 w; w.x = pk2(y.x, y.y); w.y = pk2(y.z, y.w); o8[64 * j] = w; }
        }
    }
}

struct EpiInProj {
    static constexpr bool PERM = true;
    bf16_t* B0; bf16_t* QB; bf16_t* KB; bf16_t* VB; float* SSQ;
    __device__ __forceinline__ void operator()(const pg8::f32x4 (&acc)[2][2][4][2], const pg8::Unit& u, int wr, int wc, int fr, int fq) const {
        const int t = u.pn >> 2; bf16_t* base = t == 0 ? B0 : (t == 1 ? QB : (t == 2 ? KB : VB));
        const int row0 = u.pm * 256 + wr * 64 + fr, col0 = (u.pn & 3) * 256 + wc * 32 + 8 * fq;
#pragma unroll
        for (int ai = 0; ai < 2; ++ai)
#pragma unroll
            for (int m = 0; m < 4; ++m) { const int row = row0 + ai * 128 + m * 16; bf16_t* rowp = base + (size_t)row * 1024 + col0; float ss = 0.f;
#pragma unroll
                for (int bj = 0; bj < 2; ++bj) { const pg8::f32x4 v0 = acc[ai][bj][m][0], v1 = acc[ai][bj][m][1];
                    ss += (v0[0] * v0[0] + v0[1] * v0[1]) + (v0[2] * v0[2] + v0[3] * v0[3]) + (v1[0] * v1[0] + v1[1] * v1[1]) + (v1[2] * v1[2] + v1[3] * v1[3]);
                    pg8::u32x4 w; w.x = pg8::cvt_pk_bf16(v0[0], v0[1]); w.y = pg8::cvt_pk_bf16(v0[2], v0[3]); w.z = pg8::cvt_pk_bf16(v1[0], v1[1]); w.w = pg8::cvt_pk_bf16(v1[2], v1[3]);
                    *(pg8::u32x4*)(rowp + bj * 128) = w; }
                if (u.pn < 2) { ss += __shfl_xor(ss, 16); ss += __shfl_xor(ss, 32); if (fq == 0) SSQ[(size_t)row * 8 + u.pn * 4 + wc] = ss; } }
    }
};


struct EpiQupG {
    static constexpr bool PERM = true;
    const float* SSQ; bf16_t* QA; bf16_t* QI;
    __device__ __forceinline__ void operator()(const pg8::f32x4 (&acc)[2][2][4][2], const pg8::Unit& u, int wr, int wc, int fr, int fq) const {
        bf16_t* base = (u.pn >> 2) ? QI : QA;
        const int row0 = u.pm * 256 + wr * 64 + fr, col0 = (u.pn & 3) * 256 + wc * 32 + 8 * fq;
#pragma unroll
        for (int ai = 0; ai < 2; ++ai)
#pragma unroll
            for (int m = 0; m < 4; ++m) { const int row = row0 + ai * 128 + m * 16; bf16_t* rowp = base + (size_t)row * 1024 + col0;
                const pg8::f32x4 s0 = *(const pg8::f32x4*)(SSQ + (size_t)row * 8), s1 = *(const pg8::f32x4*)(SSQ + (size_t)row * 8 + 4);
                const float rs = rsqrtf(((s0[0] + s0[1]) + (s0[2] + s0[3]) + (s1[0] + s1[1]) + (s1[2] + s1[3])) * (1.f / 512.f) + EPS);
#pragma unroll
                for (int bj = 0; bj < 2; ++bj) { const pg8::f32x4 v0 = acc[ai][bj][m][0] * rs, v1 = acc[ai][bj][m][1] * rs;
                    pg8::u32x4 w; w.x = pg8::cvt_pk_bf16(v0[0], v0[1]); w.y = pg8::cvt_pk_bf16(v0[2], v0[3]); w.z = pg8::cvt_pk_bf16(v1[0], v1[1]); w.w = pg8::cvt_pk_bf16(v1[2], v1[3]);
                    *(pg8::u32x4*)(rowp + bj * 128) = w; } }
    }
};
struct EpiOutProj {
    static constexpr bool PERM = true;
    const float* x; const float* MOD; float* out;
    __device__ __forceinline__ void operator()(const pg8::f32x4 (&acc)[2][2][4][2], const pg8::Unit& u, int wr, int wc, int fr, int fq) const {
        const int b = (u.pm * 256) >> 12;
        const int row0 = u.pm * 256 + wr * 64 + fr, col0 = u.pn * 256 + wc * 32 + 8 * fq;
        const float* gp = MOD + (size_t)b * NMOD + 2 * D + col0;
        pg8::f32x4 g[2][2];
#pragma unroll
        for (int bj = 0; bj < 2; ++bj) { g[bj][0] = *(const pg8::f32x4*)(gp + bj * 128); g[bj][1] = *(const pg8::f32x4*)(gp + bj * 128 + 4); }
#pragma unroll
        for (int ai = 0; ai < 2; ++ai)
#pragma unroll
            for (int m = 0; m < 4; ++m) { const size_t off = (size_t)(row0 + ai * 128 + m * 16) * D + col0;
#pragma unroll
                for (int bj = 0; bj < 2; ++bj) { const pg8::f32x4 x0 = *(const pg8::f32x4*)(x + off + bj * 128), x1 = *(const pg8::f32x4*)(x + off + bj * 128 + 4);
                    *(pg8::f32x4*)(out + off + bj * 128) = x0 + g[bj][0] * acc[ai][bj][m][0]; *(pg8::f32x4*)(out + off + bj * 128 + 4) = x1 + g[bj][1] * acc[ai][bj][m][1]; } }
    }
};
__device__ __forceinline__ void kanorm_pass(const MkArgs& a) {
    const int tid = threadIdx.x, lane = tid & 63, wave = __builtin_amdgcn_readfirstlane(tid >> 6);
    bf16_t* B0 = (bf16_t*)(a.ws + WS_B0); const float* k_gain = a.in[9];
    const float g0 = k_gain[2 * lane], g1 = k_gain[2 * lane + 1];
    for (int m = blockIdx.x * 8 + wave; m < M; m += gridDim.x * 8) {
        unsigned* p = (unsigned*)(B0 + (size_t)m * 1024 + 512) + lane;
        const unsigned v = *p; const float k0 = __uint_as_float(v << 16), k1 = __uint_as_float(v & 0xffff0000u);
        const float rs = rsqrtf(wave_sum(k0 * k0 + k1 * k1) * (1.f / 128.f) + EPS);
        *p = pk2(k0 * rs * g0, k1 * rs * g1);
    }
}

typedef short bf16x8_t __attribute__((ext_vector_type(8)));
__device__ __forceinline__ void p8_route(const MkArgs& a, LAS unsigned char* lds) {
    const int tid = threadIdx.x, lane = tid & 63, wave = __builtin_amdgcn_readfirstlane(tid >> 6);
    const float* x1 = a.out; const float* ln2_g = a.in[14]; const float* MOD = (const float*)(a.ws + WS_MOD);
    bf16_t* H2 = (bf16_t*)(a.ws + WS_XN); const bf16_t* RT = (const bf16_t*)(a.ws + WS_RT);
    int* EID = (int*)(a.ws + WS_EID); float* GW = (float*)(a.ws + WS_GW);
    unsigned* cnt = (unsigned*)(a.ws + WS_CTL) + CW_CNT; int* list = (int*)(a.ws + WS_LIST);
    constexpr int RS = 4112;
    LAS float* s_part = (LAS float*)lds;
    LAS float* s_lg = (LAS float*)(lds + 49152);
    for (int item = blockIdx.x; item < M / 32; item += gridDim.x) {
        const int m0 = item * 32, b = m0 >> 12;
        const float* mb = MOD + (size_t)b * NMOD;
        __syncthreads();
        for (int rr = 0; rr < 4; ++rr) {
            const int r = wave * 4 + rr, m = m0 + r;
            const f32x4* xr = (const f32x4*)(x1 + (size_t)m * D) + lane;
            f32x4 v[8]; float ss = 0.f;
#pragma unroll
            for (int j = 0; j < 8; ++j) { v[j] = xr[64 * j]; ss += (v[j].x * v[j].x + v[j].y * v[j].y) + (v[j].z * v[j].z + v[j].w * v[j].w); }
            const float rstd = rsqrtf(wave_sum(ss) * (1.f / D) + EPS);
            u32x2* o8 = (u32x2*)(H2 + (size_t)m * D) + lane;
#pragma unroll
            for (int j = 0; j < 8; ++j) { const int k = 4 * (lane + 64 * j);
                const f32x4 g = *(const f32x4*)(ln2_g + k), sc = *(const f32x4*)(mb + 4 * D + k), sh = *(const f32x4*)(mb + 3 * D + k);
                const f32x4 y = v[j] * rstd * g * (sc + 1.f) + sh; u32x2 w; w.x = pk2(y.x, y.y); w.y = pk2(y.z, y.w); o8[64 * j] = w;
                *(LAS u32x2*)(lds + r * RS + k * 2) = w; }
        }
        __syncthreads();
        f32x4 acc[2][3];
#pragma unroll
        for (int rt = 0; rt < 2; ++rt)
#pragma unroll
            for (int ct = 0; ct < 3; ++ct) acc[rt][ct] = (f32x4){0.f, 0.f, 0.f, 0.f};
        const int fr = lane & 15, fq = lane >> 4;
#pragma unroll 2
        for (int kk = 0; kk < 8; ++kk) {
            const int k0 = 32 * (wave * 8 + kk) + 8 * fq;
            bf16x8_t af[2], bfr[3];
#pragma unroll
            for (int rt = 0; rt < 2; ++rt) af[rt] = *(const LAS bf16x8_t*)(lds + (16 * rt + fr) * RS + k0 * 2);
#pragma unroll
            for (int ct = 0; ct < 3; ++ct) bfr[ct] = *(const bf16x8_t*)(RT + (size_t)(16 * ct + fr) * D + k0);
#pragma unroll
            for (int rt = 0; rt < 2; ++rt)
#pragma unroll
                for (int ct = 0; ct < 3; ++ct) acc[rt][ct] = __builtin_amdgcn_mfma_f32_16x16x32_bf16(af[rt], bfr[ct], acc[rt][ct], 0, 0, 0);
        }
        __syncthreads();
#pragma unroll
        for (int rt = 0; rt < 2; ++rt)
#pragma unroll
            for (int ct = 0; ct < 3; ++ct)
#pragma unroll
                for (int i = 0; i < 4; ++i) s_part[(wave * 32 + 16 * rt + 4 * fq + i) * 48 + 16 * ct + fr] = acc[rt][ct][i];
        __syncthreads();
        for (int i = tid; i < 32 * 36; i += MK_THREADS) { const int r = i / 36, o = i % 36; float s = 0.f;
#pragma unroll
            for (int w = 0; w < 8; ++w) s += s_part[(w * 32 + r) * 48 + o];
            s_lg[i] = s; }
        __syncthreads();
        if (tid < 32) {
            const LAS float* lg = s_lg + tid * 36; const int m = m0 + tid;
            int gi = 0; float gm = lg[0];
            for (int i = 1; i < 4; ++i) if (lg[i] > gm) { gm = lg[i]; gi = i; }
            float gs = 0.f;
            for (int i = 0; i < 4; ++i) gs += __expf(lg[i] - gm);
            const float gw = 1.f / gs;
            const LAS float* le = lg + 4 + gi * 8;
            float em = le[0];
            for (int i = 1; i < 8; ++i) em = fmaxf(em, le[i]);
            float es = 0.f;
            for (int i = 0; i < 8; ++i) es += __expf(le[i] - em);
            int i0 = 0; float p0 = -1.f;
            for (int i = 0; i < 8; ++i) { const float p = __expf(le[i] - em) / es; if (p > p0) { p0 = p; i0 = i; } }
            int i1 = 0; float p1 = -1.f;
            for (int i = 0; i < 8; ++i) { const float p = __expf(le[i] - em) / es; if (i != i0 && p > p1) { p1 = p; i1 = i; } }
            const float den = p0 + p1;
            const int e0 = gi * 8 + i0, e1 = gi * 8 + i1;
            EID[m * 2] = e0; EID[m * 2 + 1] = e1; GW[m * 2] = gw * p0 / den; GW[m * 2 + 1] = gw * p1 / den;
            const unsigned q0 = __hip_atomic_fetch_add(cnt + e0, 1u, __ATOMIC_RELAXED, __HIP_MEMORY_SCOPE_AGENT);
            const unsigned q1 = __hip_atomic_fetch_add(cnt + 32 + e1, 1u, __ATOMIC_RELAXED, __HIP_MEMORY_SCOPE_AGENT);
            list[(size_t)e0 * 16384 + q0] = m; list[(size_t)(32 + e1) * 16384 + q1] = m;
        }
    }
}

__device__ __forceinline__ int rfl(int v) { return __builtin_amdgcn_readfirstlane(v); }
struct MoeTab { LAS int* tsm; LAS int* c0; LAS int* c1; LAS int* ts0; LAS int* ts1; };
__device__ __forceinline__ MoeTab moe_tab_build(const MkArgs& a, LAS unsigned char* lds) {
    MoeTab t; LAS int* p = (LAS int*)(lds + MK_MOE_OFF); t.tsm = p; t.c0 = p + 40; t.c1 = p + 80; t.ts0 = p + 120; t.ts1 = p + 160;
    const unsigned* cnt = (const unsigned*)(a.ws + WS_CTL) + CW_CNT;
    __syncthreads();
    if (threadIdx.x == 0) {
        int am = 0, a0 = 0, a1 = 0;
        for (int e = 0; e < 32; ++e) { const int n0 = (int)__hip_atomic_load(cnt + e, __ATOMIC_RELAXED, __HIP_MEMORY_SCOPE_AGENT), n1 = (int)__hip_atomic_load(cnt + 32 + e, __ATOMIC_RELAXED, __HIP_MEMORY_SCOPE_AGENT);
            t.c0[e] = n0; t.c1[e] = n1; t.tsm[e] = am; t.ts0[e] = a0; t.ts1[e] = a1; am += (n0 + n1 + 255) >> 8; a0 += (n0 + 255) >> 8; a1 += (n1 + 255) >> 8; }
        t.tsm[32] = am; t.ts0[32] = a0; t.ts1[32] = a1;
    }
    __syncthreads();
    return t;
}
struct SchedGU {
    MoeTab t; const int* list; const char* H2; const char* Wt; int G, c, nunit; int R[2], C[2];
    __device__ void init(const MoeTab& t_, const MkArgs& a, int G_, int c_) { t = t_; list = (const int*)(a.ws + WS_LIST); H2 = (const char*)(a.ws + WS_XN); Wt = (const char*)(a.ws + WS_WTGU); G = G_; c = c_; nunit = rfl(t.tsm[32]) * 4;
#pragma unroll
        for (int i = 0; i < 2; ++i) pg8::stage_rc((int)threadIdx.x * 16 + i * 8192, R[i], C[i]); }
    __device__ bool next(int i, pg8::Unit& u) const {
        const int L = i * G + c; if (L >= nunit) return false;
        const int mt = L >> 2, pn = L & 3; int e = 0;
        for (int j = 1; j < 32; ++j) e += (mt >= t.tsm[j]) ? 1 : 0;
        e = rfl(e);
        u.pm = mt; u.pn = pn; u.aux = e; u.a = H2; u.b = Wt + ((size_t)(e * 1024 + pn * 256) * D) * 2;
        const int n0 = rfl(t.c0[e]), n1 = rfl(t.c1[e]), rb = (mt - rfl(t.tsm[e])) * 256;
#pragma unroll
        for (int h = 0; h < 2; ++h)
#pragma unroll
            for (int j = 0; j < 2; ++j) { const int r = rb + h * 128 + R[j]; int tok = 0;
                if (r < n0) tok = list[(size_t)e * 16384 + r]; else if (r - n0 < n1) tok = list[(size_t)(32 + e) * 16384 + (r - n0)];
                u.va[h][j] = (unsigned)(tok * D + C[j]) * 2u; }
        return true;
    }
};
struct EpiGU {
    static constexpr bool PERM = true;
    bf16_t* U;
    __device__ __forceinline__ void operator()(const pg8::f32x4 (&acc)[2][2][4][2], const pg8::Unit& u, int wr, int wc, int fr, int fq) const {
        const int row0 = u.pm * 256 + wr * 64 + fr, j0 = u.pn * 128 + wc * 16 + 4 * fq;
#pragma unroll
        for (int ai = 0; ai < 2; ++ai)
#pragma unroll
            for (int m = 0; m < 4; ++m) { bf16_t* rowp = U + (size_t)(row0 + ai * 128 + m * 16) * 512 + j0;
#pragma unroll
                for (int bj = 0; bj < 2; ++bj) { const pg8::f32x4 gv = acc[ai][bj][m][0], uv = acc[ai][bj][m][1]; float o[4];
#pragma unroll
                    for (int i = 0; i < 4; ++i) o[i] = gv[i] / (1.f + __expf(-gv[i])) * uv[i];
                    u32x2 w; w.x = pg8::cvt_pk_bf16(o[0], o[1]); w.y = pg8::cvt_pk_bf16(o[2], o[3]); *(u32x2*)(rowp + bj * 64) = w; } }
    }
};
struct SchedDN {
    MoeTab t; int slot; const char* U; const char* Wt; int G, c, nunit; unsigned vb[2][2];
    __device__ void init(const MoeTab& t_, const MkArgs& a, int slot_, int G_, int c_) { t = t_; slot = slot_; U = (const char*)(a.ws + WS_U); Wt = (const char*)(a.ws + WS_WTDN); G = G_; c = c_; nunit = rfl(slot ? t.ts1[32] : t.ts0[32]) * 8;
#pragma unroll
        for (int i = 0; i < 2; ++i) { int R, C; pg8::stage_rc((int)threadIdx.x * 16 + i * 8192, R, C); vb[0][i] = (unsigned)(R * 512 + C) * 2u; vb[1][i] = (unsigned)((128 + R) * 512 + C) * 2u; } }
    __device__ bool next(int i, pg8::Unit& u) const {
        const int L = i * G + c; if (L >= nunit) return false;
        const int tl = L >> 3, pn = L & 7; const LAS int* ts = slot ? t.ts1 : t.ts0; int e = 0;
        for (int j = 1; j < 32; ++j) e += (tl >= ts[j]) ? 1 : 0;
        e = rfl(e);
        const int lt = tl - rfl(ts[e]);
        u.pm = lt; u.pn = pn; u.aux = e;
        u.a = U + ((size_t)(rfl(t.tsm[e]) * 256 + (slot ? rfl(t.c0[e]) : 0) + lt * 256) * 512) * 2; u.b = Wt + ((size_t)(e * D + pn * 256) * 512) * 2;
        u.va[0][0] = vb[0][0]; u.va[0][1] = vb[0][1]; u.va[1][0] = vb[1][0]; u.va[1][1] = vb[1][1];
        return true;
    }
};
struct EpiDown {
    static constexpr bool PERM = true;
    MoeTab t; int slot; const int* list; const float* GW; const float* MOD; float* out;
    __device__ __forceinline__ void operator()(const pg8::f32x4 (&acc)[2][2][4][2], const pg8::Unit& u, int wr, int wc, int fr, int fq) const {
        const int e = u.aux, nv = rfl(slot ? t.c1[e] : t.c0[e]) - u.pm * 256;
        const int* lp = list + (size_t)(slot * 32 + e) * 16384 + u.pm * 256;
        const int col0 = u.pn * 256 + wc * 32 + 8 * fq;
#pragma unroll
        for (int ai = 0; ai < 2; ++ai)
#pragma unroll
            for (int m = 0; m < 4; ++m) { const int r = ai * 128 + wr * 64 + m * 16 + fr;
                if (r < nv) { const int tok = lp[r]; const float gw = GW[tok * 2 + slot]; const float* gp = MOD + (size_t)(tok >> 12) * NMOD + 5 * D + col0; float* op = out + (size_t)tok * D + col0;
#pragma unroll
                    for (int bj = 0; bj < 2; ++bj)
#pragma unroll
                        for (int n = 0; n < 2; ++n) { const pg8::f32x4 g0 = *(const pg8::f32x4*)(gp + bj * 128 + 4 * n); pg8::f32x4 o0 = *(pg8::f32x4*)(op + bj * 128 + 4 * n);
                            o0 += g0 * gw * acc[ai][bj][m][n]; *(pg8::f32x4*)(op + bj * 128 + 4 * n) = o0; } }
                asm volatile("" ::: "memory"); }
    }
};

typedef float f32x16 __attribute__((ext_vector_type(16)));
typedef short s16x4 __attribute__((ext_vector_type(4)));
__device__ __forceinline__ s16x4 tr_read(unsigned lds_addr) { s16x4 r; asm volatile("ds_read_b64_tr_b16 %0, %1\n\ts_waitcnt lgkmcnt(0)" : "=&v"(r) : "v"(lds_addr) : "memory"); return r; }
__device__ __forceinline__ unsigned off_b(unsigned row, unsigned ch) { return 256u * row + 16u * (ch ^ (((row & 3) << 2) | ((row >> 2) & 3))); }
__device__ __forceinline__ int crow(int reg, int h) { return (reg & 3) + 8 * (reg >> 2) + 4 * h; }
constexpr float SB_STOP = -104.0f;

constexpr int VT_STRIDE = 272;
__device__ __forceinline__ void tr8_sb0(unsigned addr, s16x4 (&r)[8]) {
    asm volatile(
        "ds_read_b64_tr_b16 %0, %8 offset:0\n\t"
        "ds_read_b64_tr_b16 %1, %8 offset:2176\n\t"
        "ds_read_b64_tr_b16 %2, %8 offset:4352\n\t"
        "ds_read_b64_tr_b16 %3, %8 offset:6528\n\t"
        "ds_read_b64_tr_b16 %4, %8 offset:64\n\t"
        "ds_read_b64_tr_b16 %5, %8 offset:2240\n\t"
        "ds_read_b64_tr_b16 %6, %8 offset:4416\n\t"
        "ds_read_b64_tr_b16 %7, %8 offset:6592\n\t"
        "s_waitcnt lgkmcnt(0)"
        : "=&v"(r[0]), "=&v"(r[1]), "=&v"(r[2]), "=&v"(r[3]), "=&v"(r[4]), "=&v"(r[5]), "=&v"(r[6]), "=&v"(r[7])
        : "v"(addr) : "memory");
}
__device__ __forceinline__ void tr8_sb1(unsigned addr, s16x4 (&r)[8]) {
    asm volatile(
        "ds_read_b64_tr_b16 %0, %8 offset:128\n\t"
        "ds_read_b64_tr_b16 %1, %8 offset:2304\n\t"
        "ds_read_b64_tr_b16 %2, %8 offset:4480\n\t"
        "ds_read_b64_tr_b16 %3, %8 offset:6656\n\t"
        "ds_read_b64_tr_b16 %4, %8 offset:192\n\t"
        "ds_read_b64_tr_b16 %5, %8 offset:2368\n\t"
        "ds_read_b64_tr_b16 %6, %8 offset:4544\n\t"
        "ds_read_b64_tr_b16 %7, %8 offset:6720\n\t"
        "s_waitcnt lgkmcnt(0)"
        : "=&v"(r[0]), "=&v"(r[1]), "=&v"(r[2]), "=&v"(r[3]), "=&v"(r[4]), "=&v"(r[5]), "=&v"(r[6]), "=&v"(r[7])
        : "v"(addr) : "memory");
}
__device__ __forceinline__ void tr8_dsa0(unsigned addr, s16x4 (&r)[8]) {
    asm volatile(
        "ds_read_b64_tr_b16 %0, %8 offset:0\n\t"
        "ds_read_b64_tr_b16 %1, %8 offset:4352\n\t"
        "ds_read_b64_tr_b16 %2, %8 offset:32\n\t"
        "ds_read_b64_tr_b16 %3, %8 offset:4384\n\t"
        "ds_read_b64_tr_b16 %4, %8 offset:64\n\t"
        "ds_read_b64_tr_b16 %5, %8 offset:4416\n\t"
        "ds_read_b64_tr_b16 %6, %8 offset:96\n\t"
        "ds_read_b64_tr_b16 %7, %8 offset:4448\n\t"
        "s_waitcnt lgkmcnt(0)"
        : "=&v"(r[0]), "=&v"(r[1]), "=&v"(r[2]), "=&v"(r[3]), "=&v"(r[4]), "=&v"(r[5]), "=&v"(r[6]), "=&v"(r[7])
        : "v"(addr) : "memory");
}
__device__ __forceinline__ void tr8_dsa1(unsigned addr, s16x4 (&r)[8]) {
    asm volatile(
        "ds_read_b64_tr_b16 %0, %8 offset:128\n\t"
        "ds_read_b64_tr_b16 %1, %8 offset:4480\n\t"
        "ds_read_b64_tr_b16 %2, %8 offset:160\n\t"
        "ds_read_b64_tr_b16 %3, %8 offset:4512\n\t"
        "ds_read_b64_tr_b16 %4, %8 offset:192\n\t"
        "ds_read_b64_tr_b16 %5, %8 offset:4544\n\t"
        "ds_read_b64_tr_b16 %6, %8 offset:224\n\t"
        "ds_read_b64_tr_b16 %7, %8 offset:4576\n\t"
        "s_waitcnt lgkmcnt(0)"
        : "=&v"(r[0]), "=&v"(r[1]), "=&v"(r[2]), "=&v"(r[3]), "=&v"(r[4]), "=&v"(r[5]), "=&v"(r[6]), "=&v"(r[7])
        : "v"(addr) : "memory");
}
__device__ __forceinline__ void tr16_sb(unsigned addr, s16x4 (&r)[16]) {
    asm volatile(
        "ds_read_b64_tr_b16 %0, %16 offset:0\n\t"
        "ds_read_b64_tr_b16 %1, %16 offset:2176\n\t"
        "ds_read_b64_tr_b16 %2, %16 offset:4352\n\t"
        "ds_read_b64_tr_b16 %3, %16 offset:6528\n\t"
        "ds_read_b64_tr_b16 %4, %16 offset:64\n\t"
        "ds_read_b64_tr_b16 %5, %16 offset:2240\n\t"
        "ds_read_b64_tr_b16 %6, %16 offset:4416\n\t"
        "ds_read_b64_tr_b16 %7, %16 offset:6592\n\t"
        "ds_read_b64_tr_b16 %8, %16 offset:128\n\t"
        "ds_read_b64_tr_b16 %9, %16 offset:2304\n\t"
        "ds_read_b64_tr_b16 %10, %16 offset:4480\n\t"
        "ds_read_b64_tr_b16 %11, %16 offset:6656\n\t"
        "ds_read_b64_tr_b16 %12, %16 offset:192\n\t"
        "ds_read_b64_tr_b16 %13, %16 offset:2368\n\t"
        "ds_read_b64_tr_b16 %14, %16 offset:4544\n\t"
        "ds_read_b64_tr_b16 %15, %16 offset:6720\n\t"
        "s_waitcnt lgkmcnt(0)"
        : "=&v"(r[0]), "=&v"(r[1]), "=&v"(r[2]), "=&v"(r[3]), "=&v"(r[4]), "=&v"(r[5]), "=&v"(r[6]), "=&v"(r[7]), "=&v"(r[8]), "=&v"(r[9]), "=&v"(r[10]), "=&v"(r[11]), "=&v"(r[12]), "=&v"(r[13]), "=&v"(r[14]), "=&v"(r[15])
        : "v"(addr) : "memory");
}
__device__ __forceinline__ void tr16_dsa(unsigned addr, s16x4 (&r)[16]) {
    asm volatile(
        "ds_read_b64_tr_b16 %0, %16 offset:0\n\t"
        "ds_read_b64_tr_b16 %1, %16 offset:4352\n\t"
        "ds_read_b64_tr_b16 %2, %16 offset:32\n\t"
        "ds_read_b64_tr_b16 %3, %16 offset:4384\n\t"
        "ds_read_b64_tr_b16 %4, %16 offset:64\n\t"
        "ds_read_b64_tr_b16 %5, %16 offset:4416\n\t"
        "ds_read_b64_tr_b16 %6, %16 offset:96\n\t"
        "ds_read_b64_tr_b16 %7, %16 offset:4448\n\t"
        "ds_read_b64_tr_b16 %8, %16 offset:128\n\t"
        "ds_read_b64_tr_b16 %9, %16 offset:4480\n\t"
        "ds_read_b64_tr_b16 %10, %16 offset:160\n\t"
        "ds_read_b64_tr_b16 %11, %16 offset:4512\n\t"
        "ds_read_b64_tr_b16 %12, %16 offset:192\n\t"
        "ds_read_b64_tr_b16 %13, %16 offset:4544\n\t"
        "ds_read_b64_tr_b16 %14, %16 offset:224\n\t"
        "ds_read_b64_tr_b16 %15, %16 offset:4576\n\t"
        "s_waitcnt lgkmcnt(0)"
        : "=&v"(r[0]), "=&v"(r[1]), "=&v"(r[2]), "=&v"(r[3]), "=&v"(r[4]), "=&v"(r[5]), "=&v"(r[6]), "=&v"(r[7]), "=&v"(r[8]), "=&v"(r[9]), "=&v"(r[10]), "=&v"(r[11]), "=&v"(r[12]), "=&v"(r[13]), "=&v"(r[14]), "=&v"(r[15])
        : "v"(addr) : "memory");
}
__device__ __forceinline__ void sb_wave(const bf16_t* __restrict__ QB, const bf16_t* __restrict__ KB, const bf16_t* __restrict__ VB, int b, int h, int q0, LAS unsigned char* vt, f32x16 (&o)[4]) {
    int lane = threadIdx.x & 63; asm volatile("" : "+v"(lane));
    const int r32 = lane & 31, hi = lane >> 5;
    bf16x8_t bq[8];
    { const bf16_t* qp = QB + (size_t)(b * S + q0 + r32) * 1024 + h * 128 + 64 * hi;
#pragma unroll
      for (int s = 0; s < 8; ++s) bq[s] = *(const bf16x8_t*)(qp + 8 * s); }
#pragma unroll
    for (int c = 0; c < 4; ++c)
#pragma unroll
        for (int i = 0; i < 16; ++i) o[c][i] = 0.f;
    float carry = 0.f;
    const int q16 = lane & 15, tq = q16 >> 2, tp = q16 & 3, blk = (lane >> 4) & 1;
    const unsigned traddr = (unsigned)(uintptr_t)vt + VT_STRIDE * (4 * hi + tq) + 32 * blk + 16 * (tp >> 1) + 8 * (tp & 1);
    const bf16_t* kbase = KB + (size_t)b * S * 1024 + h * 128 + 64 * hi + (size_t)r32 * 1024;
    const bf16_t* vbase = VB + (size_t)b * S * 1024 + h * 128 + (size_t)(lane >> 4) * 1024 + 8 * (lane & 15);
    bf16x8_t kf[8]; u32x4 vr[8];
    { const int kt = q0 >> 5;
#pragma unroll
      for (int s = 0; s < 8; ++s) kf[s] = *(const bf16x8_t*)(kbase + (size_t)kt * 32 * 1024 + 8 * s);
#pragma unroll
      for (int i = 0; i < 8; ++i) vr[i] = *(const u32x4*)(vbase + (size_t)(kt * 32 + 4 * i) * 1024); }
    for (int kt = q0 >> 5; kt >= 0; --kt) {
        const int k0 = kt * 32;
#pragma unroll
        for (int i = 0; i < 8; ++i) *(LAS u32x4*)(vt + (4 * i + (lane >> 4)) * VT_STRIDE + 16 * (lane & 15)) = vr[i];
        f32x16 z;
#pragma unroll
        for (int i = 0; i < 16; ++i) z[i] = 0.f;
#pragma unroll
        for (int s = 0; s < 8; ++s) z = __builtin_amdgcn_mfma_f32_32x32x16_bf16(kf[s], bq[s], z, 0, 0, 0);
        { const int kn = kt > 0 ? kt - 1 : 0;
#pragma unroll
          for (int s = 0; s < 8; ++s) kf[s] = *(const bf16x8_t*)(kbase + (size_t)kn * 32 * 1024 + 8 * s);
#pragma unroll
          for (int i = 0; i < 8; ++i) vr[i] = *(const u32x4*)(vbase + (size_t)(kn * 32 + 4 * i) * 1024); }
        const bool diag = (k0 == q0);
        float lm[16], sg[4];
#pragma unroll
        for (int g = 0; g < 4; ++g) sg[g] = 0.f;
#pragma unroll
        for (int i = 0; i < 16; ++i) { const float zz = z[i]; const float sp = fmaxf(zz, 0.f) + __logf(1.f + __expf(-fabsf(zz)));
            const bool valid = !diag || (crow(i, hi) < r32);
            lm[i] = valid ? -sp : 0.f; z[i] = valid ? (zz - sp) : -INFINITY; sg[i >> 2] += lm[i]; }
        float psg[4];
#pragma unroll
        for (int g = 0; g < 4; ++g) psg[g] = __shfl_xor(sg[g], 32);
        float aft[4];
        { float run = carry;
#pragma unroll
          for (int g = 3; g >= 0; --g) { if (hi == 0) { run += psg[g]; aft[g] = run; run += sg[g]; } else { aft[g] = run; run += sg[g]; run += psg[g]; } }
          carry = run; }
        float av[16];
#pragma unroll
        for (int g = 0; g < 4; ++g) { float run = aft[g];
#pragma unroll
            for (int r = 3; r >= 0; --r) { const int i = 4 * g + r; av[i] = __expf(z[i] + run); run += lm[i]; } }
        bf16x8_t pa[2];
#pragma unroll
        for (int s = 0; s < 2; ++s) { u32x4 p; p.x = pg8::cvt_pk_bf16(av[8 * s], av[8 * s + 1]); p.y = pg8::cvt_pk_bf16(av[8 * s + 2], av[8 * s + 3]); p.z = pg8::cvt_pk_bf16(av[8 * s + 4], av[8 * s + 5]); p.w = pg8::cvt_pk_bf16(av[8 * s + 6], av[8 * s + 7]); pa[s] = __builtin_bit_cast(bf16x8_t, p); }
        LDS_WAIT();
#pragma unroll
        for (int half = 0; half < 2; ++half) {
            s16x4 tr[8];
            if (half == 0) tr8_sb0(traddr, tr); else tr8_sb1(traddr, tr);
#pragma unroll
            for (int cc = 0; cc < 2; ++cc)
#pragma unroll
                for (int s = 0; s < 2; ++s) {
                    const bf16x8_t vf = __builtin_shufflevector(tr[(cc * 2 + s) * 2], tr[(cc * 2 + s) * 2 + 1], 0, 1, 2, 3, 4, 5, 6, 7);
                    o[2 * half + cc] = __builtin_amdgcn_mfma_f32_32x32x16_bf16(vf, pa[s], o[2 * half + cc], 0, 0, 0);
                }
        }
        if (__all(carry <= SB_STOP)) break;
    }
}
__device__ __forceinline__ void tr_read2(unsigned a0, unsigned a1, s16x4& r0, s16x4& r1) {
    asm volatile("ds_read_b64_tr_b16 %0, %2\n\tds_read_b64_tr_b16 %1, %3\n\ts_waitcnt lgkmcnt(0)" : "=&v"(r0), "=&v"(r1) : "v"(a0), "v"(a1) : "memory"); }
__device__ __forceinline__ int wave_sum_i(int v) {
    v += __builtin_amdgcn_update_dpp(0, v, 0xB1, 0xF, 0xF, true);
    v += __builtin_amdgcn_update_dpp(0, v, 0x4E, 0xF, 0xF, true);
    v += __builtin_amdgcn_update_dpp(0, v, 0x141, 0xF, 0xF, true);
    v += __builtin_amdgcn_update_dpp(0, v, 0x140, 0xF, 0xF, true);
    return __builtin_amdgcn_readlane(v, 0) + __builtin_amdgcn_readlane(v, 16) + __builtin_amdgcn_readlane(v, 32) + __builtin_amdgcn_readlane(v, 48);
}
template <int NR>
__device__ __forceinline__ void topk_row(const float* __restrict__ row, int n, LAS unsigned short* sel, int lane_in) {
    int lane = lane_in; asm volatile("" : "+v"(lane));
    unsigned key[NR];
#pragma unroll
    for (int i = 0; i < NR; ++i) { const int s = lane + 64 * i; const float v = __hip_atomic_load(row + s, __ATOMIC_RELAXED, __HIP_MEMORY_SCOPE_AGENT); key[i] = s < n ? fkey(v) : 0u; }
    unsigned T = 0u; bool exact = false;
    for (int bit = 31; bit >= 0; --bit) {
        const unsigned cand = T | (1u << bit);
        int c = 0;
#pragma unroll
        for (int i = 0; i < NR; ++i) c += (key[i] >= cand) ? 1 : 0;
        c = wave_sum_i(c);
        if (c >= 256) { T = cand; if (c == 256) { exact = true; break; } }
    }
    const unsigned long long ltm = (1ull << lane) - 1ull;
    if (exact) {
        int base = 0;
#pragma unroll
        for (int i = 0; i < NR; ++i) {
            const bool take = key[i] >= T;
            const unsigned long long mt = __ballot(take);
            if (take) sel[base + __popcll(mt & ltm)] = (unsigned short)(lane + 64 * i);
            base += __popcll(mt);
        }
    } else {
        int cg = 0;
#pragma unroll
        for (int i = 0; i < NR; ++i) cg += (key[i] > T) ? 1 : 0;
        const int need = 256 - wave_sum_i(cg);
        int base = 0, run_eq = 0;
#pragma unroll 1
        for (int i = 0; i < NR; ++i) {
            unsigned k = key[0];
#pragma unroll
            for (int q = 1; q < NR; ++q) k = (i == q) ? key[q] : k;
            const bool gt = k > T, eq = (k == T);
            const unsigned long long meq = __ballot(eq);
            const bool take = gt || (eq && (run_eq + __popcll(meq & ltm)) < need);
            const unsigned long long mt = __ballot(take);
            if (take) sel[base + __popcll(mt & ltm)] = (unsigned short)(lane + 64 * i);
            base += __popcll(mt); run_eq += __popcll(meq);
        }
    }
}
__device__ __forceinline__ void dsa_token(const bf16_t* __restrict__ B0, const bf16_t* __restrict__ QA, const float* __restrict__ q_gain, const float* __restrict__ gn_a, bf16_t* __restrict__ O,
                                          int b, int t, int cnt, const LAS unsigned short* sel, const LAS float* s_bias, LAS unsigned char* vt) {
    int lane = threadIdx.x & 63; asm volatile("" : "+v"(lane));
    const int fr = lane & 15, g = lane >> 4, hd = fr & 7;
    const size_t m = (size_t)b * S + t;
    bf16x8_t bqa[4];
    {
        const bf16_t* qp = QA + m * 1024 + hd * 128 + 32 * g;
        float qf[32]; float ss = 0.f;
#pragma unroll
        for (int kk = 0; kk < 4; ++kk) { const u32x4 v = *(const u32x4*)(qp + 8 * kk);
#pragma unroll
            for (int j = 0; j < 4; ++j) { const unsigned w = v[j]; qf[8 * kk + 2 * j] = __uint_as_float(w << 16); qf[8 * kk + 2 * j + 1] = __uint_as_float(w & 0xffff0000u); } }
#pragma unroll
        for (int j = 0; j < 32; ++j) ss += qf[j] * qf[j];
        ss += __shfl_xor(ss, 16); ss += __shfl_xor(ss, 32);
        const float rs = (fr < 8) ? rsqrtf(ss * (1.f / 128.f) + EPS) * 0.08838834764831845f : 0.f;
        const float* gp = q_gain + 32 * g;
#pragma unroll
        for (int kk = 0; kk < 4; ++kk) { u32x4 p;
#pragma unroll
            for (int j = 0; j < 4; ++j) p[j] = pg8::cvt_pk_bf16(qf[8 * kk + 2 * j] * rs * gp[8 * kk + 2 * j], qf[8 * kk + 2 * j + 1] * rs * gp[8 * kk + 2 * j + 1]);
            bqa[kk] = __builtin_bit_cast(bf16x8_t, p); }
    }
    f32x4 lg[16];
    const bf16_t* kbase = B0 + (size_t)b * S * 1024 + 512 + 32 * g;
    bf16x8_t ka[4][4];
#define DSA_ISSUE_K(i, slot) do { const int s_ = sel[16 * (i) + fr]; const bf16_t* kp_ = kbase + (size_t)s_ * 1024; \
        _Pragma("unroll") for (int kk = 0; kk < 4; ++kk) ka[slot][kk] = *(const bf16x8_t*)(kp_ + 8 * kk); } while (0)
    DSA_ISSUE_K(0, 0); DSA_ISSUE_K(1, 1); DSA_ISSUE_K(2, 2); DSA_ISSUE_K(3, 3);
    asm volatile("" ::: "memory");
#pragma unroll
    for (int i = 0; i < 16; ++i) {
        f32x4 acc = (f32x4){0.f, 0.f, 0.f, 0.f};
#pragma unroll
        for (int kk = 0; kk < 4; ++kk) acc = __builtin_amdgcn_mfma_f32_16x16x32_bf16(ka[i & 3][kk], bqa[kk], acc, 0, 0, 0);
        lg[i] = acc;
        if (i + 4 < 16) DSA_ISSUE_K(i + 4, i & 3);
        asm volatile("" ::: "memory");
    }
#undef DSA_ISSUE_K
    const bf16_t* vb0 = B0 + (size_t)b * S * 1024 + 640 + 8 * (lane & 15);
    u32x4 vr[2][8];
#define DSA_ISSUE_V(ks, slot) do { _Pragma("unroll") for (int i = 0; i < 8; ++i) { const int s_ = sel[32 * (ks) + 4 * i + (lane >> 4)]; vr[slot][i] = *(const u32x4*)(vb0 + (size_t)s_ * 1024); } } while (0)
    DSA_ISSUE_V(0, 0);
    asm volatile("" ::: "memory");
    float mx = -INFINITY;
#pragma unroll
    for (int i = 0; i < 16; ++i) {
        const u32x2 sv = *(const LAS u32x2*)(sel + 16 * i + 4 * g);
#pragma unroll
        for (int r = 0; r < 4; ++r) { const int j = 16 * i + 4 * g + r; const int sj = (int)((r & 1) ? (sv[r >> 1] >> 16) : (sv[r >> 1] & 0xffffu));
            int d = t - sj; d = d < 0 ? 0 : (d > 127 ? 127 : d);
            const float v = (j < cnt) ? lg[i][r] + s_bias[d * 8 + hd] : -INFINITY; lg[i][r] = v; mx = fmaxf(mx, v); }
    }
    mx = fmaxf(mx, __shfl_xor(mx, 16)); mx = fmaxf(mx, __shfl_xor(mx, 32));
    float sm = 0.f;
#pragma unroll
    for (int i = 0; i < 16; ++i)
#pragma unroll
        for (int r = 0; r < 4; ++r) { const float p = __expf(lg[i][r] - mx); lg[i][r] = p; sm += p; }
    sm += __shfl_xor(sm, 16); sm += __shfl_xor(sm, 32);
    const float inv = 1.f / sm;
    bf16x8_t pa[8];
#pragma unroll
    for (int ks = 0; ks < 8; ++ks) { u32x4 p; const f32x4 p0 = lg[2 * ks], p1 = lg[2 * ks + 1];
        p.x = pg8::cvt_pk_bf16(p0[0], p0[1]); p.y = pg8::cvt_pk_bf16(p0[2], p0[3]); p.z = pg8::cvt_pk_bf16(p1[0], p1[1]); p.w = pg8::cvt_pk_bf16(p1[2], p1[3]);
        pa[ks] = __builtin_bit_cast(bf16x8_t, p); }
    f32x4 out[8];
#pragma unroll
    for (int c = 0; c < 8; ++c) out[c] = (f32x4){0.f, 0.f, 0.f, 0.f};
    const int tq = fr >> 2, tp = fr & 3;
    const unsigned traddr = (unsigned)(uintptr_t)vt + VT_STRIDE * (4 * g + tq) + 16 * (tp >> 1) + 8 * (tp & 1);
    DSA_ISSUE_V(1, 1);
    asm volatile("" ::: "memory");
#pragma unroll
    for (int ks = 0; ks < 8; ++ks) {
#pragma unroll
        for (int i = 0; i < 8; ++i) *(LAS u32x4*)(vt + (4 * i + (lane >> 4)) * VT_STRIDE + 16 * (lane & 15)) = vr[ks & 1][i];
        if (ks + 2 < 8) DSA_ISSUE_V(ks + 2, ks & 1);
        LDS_WAIT();
#pragma unroll
        for (int half = 0; half < 2; ++half) {
            s16x4 tr[8];
            if (half == 0) tr8_dsa0(traddr, tr); else tr8_dsa1(traddr, tr);
#pragma unroll
            for (int cc = 0; cc < 4; ++cc) {
                const bf16x8_t vf = __builtin_shufflevector(tr[2 * cc], tr[2 * cc + 1], 0, 1, 2, 3, 4, 5, 6, 7);
                out[4 * half + cc] = __builtin_amdgcn_mfma_f32_16x16x32_bf16(pa[ks], vf, out[4 * half + cc], 0, 0, 0);
            }
        }
        asm volatile("" ::: "memory");
    }
#undef DSA_ISSUE_V
    float invh[4];
#pragma unroll
    for (int r = 0; r < 4; ++r) invh[r] = __shfl(inv, 4 * (g & 1) + r);
    float ss = 0.f;
#pragma unroll
    for (int c = 0; c < 8; ++c)
#pragma unroll
        for (int r = 0; r < 4; ++r) { const float v = out[c][r] * invh[r]; out[c][r] = v; ss += (g < 2) ? v * v : 0.f; }
    const float rstd = rsqrtf(wave_sum(ss) * (1.f / 1024.f) + EPS);
    if (g < 2) {
#pragma unroll
        for (int c = 0; c < 8; ++c)
#pragma unroll
            for (int r = 0; r < 4; ++r) { const int e = (4 * g + r) * 128 + 16 * c + fr; O[m * D + e] = f2bf(out[c][r] * rstd * gn_a[e]); }
    }
}
__device__ __forceinline__ void idx4(const bf16_t* __restrict__ B0, const bf16_t* __restrict__ QI, int b, int t0, float* __restrict__ SCW) {
    int lane = threadIdx.x & 63; asm volatile("" : "+v"(lane));
    const int r32 = lane & 31, hi = lane >> 5;
    bf16x8_t aq[2][4]; float wv[2][16];
#pragma unroll
    for (int blk = 0; blk < 2; ++blk) {
        const int tt = (r32 >> 2) & 1, hh = (r32 & 3) + 4 * (r32 >> 3);
        const bf16_t* qp = QI + (size_t)(b * S + t0 + 2 * blk + tt) * 1024 + hh * 64 + 32 * hi;
#pragma unroll
        for (int kk = 0; kk < 4; ++kk) aq[blk][kk] = *(const bf16x8_t*)(qp + 8 * kk);
        const bf16_t* wp = B0 + (size_t)(b * S + t0 + 2 * blk + hi) * 1024 + 832;
        const u32x4 w0 = *(const u32x4*)wp, w1 = *(const u32x4*)(wp + 8);
#pragma unroll
        for (int j = 0; j < 4; ++j) { wv[blk][2 * j] = __uint_as_float(w0[j] << 16); wv[blk][2 * j + 1] = __uint_as_float(w0[j] & 0xffff0000u); wv[blk][8 + 2 * j] = __uint_as_float(w1[j] << 16); wv[blk][8 + 2 * j + 1] = __uint_as_float(w1[j] & 0xffff0000u); }
    }
    const bf16_t* kb = B0 + (size_t)(b * S + r32) * 1024 + 768 + 32 * hi;
    const int nsub = (t0 + 3) / 32 + 1;
    bf16x8_t bk[3][4];
#define IDX_ISSUE(sub, slot) do { const int sb_ = (sub) < nsub ? (sub) : nsub - 1; const bf16_t* p_ = kb + (size_t)sb_ * 32 * 1024; \
        _Pragma("unroll") for (int kk = 0; kk < 4; ++kk) bk[slot][kk] = *(const bf16x8_t*)(p_ + 8 * kk); } while (0)
    IDX_ISSUE(0, 0); IDX_ISSUE(1, 1); IDX_ISSUE(2, 2);
    for (int sub0 = 0; sub0 < nsub; sub0 += 3) {
#pragma unroll
        for (int j = 0; j < 3; ++j) {
            const int sub = sub0 + j;
            if (sub < nsub) {
#pragma unroll
                for (int blk = 0; blk < 2; ++blk) {
                    f32x16 sc;
#pragma unroll
                    for (int i = 0; i < 16; ++i) sc[i] = 0.f;
#pragma unroll
                    for (int kk = 0; kk < 4; ++kk) sc = __builtin_amdgcn_mfma_f32_32x32x16_bf16(aq[blk][kk], bk[j][kk], sc, 0, 0, 0);
                    float score = 0.f;
#pragma unroll
                    for (int i = 0; i < 16; ++i) score += wv[blk][i] * fmaxf(sc[i], 0.f);
                    SCW[(size_t)(2 * blk + hi) * 4096 + sub * 32 + r32] = score;
                }
            }
            IDX_ISSUE(sub + 3, j);
            asm volatile("" ::: "memory");
        }
    }
#undef IDX_ISSUE
}
__device__ __forceinline__ void p5_attn(const MkArgs& a, LAS unsigned char* lds) {
    const int tid = threadIdx.x, lane = tid & 63, wave = __builtin_amdgcn_readfirstlane(tid >> 6);
    const bf16_t* B0 = (const bf16_t*)(a.ws + WS_B0); const bf16_t* QI = (const bf16_t*)(a.ws + WS_QI); const bf16_t* QA = (const bf16_t*)(a.ws + WS_QA);
    const bf16_t* QB = (const bf16_t*)(a.ws + WS_QB); const bf16_t* KB = (const bf16_t*)(a.ws + WS_KB); const bf16_t* VB = (const bf16_t*)(a.ws + WS_VB);
    bf16_t* O = (bf16_t*)(a.ws + WS_O); float* OBS = (float*)(a.ws + WS_OBS); const float* rel_bias = a.in[10];
    const int gw = blockIdx.x * 8 + wave, NW = gridDim.x * 8;
    float* SCW = (float*)(a.ws + (gw < 1024 ? WS_XN : WS_OBRAW)) + (size_t)(gw & 1023) * (4 * 4096);
    LAS float* s_bias = (LAS float*)lds;
    LAS unsigned short* s_sel = (LAS unsigned short*)(lds + 4096 + wave * 2048);
    LAS unsigned char* s_vt = lds + 20480 + wave * 9216;
    for (int i = tid; i < 1024; i += MK_THREADS) s_bias[i] = rel_bias[t5_bucket(i >> 3) * 8 + (i & 7)];
    __syncthreads();
    const int xb = (blockIdx.x & 7) >> 1, rb = (((int)blockIdx.x >> 3) * 2 + ((int)blockIdx.x & 1)) * 8 + wave, RW = (gridDim.x >> 2) * 8;
    const bool xcd_ok = (gridDim.x & 7) == 0;
    for (int q = 0; ; ++q) {
        int G;
        if (xcd_ok) { const int gi = (q & 1) ? (q * RW + (RW - 1 - rb)) : (q * RW + rb); if (q * RW >= 1024) break; G = gi < 1024 ? gi * 4 + xb : 4096; }
        else { G = (q & 1) ? (q * NW + (NW - 1 - gw)) : (q * NW + gw); if (q * NW >= 4096) break; }
        if (G < 4096) {
            const int b = G & 3, t0 = (G >> 2) * 4;
            REP(50) idx4(B0, QI, b, t0, SCW);
            asm volatile("s_waitcnt vmcnt(0)" ::: "memory");
            REP(51) for (int tt = 0; tt < 4; ++tt) {
                const int t = t0 + tt, n = t + 1; const float* row = SCW + (size_t)tt * 4096; LAS unsigned short* sel = s_sel + tt * 256;
                if (n <= 256) { for (int i = 0; i < 4; ++i) { const int j = lane + 64 * i; sel[j] = (unsigned short)(j < n ? j : 0); } }
                else if (n <= 1024) topk_row<16>(row, n, sel, lane);
                else if (n <= 2048) topk_row<32>(row, n, sel, lane);
                else if (n <= 3072) topk_row<48>(row, n, sel, lane);
                else topk_row<64>(row, n, sel, lane);
            }
            LDS_WAIT();
            REP(52) for (int tt = 0; tt < 4; ++tt) {
                const int t = t0 + tt;
                dsa_token(B0, QA, a.in[8], a.in[11], O, b, t, t + 1 < 256 ? t + 1 : 256, s_sel + tt * 256, s_bias, s_vt);
            }
        }
        int U, ub;
        if (xcd_ok) { U = q * RW + rb; ub = xb; if (U >= 1024) U = 1 << 30; } else { const int u4 = q * NW + gw; U = u4 < 4096 ? (u4 >> 2) : (1 << 30); ub = u4 & 3; }
        REP(53) if (U < 1024) {
            const int h = U & 7, b = ub, q0 = (U >> 3) * 32;
            f32x16 o[4];
            sb_wave(QB, KB, VB, b, h, q0, s_vt, o);
            const int r32 = lane & 31, hi = lane >> 5;
            float ss = 0.f;
#pragma unroll
            for (int c = 0; c < 4; ++c)
#pragma unroll
                for (int i = 0; i < 16; ++i) ss += o[c][i] * o[c][i];
            ss += __shfl_xor(ss, 32);
            const size_t m = (size_t)b * S + q0 + r32;
            if (hi == 0) OBS[m * 8 + h] = ss;
            bf16_t* op = O + m * D + 1024 + h * 128;
#pragma unroll
            for (int c = 0; c < 4; ++c)
#pragma unroll
                for (int g = 0; g < 4; ++g) { const int d = 32 * c + 8 * g + 4 * hi;
                    u32x2 w; w.x = pk2(o[c][4 * g], o[c][4 * g + 1]); w.y = pk2(o[c][4 * g + 2], o[c][4 * g + 3]); *(u32x2*)(op + d) = w; }
        }
    }
}
__device__ __forceinline__ void obnorm_pass(const MkArgs& a) {
    const int tid = threadIdx.x, lane = tid & 63, wave = __builtin_amdgcn_readfirstlane(tid >> 6);
    bf16_t* O = (bf16_t*)(a.ws + WS_O); const float* OBS = (const float*)(a.ws + WS_OBS); const float* gn_b = a.in[12];
    f32x4 gv[4];
#pragma unroll
    for (int j = 0; j < 4; ++j) gv[j] = *(const f32x4*)(gn_b + 16 * lane + 4 * j);
    for (int m = blockIdx.x * 8 + wave; m < M; m += gridDim.x * 8) {
        const f32x4 s0 = *(const f32x4*)(OBS + (size_t)m * 8), s1 = *(const f32x4*)(OBS + (size_t)m * 8 + 4);
        const float rstd = rsqrtf(((s0[0] + s0[1]) + (s0[2] + s0[3]) + (s1[0] + s1[1]) + (s1[2] + s1[3])) * (1.f / 1024.f) + EPS);
        u32x4* p = (u32x4*)(O + (size_t)m * D + 1024 + 16 * lane);
        u32x4 v0 = p[0], v1 = p[1];
#pragma unroll
        for (int j = 0; j < 4; ++j) { const float lo0 = __uint_as_float(v0[j] << 16) * rstd, hi0 = __uint_as_float(v0[j] & 0xffff0000u) * rstd;
            const float lo1 = __uint_as_float(v1[j] << 16) * rstd, hi1 = __uint_as_float(v1[j] & 0xffff0000u) * rstd;
            v0[j] = pk2(lo0 * gv[j >> 1][2 * (j & 1)], hi0 * gv[j >> 1][2 * (j & 1) + 1]); v1[j] = pk2(lo1 * gv[2 + (j >> 1)][2 * (j & 1)], hi1 * gv[2 + (j >> 1)][2 * (j & 1) + 1]); }
        p[0] = v0; p[1] = v1;
    }
}

constexpr int CW_BAR = 4096;
__global__ void __launch_bounds__(MK_THREADS, 2) mk_fwd(MkArgs a) {
    extern __shared__ __attribute__((aligned(16))) unsigned char lds_raw[];
    LAS unsigned char* lds = (LAS unsigned char*)lds_raw;
    const int lo = a.ph_lo, hi = a.ph_hi;
    const bool fused = (hi - lo) > 1;
    volatile LAS unsigned* misc = (volatile LAS unsigned*)(lds + MK_MISC_OFF);
    XcdBarrier bar; bar.bar = (unsigned*)(a.ws + WS_CTL) + CW_BAR; bar.x = 0; bar.st = misc + 8;
    if (fused) {
        if (threadIdx.x < 32) misc[threadIdx.x] = 0u;
        __syncthreads();
        bar = xcd_barrier_post((unsigned*)(a.ws + WS_CTL) + CW_BAR, misc + 8);
    }
    int nbar = 0;
#ifdef MK_TS_A
    volatile LAS unsigned* ts_ = (volatile LAS unsigned*)(lds + MK_MISC_OFF + 128); int nts_ = 0;
#define STAMP() do { if (threadIdx.x == 0) ts_[nts_] = (unsigned)__builtin_amdgcn_s_memrealtime(); ++nts_; } while (0)
#else
#define STAMP() do {} while (0)
#endif
    STAMP();
#define IN(k) (lo <= (k) && (k) < hi)
#define SEAM() do { if (fused) { if (nbar == 0) cg::this_grid().sync(); else xcd_barrier(bar); ++nbar; } STAMP(); } while (0)
    if (IN(0)) { REP(0) { p0_prep(a, lds); __syncthreads(); } SEAM(); }
    if (IN(1)) { REP(1) { p1_xn(a, lds); __syncthreads(); } SEAM(); }
    if (IN(2)) {
        pg8::Gemm g{(const bf16_t*)(a.ws + WS_XN), (const bf16_t*)(a.ws + WS_WTIN), M, 4096, D, D, D};
        pg8::StaticOrder S; S.init(g, (int)gridDim.x, (int)blockIdx.x);
        EpiInProj E{(bf16_t*)(a.ws + WS_B0), (bf16_t*)(a.ws + WS_QB), (bf16_t*)(a.ws + WS_KB), (bf16_t*)(a.ws + WS_VB), (float*)(a.ws + WS_SSQ)};
        REP(2) pg8::gemm_phase<EpiInProj, pg8::StaticOrder>(lds, g, S, E);
        SEAM();
    }
    if (IN(3)) {
        kanorm_pass(a);
        pg8::Gemm g{(const bf16_t*)(a.ws + WS_B0), (const bf16_t*)(a.ws + WS_WTQUP), M, 2048, 512, 1024, 512};
        pg8::StaticOrder S; S.init(g, (int)gridDim.x, (int)blockIdx.x);
        EpiQupG E{(const float*)(a.ws + WS_SSQ), (bf16_t*)(a.ws + WS_QA), (bf16_t*)(a.ws + WS_QI)};
        REP(3) pg8::gemm_phase<EpiQupG, pg8::StaticOrder>(lds, g, S, E);
        SEAM();
    }
    if (IN(5)) { REP(5) { p5_attn(a, lds); __syncthreads(); } SEAM(); }
    if (IN(7)) {
        obnorm_pass(a);
        pg8::Gemm g{(const bf16_t*)(a.ws + WS_O), (const bf16_t*)(a.ws + WS_WTOUT), M, D, D, D, D};
        pg8::StaticOrder S; S.init(g, (int)gridDim.x, (int)blockIdx.x);
        EpiOutProj E{a.in[0], (const float*)(a.ws + WS_MOD), a.out};
        REP(7) pg8::gemm_phase<EpiOutProj, pg8::StaticOrder>(lds, g, S, E);
        SEAM();
    }
    if (IN(8)) { p8_route(a, lds); SEAM(); }
    if (IN(9)) {
        const MoeTab t = moe_tab_build(a, lds);
        pg8::Gemm g{(const bf16_t*)(a.ws + WS_XN), (const bf16_t*)(a.ws + WS_WTGU), 0, 0, D, D, D};
        SchedGU S; S.init(t, a, (int)gridDim.x, (int)blockIdx.x);
        EpiGU E{(bf16_t*)(a.ws + WS_U)};
        REP(9) pg8::gemm_phase<EpiGU, SchedGU>(lds, g, S, E);
        SEAM();
    }
    for (int slot = 0; slot < 2; ++slot) if (IN(10 + slot)) {
        const MoeTab t = moe_tab_build(a, lds);
        pg8::Gemm g{(const bf16_t*)(a.ws + WS_U), (const bf16_t*)(a.ws + WS_WTDN), 0, 0, 512, 512, 512};
        SchedDN S; S.init(t, a, slot, (int)gridDim.x, (int)blockIdx.x);
        EpiDown E{t, slot, (const int*)(a.ws + WS_LIST), (const float*)(a.ws + WS_GW), (const float*)(a.ws + WS_MOD), a.out};
        pg8::gemm_phase<EpiDown, SchedDN>(lds, g, S, E);
        if (slot == 0) SEAM();
    }
#ifdef MK_TS_A
    SEAM();
    __syncthreads();
    if (blockIdx.x == 0) {
        const float da = (MK_TS_A == 11) ? (float)(ts_[11] - ts_[0]) * 0.01f : (float)(ts_[MK_TS_A + 1] - ts_[MK_TS_A]) * 0.01f;
        const float db = (MK_TS_B == 11) ? (float)(ts_[11] - ts_[0]) * 0.01f : (float)(ts_[MK_TS_B + 1] - ts_[MK_TS_B]) * 0.01f;
        if (threadIdx.x == 0) a.out[0] += da;
        for (int i = threadIdx.x; i < (1 << 20); i += MK_THREADS) a.out[4096 + i] *= (1.f + db * (1.f / 250.f));
    }
#endif
#undef IN
#undef SEAM
}

#ifndef MK_ONE_LAUNCH
#define MK_ONE_LAUNCH 1
#endif
extern "C" void kernel_launch(void* const* d_in, const int* in_sizes, int n_in, void* d_out, int out_size, void* d_ws, size_t ws_size, hipStream_t stream) {
    static int grid = 0;
    if (grid == 0) {
        if (ws_size < WS_END || n_in != 20 || out_size != M * D) { fprintf(stderr, "kernel_launch: unexpected sizes: ws %zu (need %zu), n_in %d, out %d\n", ws_size, (size_t)WS_END, n_in, out_size); grid = -1; return; }
        int dev = 0, cus = 0, per_cu = 0;
        if (hipGetDevice(&dev) != hipSuccess || hipDeviceGetAttribute(&cus, hipDeviceAttributeMultiprocessorCount, dev) != hipSuccess) { grid = -1; return; }
        if (hipFuncSetAttribute((const void*)mk_fwd, hipFuncAttributeMaxDynamicSharedMemorySize, MK_LDS) != hipSuccess) { fprintf(stderr, "kernel_launch: hipFuncSetAttribute failed\n"); grid = -1; return; }
        if (hipOccupancyMaxActiveBlocksPerMultiprocessor(&per_cu, (const void*)mk_fwd, MK_THREADS, MK_LDS) != hipSuccess || per_cu < 1) { fprintf(stderr, "kernel_launch: occupancy query failed (%d)\n", per_cu); grid = -1; return; }
        grid = cus < 256 ? cus : 256;
        fprintf(stderr, "kernel_launch: cus %d per_cu %d grid %d\n", cus, per_cu, grid);
    }
    if (grid < 0) return;
    if (hipMemsetAsync(d_ws, 0, 1 * MiB, stream) != hipSuccess) return;
    MkArgs a{};
    for (int i = 0; i < 20; ++i) a.in[i] = (const float*)d_in[i];
    a.out = (float*)d_out; a.ws = (unsigned char*)d_ws;
#if MK_ONE_LAUNCH
    a.ph_lo = 0; a.ph_hi = 12;
    void* args[] = {&a};
    const hipError_t e = hipLaunchCooperativeKernel((const void*)mk_fwd, dim3(grid), dim3(MK_THREADS), args, MK_LDS, stream);
    if (e != hipSuccess) fprintf(stderr, "kernel_launch: cooperative launch failed: %s (grid %d)\n", hipGetErrorString(e), grid);
#else
    const int phases[] = {0, 1, 2, 3, 5, 7, 8, 9, 10, 11};
    for (int ph : phases) { a.ph_lo = ph; a.ph_hi = ph + 1; hipLaunchKernelGGL(mk_fwd, dim3(grid), dim3(MK_THREADS), MK_LDS, stream, a); }
#endif
}
```

```cpp
#include <hip/hip_runtime.h>
#include <hip/hip_cooperative_groups.h>
#include <stdint.h>
#include <cstdio>
namespace cg = cooperative_groups;

typedef unsigned short bf16_t;
#define LAS __attribute__((address_space(3)))

constexpr int D = 2048, NB = 4, S = 4096, M = NB * S;
constexpr int NMOD = 6 * D;
constexpr int DIN = 3920;
constexpr float EPS = 1e-6f;
constexpr size_t MiB = 1ull << 20;
constexpr size_t WS_CTL = 0;
constexpr size_t WS_MOD = 1 * MiB;
constexpr size_t WS_RC = 2 * MiB;
constexpr size_t WS_EID = 3 * MiB;
constexpr size_t WS_GW = 4 * MiB;
constexpr size_t WS_SSQ = 5 * MiB;
constexpr size_t WS_XN = 8 * MiB;
constexpr size_t WS_B0 = 72 * MiB;
constexpr size_t WS_QB = 104 * MiB;
constexpr size_t WS_KB = 136 * MiB;
constexpr size_t WS_VB = 168 * MiB;
constexpr size_t WS_QA = 200 * MiB;
constexpr size_t WS_QI = 232 * MiB;
constexpr size_t WS_SEL = 264 * MiB;
constexpr size_t WS_O = 272 * MiB;
constexpr size_t WS_OBRAW = 336 * MiB;
constexpr size_t WS_MODP = 400 * MiB;
constexpr size_t WS_WTIN = 408 * MiB;
constexpr size_t WS_WTQUP = 424 * MiB;
constexpr size_t WS_WTOUT = 426 * MiB;
constexpr size_t WS_WTGU = 434 * MiB;
constexpr size_t WS_WTDN = 562 * MiB;
constexpr size_t WS_RT = 6 * MiB;
constexpr size_t WS_LIST = WS_B0;
constexpr size_t WS_U = WS_O;
constexpr size_t WS_Y = WS_QB;
constexpr size_t WS_OBS = 7 * MiB;
constexpr int CW_CNT = 8192;
constexpr size_t WS_END = 626 * MiB;

__device__ __forceinline__ float bf2f(bf16_t v) { return __uint_as_float(((unsigned)v) << 16); }
__device__ __forceinline__ bf16_t f2bf(float f) { unsigned u = __float_as_uint(f); u += 0x7fffu + ((u >> 16) & 1u); return (bf16_t)(u >> 16); }
__device__ __forceinline__ float silu_f(float v) { return v / (1.f + __expf(-v)); }
__device__ __forceinline__ unsigned fkey(float f) { const unsigned u = __float_as_uint(f); return (u & 0x80000000u) ? ~u : (u | 0x80000000u); }
__device__ __forceinline__ int t5_bucket(int dist) {
    if (dist < 16) return dist;
    int large = 16 + (int)(__logf((float)dist * (1.f / 16.f)) / 2.0794415416798357f * 16.f);
    return large < 31 ? large : 31;
}

namespace pg8 {
#define PG8_LAS __attribute__((address_space(3)))
typedef short bf16x8 __attribute__((ext_vector_type(8)));
typedef float f32x4 __attribute__((ext_vector_type(4)));
typedef unsigned u32x4 __attribute__((ext_vector_type(4)));
constexpr int BM = 256, BK = 64, HALF = 128, HTB = HALF * BK * 2, STAGE_BYTES = 8 * HTB, NXCD = 8, WGM = 8;
__host__ __device__ __forceinline__ int lds_byte(int r, int c) { const int st = (r >> 4) * 2 + (c >> 5), rr = r & 15, cc = c & 31, ob = rr * 64 + cc * 2; return st * 1024 + (ob ^ (((ob >> 9) & 1) << 5)); }
__host__ __device__ __forceinline__ void stage_rc(int b, int& R, int& C) { const int st = b / 1024, sb = b % 1024, swz = sb ^ (((sb >> 9) & 1) << 5); R = (st >> 1) * 16 + swz / 64; C = (st & 1) * 32 + (swz % 64) / 2; }
__host__ __device__ __forceinline__ int perm32(int rho) { const int n = rho >> 4, i = rho & 15; return 8 * (i >> 2) + 4 * n + (i & 3); }
__device__ __forceinline__ unsigned cvt_pk_bf16(float lo, float hi) { unsigned r; asm volatile("v_cvt_pk_bf16_f32 %0, %1, %2" : "=v"(r) : "v"(lo), "v"(hi)); return r; }

struct Unit { int pm, pn, aux, dup; const char* a; const char* b; unsigned va[2][2]; };
struct Gemm { const bf16_t* A; const bf16_t* Bt; int M, N, K, lda, ldb; };

struct StaticOrder {
    int nM, nN, nwg, G, c, ndup; const char* A; const char* Bt; size_t tstepA, tstepB; unsigned vb[2][2];
    __device__ void init(const Gemm& g, int G_, int c_, int ndup_ = 1) { ndup = ndup_; nM = g.M / BM; nN = g.N / BM; nwg = nM * nN; G = G_; c = c_; A = (const char*)g.A; Bt = (const char*)g.Bt; tstepA = (size_t)BM * g.lda * 2; tstepB = (size_t)BM * g.ldb * 2;
#pragma unroll
        for (int i = 0; i < 2; ++i) { int R, C; stage_rc((int)threadIdx.x * 16 + i * 8192, R, C); vb[0][i] = (unsigned)(R * g.lda + C) * 2u; vb[1][i] = (unsigned)((HALF + R) * g.lda + C) * 2u; } }
    __device__ bool next(int i, Unit& u) const {
        const long L0 = (long)i * G + c; if (L0 >= (long)nwg * ndup) return false;
        u.dup = (int)(L0 / nwg); int wgid = (int)(L0 % nwg); { const int q = nwg / NXCD, r = nwg % NXCD, xcd = wgid % NXCD, off = wgid / NXCD; wgid = (xcd < r ? xcd * (q + 1) : r * (q + 1) + (xcd - r) * q) + off; }
        const int nig = WGM * nN, gid = wgid / nig, fm = gid * WGM, gsz = (nM - fm) < WGM ? (nM - fm) : WGM;
        u.pm = fm + ((wgid % nig) % gsz); u.pn = (wgid % nig) / gsz;
        u.a = A + (size_t)u.pm * tstepA; u.b = Bt + (size_t)u.pn * tstepB; u.aux = 0; u.va[0][0] = vb[0][0]; u.va[0][1] = vb[0][1]; u.va[1][0] = vb[1][0]; u.va[1][1] = vb[1][1]; return true;
    }
};

template <class Epi, class Sched>
__device__ __forceinline__ void gemm_phase(PG8_LAS unsigned char* lds, const Gemm g, const Sched& S, const Epi& E) {
    const int tid = threadIdx.x, wid = __builtin_amdgcn_readfirstlane(tid >> 6), lane = tid & 63, wr = wid >> 2, wc = wid & 3, fr = lane & 15, fq = lane >> 4;
    const int K = g.K, nt = K / BK;
    unsigned voffB[2];
#pragma unroll
    for (int i = 0; i < 2; ++i) { int R, C; stage_rc(tid * 16 + i * 8192, R, C); const int Rb = Epi::PERM ? ((R & ~31) + perm32(R & 31)) : R;
        voffB[i] = (unsigned)(Rb * g.ldb + C) * 2u; }
    const size_t kstep = (size_t)(BK * 2);
    const size_t hstepB = (size_t)HALF * g.ldb * 2;
    const unsigned ldsw = (unsigned)wid * 1024u;
    const int aoff = lds_byte(wr * 64 + fr, fq * 8), boff = lds_byte(wc * 32 + fr, fq * 8);
#define PG8_SA(b, h) (((b) * 2 + (h)) * HTB)
#define PG8_SB(b, h) ((4 + (b) * 2 + (h)) * HTB)
#define PG8_STAGE(bufoff, gbase, voff) do { _Pragma("unroll") for (int _i = 0; _i < 2; ++_i) \
        __builtin_amdgcn_global_load_lds((const unsigned*)((const char*)(gbase) + (voff)[_i]), (PG8_LAS unsigned*)(lds + (bufoff) + ldsw + _i * 8192), 16, 0, 0); } while (0)
#define PG8_LDA(dst, b, h) do { _Pragma("unroll") for (int m = 0; m < 4; ++m) _Pragma("unroll") for (int k = 0; k < 2; ++k) dst[m][k] = *(const PG8_LAS bf16x8*)(lds + PG8_SA(b, h) + aoff + m * 2048 + k * 1024); } while (0)
#define PG8_LDB(dst, b, h) do { _Pragma("unroll") for (int n = 0; n < 2; ++n) _Pragma("unroll") for (int k = 0; k < 2; ++k) dst[n][k] = *(const PG8_LAS bf16x8*)(lds + PG8_SB(b, h) + boff + n * 2048 + k * 1024); } while (0)
#define PG8_MMA(ai, bj, At, Bt) do { __builtin_amdgcn_s_setprio(1); _Pragma("unroll") for (int m = 0; m < 4; ++m) _Pragma("unroll") for (int n = 0; n < 2; ++n) _Pragma("unroll") for (int k = 0; k < 2; ++k) \
        acc[ai][bj][m][n] = __builtin_amdgcn_mfma_f32_16x16x32_bf16(Bt[n][k], At[m][k], acc[ai][bj][m][n], 0, 0, 0); __builtin_amdgcn_s_setprio(0); } while (0)
#define PG8_WAIT_V(n) asm volatile("s_waitcnt vmcnt(" #n ")" ::: "memory")
#define PG8_WAIT_L(n) asm volatile("s_waitcnt lgkmcnt(" #n ")" ::: "memory")
#define PG8_BAR __builtin_amdgcn_s_barrier()
#define PG8_SCHED __builtin_amdgcn_sched_barrier(0)
    Unit cur, nxt; int ui = 0;
    if (!S.next(0, cur)) return;
    f32x4 acc[2][2][4][2];
#pragma unroll
    for (int a = 0; a < 2; ++a)
#pragma unroll
        for (int b = 0; b < 2; ++b)
#pragma unroll
            for (int m = 0; m < 4; ++m)
#pragma unroll
                for (int n = 0; n < 2; ++n) acc[a][b][m][n] = (f32x4){0.f, 0.f, 0.f, 0.f};
    bf16x8 At[4][2], B0[2][2], B1[2][2];
    const char* cA = cur.a; const char* cB = cur.b;
    PG8_STAGE(PG8_SB(0, 0), cB, voffB); PG8_STAGE(PG8_SB(0, 1), cB + hstepB, voffB); PG8_STAGE(PG8_SA(0, 0), cA, cur.va[0]); PG8_STAGE(PG8_SA(0, 1), cA, cur.va[1]);
    if (wr == 1) PG8_BAR;
    PG8_WAIT_V(2); PG8_BAR;
    PG8_STAGE(PG8_SB(1, 0), cB + kstep, voffB); PG8_STAGE(PG8_SA(1, 0), cA + kstep, cur.va[0]); PG8_STAGE(PG8_SB(1, 1), cB + hstepB + kstep, voffB);
    PG8_WAIT_V(6); PG8_BAR;
    for (;;) {
        const bool has_next = S.next(ui + 1, nxt);
        if (!has_next) nxt = cur;
        const char* nA = has_next ? nxt.a : cA; const char* nB = has_next ? nxt.b : cB;
        for (int t = 0; t < nt; t += 2) {
            const bool last = (t == nt - 2);
            const char* a1 = cA + (size_t)(t + 1) * kstep;
            const char* a2 = last ? nA : cA + (size_t)(t + 2) * kstep; const char* b2 = last ? nB : cB + (size_t)(t + 2) * kstep;
            const char* a3 = a2 + kstep; const char* b3 = b2 + kstep;
            unsigned vn0[2], vn1[2];
            vn0[0] = last ? nxt.va[0][0] : cur.va[0][0]; vn0[1] = last ? nxt.va[0][1] : cur.va[0][1]; vn1[0] = last ? nxt.va[1][0] : cur.va[1][0]; vn1[1] = last ? nxt.va[1][1] : cur.va[1][1];
            PG8_LDB(B0, 0, 0); PG8_LDB(B1, 0, 1); PG8_SCHED; PG8_LDA(At, 0, 0); PG8_STAGE(PG8_SA(1, 1), a1, cur.va[1]);
            PG8_WAIT_V(8); PG8_WAIT_L(0); PG8_BAR; PG8_MMA(0, 0, At, B0); PG8_MMA(0, 1, At, B1); PG8_BAR; PG8_SCHED;
            PG8_LDA(At, 0, 1); PG8_STAGE(PG8_SB(0, 0), b2, voffB); PG8_STAGE(PG8_SB(0, 1), b2 + hstepB, voffB); PG8_STAGE(PG8_SA(0, 0), a2, vn0);
            PG8_WAIT_V(8); PG8_WAIT_L(0); PG8_BAR; PG8_MMA(1, 0, At, B0); PG8_MMA(1, 1, At, B1); PG8_BAR; PG8_SCHED;
            PG8_LDB(B0, 1, 0); PG8_LDB(B1, 1, 1); PG8_SCHED; PG8_LDA(At, 1, 0); PG8_STAGE(PG8_SA(0, 1), a2, vn1);
            PG8_WAIT_V(8); PG8_WAIT_L(0); PG8_BAR; PG8_MMA(0, 0, At, B0); PG8_MMA(0, 1, At, B1); PG8_BAR; PG8_SCHED;
            PG8_LDA(At, 1, 1); PG8_STAGE(PG8_SB(1, 0), b3, voffB); PG8_STAGE(PG8_SB(1, 1), b3 + hstepB, voffB); PG8_STAGE(PG8_SA(1, 0), a3, vn0);
            PG8_WAIT_V(8); PG8_WAIT_L(0); PG8_BAR; PG8_MMA(1, 0, At, B0); PG8_MMA(1, 1, At, B1); PG8_BAR; PG8_SCHED;
        }
        if (wr == 0) PG8_BAR;
        E(acc, cur, wr, wc, fr, fq);
        if (!has_next) break;
#pragma unroll
        for (int a = 0; a < 2; ++a)
#pragma unroll
            for (int b = 0; b < 2; ++b)
#pragma unroll
                for (int m = 0; m < 4; ++m)
#pragma unroll
                    for (int n = 0; n < 2; ++n) acc[a][b][m][n] = (f32x4){0.f, 0.f, 0.f, 0.f};
        cur = nxt; cA = nA; cB = nB; ++ui;
        if (wr == 1) PG8_BAR;
    }
    PG8_WAIT_V(0);
    PG8_BAR;
#undef PG8_SA
#undef PG8_SB
#undef PG8_STAGE
#undef PG8_LDA
#undef PG8_LDB
#undef PG8_MMA
#undef PG8_WAIT_V
#undef PG8_WAIT_L
#undef PG8_BAR
#undef PG8_SCHED
}
}
#ifndef MK_DUP
#define MK_DUP -1
#endif
#define REP(k) for (int rep_ = 0; rep_ < ((MK_DUP) == (k) ? 2 : 1); ++rep_)

#define XB_TMO      128
#define XB_XCNT(j)  (256  + 64 * (j))
#define XB_XSUB(j)  (1280 + 64 * (j))
#define XB_XGEN(j)  (2304 + 64 * (j))
#define XB_TOP      3328
#define XB_TOPGEN   3392
#define XCD_BAR_WORDS 3456
#define XB_SPIN_CAP (1u << 18)
__device__ __forceinline__ unsigned xb_ld(unsigned* p)              { return __hip_atomic_load(p, __ATOMIC_RELAXED, __HIP_MEMORY_SCOPE_AGENT); }
__device__ __forceinline__ unsigned xb_add(unsigned* p, unsigned v) { return __hip_atomic_fetch_add(p, v, __ATOMIC_RELAXED, __HIP_MEMORY_SCOPE_AGENT); }
__device__ __forceinline__ unsigned xb_xcc_id() { return (unsigned)__builtin_amdgcn_s_getreg((3 << 11) | 20) & 0xFu; }
#define XB_SPIN(cond, bar) do { unsigned _sp = 0; while (cond) { __builtin_amdgcn_s_sleep(1); \
    if ((++_sp & 255u) == 0u) { if (xb_ld(&(bar)[XB_TMO])) break; if (_sp > XB_SPIN_CAP) { atomicAdd(&(bar)[XB_TMO], 1u); break; } } } } while (0)
struct XcdBarrier { unsigned* bar; unsigned x; volatile LAS unsigned* st; };
__device__ __forceinline__ XcdBarrier xcd_barrier_post(unsigned* bar, volatile LAS unsigned* st) {
    XcdBarrier b; b.bar = bar; b.x = xb_xcc_id(); b.st = st;
    if (threadIdx.x == 0) (void)xb_add(&bar[XB_XCNT(b.x)], 1u);
    return b;
}
__device__ __forceinline__ void xcd_barrier_complete(unsigned* bar, unsigned x, unsigned& nloc, unsigned& nx) {
    const unsigned G = gridDim.x * gridDim.y * gridDim.z;
    unsigned sum, cnt, mine, sp = 0u;
    for (;;) {
        sum = 0u; cnt = 0u; mine = 0u;
#pragma unroll
        for (unsigned j = 0; j < 16; ++j) { const unsigned c = xb_ld(&bar[XB_XCNT(j)]); sum += c; cnt += (c > 0u) ? 1u : 0u; mine = (j == x) ? c : mine; }
        if (sum == G) break;
        __builtin_amdgcn_s_sleep(1);
        if ((++sp & 255u) == 0u) { if (xb_ld(&bar[XB_TMO])) break; if (sp > XB_SPIN_CAP) { atomicAdd(&bar[XB_TMO], 1u); break; } }
    }
    nloc = mine > 0u ? mine : 1u; nx = cnt > 0u ? cnt : 1u;
}
__device__ __forceinline__ void xcd_barrier(const XcdBarrier& b) {
    asm volatile("s_waitcnt vmcnt(0)" ::: "memory");
    __syncthreads();
    if (threadIdx.x == 0) {
        unsigned* bar = b.bar;
        __builtin_amdgcn_s_waitcnt(0);
        unsigned nloc = b.st[0], nx = b.st[1];
        if (nloc == 0u) { xcd_barrier_complete(bar, b.x, nloc, nx); b.st[0] = nloc; b.st[1] = nx; }
        const unsigned old = xb_add(&bar[XB_XSUB(b.x)], 1u);
        const unsigned gen = old / nloc;
        if (old + 1u == (gen + 1u) * nloc) {
            __builtin_amdgcn_fence(__ATOMIC_RELEASE, "agent");
            asm volatile("s_waitcnt vmcnt(0)" ::: "memory");
            const unsigned og = xb_add(&bar[XB_TOP], 1u);
            const unsigned tg = og / nx;
            if (og + 1u == (tg + 1u) * nx) xb_add(&bar[XB_TOPGEN], 1u);
            else XB_SPIN(xb_ld(&bar[XB_TOPGEN]) == tg, bar);
            __builtin_amdgcn_fence(__ATOMIC_ACQUIRE, "agent");
            xb_add(&bar[XB_XGEN(b.x)], 1u);
            asm volatile("s_waitcnt vmcnt(0)" ::: "memory");
        } else {
            XB_SPIN(xb_ld(&bar[XB_XGEN(b.x)]) == gen, bar);
            __builtin_amdgcn_fence(__ATOMIC_ACQUIRE, "agent");
            asm volatile("s_waitcnt vmcnt(0)" ::: "memory");
        }
    }
    __syncthreads();
}

constexpr int MK_THREADS = 512, MK_LDS = 155648, MK_MISC_OFF = 147456, MK_MOE_OFF = 147456 + 256;
struct MkArgs { const float* in[20]; float* out; unsigned char* ws; int ph_lo, ph_hi; };
typedef float f32x4 __attribute__((ext_vector_type(4)));
typedef unsigned u32x4 __attribute__((ext_vector_type(4)));
typedef unsigned u32x2 __attribute__((ext_vector_type(2)));
#define LDS_WAIT() asm volatile("s_waitcnt lgkmcnt(0)" ::: "memory")
__device__ __forceinline__ unsigned pk2(float lo, float hi) { return (unsigned)f2bf(lo) | ((unsigned)f2bf(hi) << 16); }
__device__ __forceinline__ float wave_sum(float v) {
#pragma unroll
    for (int o = 1; o < 64; o <<= 1) v += __shfl_xor(v, o);
    return v;
}

constexpr int TR_SCR = 64 * 68 * 4;
template <class RowMap>
__device__ __forceinline__ void tr_item(const float* __restrict__ W, int K, int N, bf16_t* __restrict__ WT, LAS float* scr, int item, int lane, const float* __restrict__ kscale, RowMap rm) {
    const int nblk = (N + 63) / 64, kb = item / nblk, nb = item % nblk, k0 = 64 * kb, n0 = 64 * nb;
    const int n4 = lane & 15, ks = lane >> 4, nn = n0 + 4 * n4;
    f32x4 v[16];
    if (nn + 3 < N) {
#pragma unroll
        for (int i = 0; i < 16; ++i) v[i] = *(const f32x4*)(W + (size_t)(k0 + 4 * i + ks) * N + nn);
    } else {
#pragma unroll
        for (int i = 0; i < 16; ++i) { const float* p = W + (size_t)(k0 + 4 * i + ks) * N; v[i] = (f32x4){nn < N ? p[nn] : 0.f, nn + 1 < N ? p[nn + 1] : 0.f, nn + 2 < N ? p[nn + 2] : 0.f, 0.f}; }
    }
#pragma unroll
    for (int i = 0; i < 16; ++i) { f32x4 x = v[i]; if (kscale) x = x * kscale[k0 + 4 * i + ks]; *(LAS f32x4*)(scr + (4 * i + ks) * 68 + 4 * n4) = x; }
    LDS_WAIT(); asm volatile("" ::: "memory");
    const int n = n0 + lane;
    float sc = 1.f; int r = 0;
    if (n < N) r = rm(n, sc);
#pragma unroll
    for (int j = 0; j < 8; ++j) {
        const LAS float* s = scr + (8 * j) * 68 + lane;
        u32x4 o; o.x = pk2(s[0 * 68] * sc, s[1 * 68] * sc); o.y = pk2(s[2 * 68] * sc, s[3 * 68] * sc); o.z = pk2(s[4 * 68] * sc, s[5 * 68] * sc); o.w = pk2(s[6 * 68] * sc, s[7 * 68] * sc);
        if (n < N) *(u32x4*)(WT + (size_t)r * K + k0 + 8 * j) = o;
    }
    LDS_WAIT(); asm volatile("" ::: "memory");
}

__device__ __forceinline__ void p0_prep(const MkArgs& a, LAS unsigned char* lds) {
    const int tid = threadIdx.x, lane = tid & 63, wave = __builtin_amdgcn_readfirstlane(tid >> 6);
    const float* c = a.in[1]; const float* w_mod = a.in[2];
    float* MODP = (float*)(a.ws + WS_MODP);
    LAS float* s_c = (LAS float*)lds;
    for (int item = blockIdx.x; item < 256; item += gridDim.x) {
        const int kc = item >> 3, cc = item & 7;
        __syncthreads();
        if (tid < 256) { const int b = tid >> 6, k = tid & 63; s_c[tid] = silu_f(c[b * D + kc * 64 + k]); }
        __syncthreads();
        float acc[4][3];
#pragma unroll
        for (int b = 0; b < 4; ++b)
#pragma unroll
            for (int j = 0; j < 3; ++j) acc[b][j] = 0.f;
        const int col0 = cc * 1536 + tid;
        for (int k0 = 0; k0 < 64; k0 += 16) {
            float w0[16], w1[16], w2[16];
#pragma unroll
            for (int k = 0; k < 16; ++k) { const float* wr = w_mod + (size_t)(kc * 64 + k0 + k) * NMOD + col0; w0[k] = wr[0]; w1[k] = wr[512]; w2[k] = wr[1024]; }
#pragma unroll
            for (int k = 0; k < 16; ++k)
#pragma unroll
                for (int b = 0; b < 4; ++b) { const float sv = s_c[b * 64 + k0 + k]; acc[b][0] += sv * w0[k]; acc[b][1] += sv * w1[k]; acc[b][2] += sv * w2[k]; }
        }
#pragma unroll
        for (int b = 0; b < 4; ++b)
#pragma unroll
            for (int j = 0; j < 3; ++j) MODP[(size_t)(kc * 4 + b) * NMOD + col0 + 512 * j] = acc[b][j];
    }
    __syncthreads();
    LAS float* scr = (LAS float*)(lds + wave * TR_SCR);
    const int gw = blockIdx.x * 8 + wave, NGW = gridDim.x * 8;
    constexpr int I_IN = 32 * 62, I_QUP = 8 * 32, I_OUT = 32 * 32;
    bf16_t* Wt_in = (bf16_t*)(a.ws + WS_WTIN); bf16_t* Wt_qup = (bf16_t*)(a.ws + WS_WTQUP); bf16_t* Wt_out = (bf16_t*)(a.ws + WS_WTOUT);
    for (int it = gw; it < I_IN + I_QUP + I_OUT; it += NGW) {
        int r = it;
        if (r < I_IN) { tr_item(a.in[5], D, DIN, Wt_in, scr, r, lane, (const float*)nullptr, [](int n, float& sc) { if (n >= 832 && n < 848) sc = 0.25f; else if (n >= 848 && n < 1872) sc = 0.08838834764831845f; return n < 848 ? n : n + 176; }); continue; }
        r -= I_IN;
        if (r < I_QUP) { tr_item(a.in[7], 512, 2048, Wt_qup, scr, r, lane, a.in[6], [](int n, float& sc) { if (n >= 1024) sc = 0.125f; return n; }); continue; }
        r -= I_QUP;
        tr_item(a.in[13], D, D, Wt_out, scr, r, lane, (const float*)nullptr, [](int n, float& sc) { return n; });
    }
    {
        bf16_t* Wt_gu = (bf16_t*)(a.ws + WS_WTGU); bf16_t* Wt_dn = (bf16_t*)(a.ws + WS_WTDN);
        for (int it = gw; it < 32 * 768; it += NGW) {
            const int e = it / 768; int r = it % 768;
            if (r < 256) { tr_item(a.in[17] + (size_t)e * D * 512, D, 512, Wt_gu + (size_t)e * 1024 * D, scr, r, lane, (const float*)nullptr, [](int n, float& sc) { return 8 * (n >> 2) + (n & 3); }); continue; }
            r -= 256;
            if (r < 256) { tr_item(a.in[18] + (size_t)e * D * 512, D, 512, Wt_gu + (size_t)e * 1024 * D, scr, r, lane, (const float*)nullptr, [](int n, float& sc) { return 8 * (n >> 2) + 4 + (n & 3); }); continue; }
            r -= 256;
            tr_item(a.in[19] + (size_t)e * 512 * D, 512, D, Wt_dn + (size_t)e * D * 512, scr, r, lane, (const float*)nullptr, [](int n, float& sc) { return n; });
        }
        bf16_t* RT = (bf16_t*)(a.ws + WS_RT); const float* rg = a.in[15]; const float* re = a.in[16];
        for (int i = blockIdx.x * MK_THREADS + tid; i < 48 * D; i += gridDim.x * MK_THREADS) { const int o = i >> 11, k = i & 2047; RT[i] = f2bf(o < 4 ? rg[k * 4 + o] : (o < 36 ? re[k * 32 + (o - 4)] : 0.f)); }
    }
    u32x4* z = (u32x4*)(Wt_in + (size_t)848 * D);
    for (int i = blockIdx.x * MK_THREADS + tid; i < 176 * 256; i += gridDim.x * MK_THREADS) z[i] = (u32x4){0u, 0u, 0u, 0u};
}

__device__ __forceinline__ void p1_xn(const MkArgs& a, LAS unsigned char* lds) {
    const int tid = threadIdx.x, lane = tid & 63, wave = __builtin_amdgcn_readfirstlane(tid >> 6);
    const float* x = a.in[0]; const float* b_mod = a.in[3]; const float* ln1_g = a.in[4];
    const float* MODP = (const float*)(a.ws + WS_MODP); float* MOD = (float*)(a.ws + WS_MOD); bf16_t* XN = (bf16_t*)(a.ws + WS_XN);
    LAS float* s_gs = (LAS float*)lds; LAS float* s_sh = s_gs + D;
    for (int i = blockIdx.x * MK_THREADS + tid; i < NB * NMOD; i += gridDim.x * MK_THREADS) {
        const int b = i / NMOD, n = i % NMOD; float s = b_mod[n];
        for (int kc = 0; kc < 32; ++kc) s += MODP[(size_t)(kc * 4 + b) * NMOD + n];
        MOD[i] = s;
    }
    for (int chunk = blockIdx.x; chunk < M / 64; chunk += gridDim.x) {
        const int b = chunk >> 6;
        __syncthreads();
        for (int k = tid; k < D; k += MK_THREADS) {
            float sh = b_mod[k], sc = b_mod[D + k];
            for (int kc = 0; kc < 32; ++kc) { sh += MODP[(size_t)(kc * 4 + b) * NMOD + k]; sc += MODP[(size_t)(kc * 4 + b) * NMOD + D + k]; }
            s_sh[k] = sh; s_gs[k] = ln1_g[k] * (1.f + sc);
        }
        __syncthreads();
        f32x4 v[8], vn[8];
        { const f32x4* xr = (const f32x4*)(x + (size_t)(chunk * 64 + wave) * D) + lane;
#pragma unroll
          for (int j = 0; j < 8; ++j) v[j] = xr[64 * j]; }
        for (int r = wave; r < 64; r += 8) {
            const int m = chunk * 64 + r;
            if (r + 8 < 64) { const f32x4* xn = (const f32x4*)(x + (size_t)(m + 8) * D) + lane;
#pragma unroll
                for (int j = 0; j < 8; ++j) vn[j] = xn[64 * j]; }
            float ss = 0.f;
#pragma unroll
            for (int j = 0; j < 8; ++j) ss += (v[j].x * v[j].x + v[j].y * v[j].y) + (v[j].z * v[j].z + v[j].w * v[j].w);
            const float rstd = rsqrtf(wave_sum(ss) * (1.f / D) + EPS);
            u32x2* o8 = (u32x2*)(XN + (size_t)m * D) + lane;
#pragma unroll
            for (int j = 0; j < 8; ++j) { const int k = 4 * (lane + 64 * j); const f32x4 gs = *(const LAS f32x4*)(s_gs + k), sh = *(const LAS f32x4*)(s_sh + k);
                const f32x4 y = v[j] * rstd * gs + sh; u32x2 w; w.x = pk2(y.x, y.y); w.y = pk2(y.z, y.w); o8[64 * j] = w; }
#pragma unroll
            for (int j = 0; j < 8; ++j) v[j] = vn[j];
        }
    }
}

struct EpiInProj {
    static constexpr bool PERM = true;
    bf16_t* B0; bf16_t* QB; bf16_t* KB; bf16_t* VB; float* SSQ;
    __device__ __forceinline__ void operator()(const pg8::f32x4 (&acc)[2][2][4][2], const pg8::Unit& u, int wr, int wc, int fr, int fq) const {
        if (u.dup) return;
        const int t = u.pn >> 2; bf16_t* base = t == 0 ? B0 : (t == 1 ? QB : (t == 2 ? KB : VB));
        const int row0 = u.pm * 256 + wr * 64 + fr, col0 = (u.pn & 3) * 256 + wc * 32 + 8 * fq;
#pragma unroll
        for (int ai = 0; ai < 2; ++ai)
#pragma unroll
            for (int m = 0; m < 4; ++m) { const int row = row0 + ai * 128 + m * 16; bf16_t* rowp = base + (size_t)row * 1024 + col0; float ss = 0.f;
#pragma unroll
                for (int bj = 0; bj < 2; ++bj) { const pg8::f32x4 v0 = acc[ai][bj][m][0], v1 = acc[ai][bj][m][1];
                    ss += (v0[0] * v0[0] + v0[1] * v0[1]) + (v0[2] * v0[2] + v0[3] * v0[3]) + (v1[0] * v1[0] + v1[1] * v1[1]) + (v1[2] * v1[2] + v1[3] * v1[3]);
                    pg8::u32x4 w; w.x = pg8::cvt_pk_bf16(v0[0], v0[1]); w.y = pg8::cvt_pk_bf16(v0[2], v0[3]); w.z = pg8::cvt_pk_bf16(v1[0], v1[1]); w.w = pg8::cvt_pk_bf16(v1[2], v1[3]);
                    *(pg8::u32x4*)(rowp + bj * 128) = w; }
                if (u.pn < 2) { ss += __shfl_xor(ss, 16); ss += __shfl_xor(ss, 32); if (fq == 0) SSQ[(size_t)row * 8 + u.pn * 4 + wc] = ss; } }
    }
};


struct EpiQupG {
    static constexpr bool PERM = true;
    const float* SSQ; bf16_t* QA; bf16_t* QI;
    __device__ __forceinline__ void operator()(const pg8::f32x4 (&acc)[2][2][4][2], const pg8::Unit& u, int wr, int wc, int fr, int fq) const {
        if (u.dup) return;
        bf16_t* base = (u.pn >> 2) ? QI : QA;
        const int row0 = u.pm * 256 + wr * 64 + fr, col0 = (u.pn & 3) * 256 + wc * 32 + 8 * fq;
#pragma unroll
        for (int ai = 0; ai < 2; ++ai)
#pragma unroll
            for (int m = 0; m < 4; ++m) { const int row = row0 + ai * 128 + m * 16; bf16_t* rowp = base + (size_t)row * 1024 + col0;
                const pg8::f32x4 s0 = *(const pg8::f32x4*)(SSQ + (size_t)row * 8), s1 = *(const pg8::f32x4*)(SSQ + (size_t)row * 8 + 4);
                const float rs = rsqrtf(((s0[0] + s0[1]) + (s0[2] + s0[3]) + (s1[0] + s1[1]) + (s1[2] + s1[3])) * (1.f / 512.f) + EPS);
#pragma unroll
                for (int bj = 0; bj < 2; ++bj) { const pg8::f32x4 v0 = acc[ai][bj][m][0] * rs, v1 = acc[ai][bj][m][1] * rs;
                    pg8::u32x4 w; w.x = pg8::cvt_pk_bf16(v0[0], v0[1]); w.y = pg8::cvt_pk_bf16(v0[2], v0[3]); w.z = pg8::cvt_pk_bf16(v1[0], v1[1]); w.w = pg8::cvt_pk_bf16(v1[2], v1[3]);
                    *(pg8::u32x4*)(rowp + bj * 128) = w; } }
    }
};
struct EpiOutProj {
    static constexpr bool PERM = true;
    const float* x; const float* MOD; float* out;
    __device__ __forceinline__ void operator()(const pg8::f32x4 (&acc)[2][2][4][2], const pg8::Unit& u, int wr, int wc, int fr, int fq) const {
        if (u.dup) return;
        const int b = (u.pm * 256) >> 12;
        const int row0 = u.pm * 256 + wr * 64 + fr, col0 = u.pn * 256 + wc * 32 + 8 * fq;
        const float* gp = MOD + (size_t)b * NMOD + 2 * D + col0;
        pg8::f32x4 g[2][2];
#pragma unroll
        for (int bj = 0; bj < 2; ++bj) { g[bj][0] = *(const pg8::f32x4*)(gp + bj * 128); g[bj][1] = *(const pg8::f32x4*)(gp + bj * 128 + 4); }
#pragma unroll
        for (int ai = 0; ai < 2; ++ai)
#pragma unroll
            for (int m = 0; m < 4; ++m) { const size_t off = (size_t)(row0 + ai * 128 + m * 16) * D + col0;
#pragma unroll
                for (int bj = 0; bj < 2; ++bj) { const pg8::f32x4 x0 = *(const pg8::f32x4*)(x + off + bj * 128), x1 = *(const pg8::f32x4*)(x + off + bj * 128 + 4);
                    *(pg8::f32x4*)(out + off + bj * 128) = x0 + g[bj][0] * acc[ai][bj][m][0]; *(pg8::f32x4*)(out + off + bj * 128 + 4) = x1 + g[bj][1] * acc[ai][bj][m][1]; } }
    }
};
__device__ __forceinline__ void kanorm_pass(const MkArgs& a) {
    const int tid = threadIdx.x, lane = tid & 63, wave = __builtin_amdgcn_readfirstlane(tid >> 6);
    bf16_t* B0 = (bf16_t*)(a.ws + WS_B0); const float* k_gain = a.in[9];
    const float g0 = k_gain[2 * lane], g1 = k_gain[2 * lane + 1];
    for (int m = blockIdx.x * 8 + wave; m < M; m += gridDim.x * 8) {
        unsigned* p = (unsigned*)(B0 + (size_t)m * 1024 + 512) + lane;
        const unsigned v = *p; const float k0 = __uint_as_float(v << 16), k1 = __uint_as_float(v & 0xffff0000u);
        const float rs = rsqrtf(wave_sum(k0 * k0 + k1 * k1) * (1.f / 128.f) + EPS);
        *p = pk2(k0 * rs * g0, k1 * rs * g1);
    }
}

typedef short bf16x8_t __attribute__((ext_vector_type(8)));
__device__ __forceinline__ void p8_route(const MkArgs& a, LAS unsigned char* lds) {
    const int tid = threadIdx.x, lane = tid & 63, wave = __builtin_amdgcn_readfirstlane(tid >> 6);
    const float* x1 = a.out; const float* ln2_g = a.in[14]; const float* MOD = (const float*)(a.ws + WS_MOD);
    bf16_t* H2 = (bf16_t*)(a.ws + WS_XN); const bf16_t* RT = (const bf16_t*)(a.ws + WS_RT);
    int* EID = (int*)(a.ws + WS_EID); float* GW = (float*)(a.ws + WS_GW);
    unsigned* cnt = (unsigned*)(a.ws + WS_CTL) + CW_CNT; int* list = (int*)(a.ws + WS_LIST);
    constexpr int RS = 4112;
    LAS float* s_part = (LAS float*)lds;
    LAS float* s_lg = (LAS float*)(lds + 49152);
    for (int item = blockIdx.x; item < M / 32; item += gridDim.x) {
        const int m0 = item * 32, b = m0 >> 12;
        const float* mb = MOD + (size_t)b * NMOD;
        __syncthreads();
        f32x4 v[4][8];
#pragma unroll
        for (int rr = 0; rr < 4; ++rr) { const f32x4* xr = (const f32x4*)(x1 + (size_t)(m0 + wave * 4 + rr) * D) + lane;
#pragma unroll
            for (int j = 0; j < 8; ++j) v[rr][j] = xr[64 * j]; }
#pragma unroll
        for (int rr = 0; rr < 4; ++rr) {
            const int r = wave * 4 + rr, m = m0 + r;
            float ss = 0.f;
#pragma unroll
            for (int j = 0; j < 8; ++j) ss += (v[rr][j].x * v[rr][j].x + v[rr][j].y * v[rr][j].y) + (v[rr][j].z * v[rr][j].z + v[rr][j].w * v[rr][j].w);
            const float rstd = rsqrtf(wave_sum(ss) * (1.f / D) + EPS);
            u32x2* o8 = (u32x2*)(H2 + (size_t)m * D) + lane;
#pragma unroll
            for (int j = 0; j < 8; ++j) { const int k = 4 * (lane + 64 * j);
                const f32x4 g = *(const f32x4*)(ln2_g + k), sc = *(const f32x4*)(mb + 4 * D + k), sh = *(const f32x4*)(mb + 3 * D + k);
                const f32x4 y = v[rr][j] * rstd * g * (sc + 1.f) + sh; u32x2 w; w.x = pk2(y.x, y.y); w.y = pk2(y.z, y.w); o8[64 * j] = w;
                *(LAS u32x2*)(lds + r * RS + k * 2) = w; }
        }
        __syncthreads();
        f32x4 acc[2][3];
#pragma unroll
        for (int rt = 0; rt < 2; ++rt)
#pragma unroll
            for (int ct = 0; ct < 3; ++ct) acc[rt][ct] = (f32x4){0.f, 0.f, 0.f, 0.f};
        const int fr = lane & 15, fq = lane >> 4;
#pragma unroll 2
        for (int kk = 0; kk < 8; ++kk) {
            const int k0 = 32 * (wave * 8 + kk) + 8 * fq;
            bf16x8_t af[2], bfr[3];
#pragma unroll
            for (int rt = 0; rt < 2; ++rt) af[rt] = *(const LAS bf16x8_t*)(lds + (16 * rt + fr) * RS + k0 * 2);
#pragma unroll
            for (int ct = 0; ct < 3; ++ct) bfr[ct] = *(const bf16x8_t*)(RT + (size_t)(16 * ct + fr) * D + k0);
#pragma unroll
            for (int rt = 0; rt < 2; ++rt)
#pragma unroll
                for (int ct = 0; ct < 3; ++ct) acc[rt][ct] = __builtin_amdgcn_mfma_f32_16x16x32_bf16(af[rt], bfr[ct], acc[rt][ct], 0, 0, 0);
        }
        __syncthreads();
#pragma unroll
        for (int rt = 0; rt < 2; ++rt)
#pragma unroll
            for (int ct = 0; ct < 3; ++ct)
#pragma unroll
                for (int i = 0; i < 4; ++i) s_part[(wave * 32 + 16 * rt + 4 * fq + i) * 48 + 16 * ct + fr] = acc[rt][ct][i];
        __syncthreads();
        for (int i = tid; i < 32 * 36; i += MK_THREADS) { const int r = i / 36, o = i % 36; float s = 0.f;
#pragma unroll
            for (int w = 0; w < 8; ++w) s += s_part[(w * 32 + r) * 48 + o];
            s_lg[i] = s; }
        __syncthreads();
        if (tid < 32) {
            const LAS float* lg = s_lg + tid * 36; const int m = m0 + tid;
            int gi = 0; float gm = lg[0];
            for (int i = 1; i < 4; ++i) if (lg[i] > gm) { gm = lg[i]; gi = i; }
            float gs = 0.f;
            for (int i = 0; i < 4; ++i) gs += __expf(lg[i] - gm);
            const float gw = 1.f / gs;
            const LAS float* le = lg + 4 + gi * 8;
            float em = le[0];
            for (int i = 1; i < 8; ++i) em = fmaxf(em, le[i]);
            float es = 0.f;
            for (int i = 0; i < 8; ++i) es += __expf(le[i] - em);
            int i0 = 0; float p0 = -1.f;
            for (int i = 0; i < 8; ++i) { const float p = __expf(le[i] - em) / es; if (p > p0) { p0 = p; i0 = i; } }
            int i1 = 0; float p1 = -1.f;
            for (int i = 0; i < 8; ++i) { const float p = __expf(le[i] - em) / es; if (i != i0 && p > p1) { p1 = p; i1 = i; } }
            const float den = p0 + p1;
            const int e0 = gi * 8 + i0, e1 = gi * 8 + i1;
            GW[m * 2] = gw * p0 / den; GW[m * 2 + 1] = gw * p1 / den;
            const unsigned q0 = __hip_atomic_fetch_add(cnt + e0, 1u, __ATOMIC_RELAXED, __HIP_MEMORY_SCOPE_AGENT);
            const unsigned q1 = __hip_atomic_fetch_add(cnt + 32 + e1, 1u, __ATOMIC_RELAXED, __HIP_MEMORY_SCOPE_AGENT);
            EID[m * 2] = (e0 << 16) | (int)q0; EID[m * 2 + 1] = (e1 << 16) | (int)q1;
            list[(size_t)e0 * 16384 + q0] = m; list[(size_t)(32 + e1) * 16384 + q1] = m;
        }
    }
}

__device__ __forceinline__ int rfl(int v) { return __builtin_amdgcn_readfirstlane(v); }
struct MoeTab { LAS int* tsm; LAS int* c0; LAS int* c1; LAS int* ts0; LAS int* ts1; };
__device__ __forceinline__ MoeTab moe_tab_build(const MkArgs& a, LAS unsigned char* lds) {
    MoeTab t; LAS int* p = (LAS int*)(lds + MK_MOE_OFF); t.tsm = p; t.c0 = p + 40; t.c1 = p + 80; t.ts0 = p + 120; t.ts1 = p + 160;
    const unsigned* cnt = (const unsigned*)(a.ws + WS_CTL) + CW_CNT;
    __syncthreads();
    if (threadIdx.x == 0) {
        int am = 0, a0 = 0, a1 = 0;
        for (int e = 0; e < 32; ++e) { const int n0 = (int)__hip_atomic_load(cnt + e, __ATOMIC_RELAXED, __HIP_MEMORY_SCOPE_AGENT), n1 = (int)__hip_atomic_load(cnt + 32 + e, __ATOMIC_RELAXED, __HIP_MEMORY_SCOPE_AGENT);
            t.c0[e] = n0; t.c1[e] = n1; t.tsm[e] = am; t.ts0[e] = a0; t.ts1[e] = a1; am += (n0 + n1 + 255) >> 8; a0 += (n0 + 255) >> 8; a1 += (n1 + 255) >> 8; }
        t.tsm[32] = am; t.ts0[32] = a0; t.ts1[32] = a1;
    }
    __syncthreads();
    return t;
}
struct SchedGU {
    MoeTab t; const int* list; const char* H2; const char* Wt; int G, c, nunit, ndup; int R[2], C[2];
    __device__ void init(const MoeTab& t_, const MkArgs& a, int G_, int c_, int ndup_ = 1) { ndup = ndup_; t = t_; list = (const int*)(a.ws + WS_LIST); H2 = (const char*)(a.ws + WS_XN); Wt = (const char*)(a.ws + WS_WTGU); G = G_; c = c_; nunit = rfl(t.tsm[32]) * 4;
#pragma unroll
        for (int i = 0; i < 2; ++i) pg8::stage_rc((int)threadIdx.x * 16 + i * 8192, R[i], C[i]); }
    __device__ bool next(int i, pg8::Unit& u) const {
        const int L0 = i * G + c; if (L0 >= nunit * ndup) return false;
        const int L = L0 % nunit; u.dup = L0 / nunit;
        const int mt = L >> 2, pn = L & 3; int e = 0;
        for (int j = 1; j < 32; ++j) e += (mt >= t.tsm[j]) ? 1 : 0;
        e = rfl(e);
        u.pm = mt; u.pn = pn; u.aux = e; u.a = H2; u.b = Wt + ((size_t)(e * 1024 + pn * 256) * D) * 2;
        const int n0 = rfl(t.c0[e]), n1 = rfl(t.c1[e]), rb = (mt - rfl(t.tsm[e])) * 256;
#pragma unroll
        for (int h = 0; h < 2; ++h)
#pragma unroll
            for (int j = 0; j < 2; ++j) { const int r = rb + h * 128 + R[j]; int tok = 0;
                if (r < n0) tok = list[(size_t)e * 16384 + r]; else if (r - n0 < n1) tok = list[(size_t)(32 + e) * 16384 + (r - n0)];
                u.va[h][j] = (unsigned)(tok * D + C[j]) * 2u; }
        return true;
    }
};
struct EpiGU {
    static constexpr bool PERM = true;
    bf16_t* U;
    __device__ __forceinline__ void operator()(const pg8::f32x4 (&acc)[2][2][4][2], const pg8::Unit& u, int wr, int wc, int fr, int fq) const {
        if (u.dup) return;
        const int row0 = u.pm * 256 + wr * 64 + fr, j0 = u.pn * 128 + wc * 16 + 4 * fq;
#pragma unroll
        for (int ai = 0; ai < 2; ++ai)
#pragma unroll
            for (int m = 0; m < 4; ++m) { bf16_t* rowp = U + (size_t)(row0 + ai * 128 + m * 16) * 512 + j0;
#pragma unroll
                for (int bj = 0; bj < 2; ++bj) { const pg8::f32x4 gv = acc[ai][bj][m][0], uv = acc[ai][bj][m][1]; float o[4];
#pragma unroll
                    for (int i = 0; i < 4; ++i) o[i] = gv[i] / (1.f + __expf(-gv[i])) * uv[i];
                    u32x2 w; w.x = pg8::cvt_pk_bf16(o[0], o[1]); w.y = pg8::cvt_pk_bf16(o[2], o[3]); *(u32x2*)(rowp + bj * 64) = w; } }
    }
};
struct SchedDN {
    MoeTab t; const char* U; const char* Wt; int G, c, nunit, ndup; unsigned vb[2][2];
    __device__ void init(const MoeTab& t_, const MkArgs& a, int G_, int c_, int ndup_ = 1) { ndup = ndup_; t = t_; U = (const char*)(a.ws + WS_U); Wt = (const char*)(a.ws + WS_WTDN); G = G_; c = c_; nunit = rfl(t.tsm[32]) * 8;
#pragma unroll
        for (int i = 0; i < 2; ++i) { int R, C; pg8::stage_rc((int)threadIdx.x * 16 + i * 8192, R, C); vb[0][i] = (unsigned)(R * 512 + C) * 2u; vb[1][i] = (unsigned)((128 + R) * 512 + C) * 2u; } }
    __device__ bool next(int i, pg8::Unit& u) const {
        const int L0 = i * G + c; if (L0 >= nunit * ndup) return false;
        const int L = L0 % nunit; u.dup = L0 / nunit;
        const int mt = L >> 3, pn = L & 7; int e = 0;
        for (int j = 1; j < 32; ++j) e += (mt >= t.tsm[j]) ? 1 : 0;
        e = rfl(e);
        u.pm = mt; u.pn = pn; u.aux = e;
        u.a = U + ((size_t)mt * 256 * 512) * 2; u.b = Wt + ((size_t)(e * D + pn * 256) * 512) * 2;
        u.va[0][0] = vb[0][0]; u.va[0][1] = vb[0][1]; u.va[1][0] = vb[1][0]; u.va[1][1] = vb[1][1];
        return true;
    }
};
struct EpiY {
    static constexpr bool PERM = true;
    bf16_t* Y;
    __device__ __forceinline__ void operator()(const pg8::f32x4 (&acc)[2][2][4][2], const pg8::Unit& u, int wr, int wc, int fr, int fq) const {
        if (u.dup) return;
        const int row0 = u.pm * 256 + wr * 64 + fr, col0 = u.pn * 256 + wc * 32 + 8 * fq;
#pragma unroll
        for (int ai = 0; ai < 2; ++ai)
#pragma unroll
            for (int m = 0; m < 4; ++m) { bf16_t* rowp = Y + (size_t)(row0 + ai * 128 + m * 16) * D + col0;
#pragma unroll
                for (int bj = 0; bj < 2; ++bj) { const pg8::f32x4 v0 = acc[ai][bj][m][0], v1 = acc[ai][bj][m][1];
                    pg8::u32x4 w; w.x = pg8::cvt_pk_bf16(v0[0], v0[1]); w.y = pg8::cvt_pk_bf16(v0[2], v0[3]); w.z = pg8::cvt_pk_bf16(v1[0], v1[1]); w.w = pg8::cvt_pk_bf16(v1[2], v1[3]);
                    *(pg8::u32x4*)(rowp + bj * 128) = w; } }
    }
};
__device__ __forceinline__ void p11_combine(const MkArgs& a, const MoeTab& t) {
    const int tid = threadIdx.x, lane = tid & 63, wave = __builtin_amdgcn_readfirstlane(tid >> 6);
    const bf16_t* Y = (const bf16_t*)(a.ws + WS_Y); const int* POSL = (const int*)(a.ws + WS_EID); const float* GW = (const float*)(a.ws + WS_GW); const float* MOD = (const float*)(a.ws + WS_MOD);
    for (int m = blockIdx.x * 8 + wave; m < M; m += gridDim.x * 8) {
        const int p0 = rfl(POSL[m * 2]), p1 = rfl(POSL[m * 2 + 1]);
        const int e0 = p0 >> 16, e1 = p1 >> 16;
        const size_t r0 = (size_t)rfl(t.tsm[e0]) * 256 + (p0 & 0xffff), r1 = (size_t)rfl(t.tsm[e1]) * 256 + rfl(t.c0[e1]) + (p1 & 0xffff);
        const float w0 = GW[m * 2], w1 = GW[m * 2 + 1];
        const float* gp = MOD + (size_t)(m >> 12) * NMOD + 5 * D;
        float* op = a.out + (size_t)m * D;
        u32x4 y0[4], y1[4]; f32x4 xv[4][2];
#pragma unroll
        for (int j = 0; j < 4; ++j) { const int c = 8 * (lane + 64 * j); y0[j] = *(const u32x4*)(Y + r0 * D + c); y1[j] = *(const u32x4*)(Y + r1 * D + c); xv[j][0] = *(const f32x4*)(op + c); xv[j][1] = *(const f32x4*)(op + c + 4); }
#pragma unroll
        for (int j = 0; j < 4; ++j) { const int c = 8 * (lane + 64 * j);
            const f32x4 g0 = *(const f32x4*)(gp + c), g1 = *(const f32x4*)(gp + c + 4);
            f32x4 s0, s1;
#pragma unroll
            for (int q = 0; q < 2; ++q) { s0[2 * q] = w0 * __uint_as_float(y0[j][q] << 16) + w1 * __uint_as_float(y1[j][q] << 16); s0[2 * q + 1] = w0 * __uint_as_float(y0[j][q] & 0xffff0000u) + w1 * __uint_as_float(y1[j][q] & 0xffff0000u);
                s1[2 * q] = w0 * __uint_as_float(y0[j][2 + q] << 16) + w1 * __uint_as_float(y1[j][2 + q] << 16); s1[2 * q + 1] = w0 * __uint_as_float(y0[j][2 + q] & 0xffff0000u) + w1 * __uint_as_float(y1[j][2 + q] & 0xffff0000u); }
            *(f32x4*)(op + c) = xv[j][0] + g0 * s0; *(f32x4*)(op + c + 4) = xv[j][1] + g1 * s1; }
    }
}
typedef float f32x16 __attribute__((ext_vector_type(16)));
typedef short s16x4 __attribute__((ext_vector_type(4)));
__device__ __forceinline__ s16x4 tr_read(unsigned lds_addr) { s16x4 r; asm volatile("ds_read_b64_tr_b16 %0, %1\n\ts_waitcnt lgkmcnt(0)" : "=&v"(r) : "v"(lds_addr) : "memory"); return r; }
__device__ __forceinline__ unsigned off_b(unsigned row, unsigned ch) { return 256u * row + 16u * (ch ^ (((row & 3) << 2) | ((row >> 2) & 3))); }
__device__ __forceinline__ int crow(int reg, int h) { return (reg & 3) + 8 * (reg >> 2) + 4 * h; }
constexpr float SB_STOP = -104.0f;

constexpr int VT_STRIDE = 272;
__device__ __forceinline__ void tr8_sb0(unsigned addr, s16x4 (&r)[8]) {
    asm volatile(
        "ds_read_b64_tr_b16 %0, %8 offset:0\n\t"
        "ds_read_b64_tr_b16 %1, %8 offset:2176\n\t"
        "ds_read_b64_tr_b16 %2, %8 offset:4352\n\t"
        "ds_read_b64_tr_b16 %3, %8 offset:6528\n\t"
        "ds_read_b64_tr_b16 %4, %8 offset:64\n\t"
        "ds_read_b64_tr_b16 %5, %8 offset:2240\n\t"
        "ds_read_b64_tr_b16 %6, %8 offset:4416\n\t"
        "ds_read_b64_tr_b16 %7, %8 offset:6592\n\t"
        "s_waitcnt lgkmcnt(0)"
        : "=&v"(r[0]), "=&v"(r[1]), "=&v"(r[2]), "=&v"(r[3]), "=&v"(r[4]), "=&v"(r[5]), "=&v"(r[6]), "=&v"(r[7])
        : "v"(addr) : "memory");
}
__device__ __forceinline__ void tr8_sb1(unsigned addr, s16x4 (&r)[8]) {
    asm volatile(
        "ds_read_b64_tr_b16 %0, %8 offset:128\n\t"
        "ds_read_b64_tr_b16 %1, %8 offset:2304\n\t"
        "ds_read_b64_tr_b16 %2, %8 offset:4480\n\t"
        "ds_read_b64_tr_b16 %3, %8 offset:6656\n\t"
        "ds_read_b64_tr_b16 %4, %8 offset:192\n\t"
        "ds_read_b64_tr_b16 %5, %8 offset:2368\n\t"
        "ds_read_b64_tr_b16 %6, %8 offset:4544\n\t"
        "ds_read_b64_tr_b16 %7, %8 offset:6720\n\t"
        "s_waitcnt lgkmcnt(0)"
        : "=&v"(r[0]), "=&v"(r[1]), "=&v"(r[2]), "=&v"(r[3]), "=&v"(r[4]), "=&v"(r[5]), "=&v"(r[6]), "=&v"(r[7])
        : "v"(addr) : "memory");
}
__device__ __forceinline__ void tr8_dsa0(unsigned addr, s16x4 (&r)[8]) {
    asm volatile(
        "ds_read_b64_tr_b16 %0, %8 offset:0\n\t"
        "ds_read_b64_tr_b16 %1, %8 offset:4352\n\t"
        "ds_read_b64_tr_b16 %2, %8 offset:32\n\t"
        "ds_read_b64_tr_b16 %3, %8 offset:4384\n\t"
        "ds_read_b64_tr_b16 %4, %8 offset:64\n\t"
        "ds_read_b64_tr_b16 %5, %8 offset:4416\n\t"
        "ds_read_b64_tr_b16 %6, %8 offset:96\n\t"
        "ds_read_b64_tr_b16 %7, %8 offset:4448\n\t"
        "s_waitcnt lgkmcnt(0)"
        : "=&v"(r[0]), "=&v"(r[1]), "=&v"(r[2]), "=&v"(r[3]), "=&v"(r[4]), "=&v"(r[5]), "=&v"(r[6]), "=&v"(r[7])
        : "v"(addr) : "memory");
}
__device__ __forceinline__ void tr8_dsa1(unsigned addr, s16x4 (&r)[8]) {
    asm volatile(
        "ds_read_b64_tr_b16 %0, %8 offset:128\n\t"
        "ds_read_b64_tr_b16 %1, %8 offset:4480\n\t"
        "ds_read_b64_tr_b16 %2, %8 offset:160\n\t"
        "ds_read_b64_tr_b16 %3, %8 offset:4512\n\t"
        "ds_read_b64_tr_b16 %4, %8 offset:192\n\t"
        "ds_read_b64_tr_b16 %5, %8 offset:4544\n\t"
        "ds_read_b64_tr_b16 %6, %8 offset:224\n\t"
        "ds_read_b64_tr_b16 %7, %8 offset:4576\n\t"
        "s_waitcnt lgkmcnt(0)"
        : "=&v"(r[0]), "=&v"(r[1]), "=&v"(r[2]), "=&v"(r[3]), "=&v"(r[4]), "=&v"(r[5]), "=&v"(r[6]), "=&v"(r[7])
        : "v"(addr) : "memory");
}
__device__ __forceinline__ void tr16_sb(unsigned addr, s16x4 (&r)[16]) {
    asm volatile(
        "ds_read_b64_tr_b16 %0, %16 offset:0\n\t"
        "ds_read_b64_tr_b16 %1, %16 offset:2176\n\t"
        "ds_read_b64_tr_b16 %2, %16 offset:4352\n\t"
        "ds_read_b64_tr_b16 %3, %16 offset:6528\n\t"
        "ds_read_b64_tr_b16 %4, %16 offset:64\n\t"
        "ds_read_b64_tr_b16 %5, %16 offset:2240\n\t"
        "ds_read_b64_tr_b16 %6, %16 offset:4416\n\t"
        "ds_read_b64_tr_b16 %7, %16 offset:6592\n\t"
        "ds_read_b64_tr_b16 %8, %16 offset:128\n\t"
        "ds_read_b64_tr_b16 %9, %16 offset:2304\n\t"
        "ds_read_b64_tr_b16 %10, %16 offset:4480\n\t"
        "ds_read_b64_tr_b16 %11, %16 offset:6656\n\t"
        "ds_read_b64_tr_b16 %12, %16 offset:192\n\t"
        "ds_read_b64_tr_b16 %13, %16 offset:2368\n\t"
        "ds_read_b64_tr_b16 %14, %16 offset:4544\n\t"
        "ds_read_b64_tr_b16 %15, %16 offset:6720\n\t"
        "s_waitcnt lgkmcnt(0)"
        : "=&v"(r[0]), "=&v"(r[1]), "=&v"(r[2]), "=&v"(r[3]), "=&v"(r[4]), "=&v"(r[5]), "=&v"(r[6]), "=&v"(r[7]), "=&v"(r[8]), "=&v"(r[9]), "=&v"(r[10]), "=&v"(r[11]), "=&v"(r[12]), "=&v"(r[13]), "=&v"(r[14]), "=&v"(r[15])
        : "v"(addr) : "memory");
}
__device__ __forceinline__ void tr16_dsa(unsigned addr, s16x4 (&r)[16]) {
    asm volatile(
        "ds_read_b64_tr_b16 %0, %16 offset:0\n\t"
        "ds_read_b64_tr_b16 %1, %16 offset:4352\n\t"
        "ds_read_b64_tr_b16 %2, %16 offset:32\n\t"
        "ds_read_b64_tr_b16 %3, %16 offset:4384\n\t"
        "ds_read_b64_tr_b16 %4, %16 offset:64\n\t"
        "ds_read_b64_tr_b16 %5, %16 offset:4416\n\t"
        "ds_read_b64_tr_b16 %6, %16 offset:96\n\t"
        "ds_read_b64_tr_b16 %7, %16 offset:4448\n\t"
        "ds_read_b64_tr_b16 %8, %16 offset:128\n\t"
        "ds_read_b64_tr_b16 %9, %16 offset:4480\n\t"
        "ds_read_b64_tr_b16 %10, %16 offset:160\n\t"
        "ds_read_b64_tr_b16 %11, %16 offset:4512\n\t"
        "ds_read_b64_tr_b16 %12, %16 offset:192\n\t"
        "ds_read_b64_tr_b16 %13, %16 offset:4544\n\t"
        "ds_read_b64_tr_b16 %14, %16 offset:224\n\t"
        "ds_read_b64_tr_b16 %15, %16 offset:4576\n\t"
        "s_waitcnt lgkmcnt(0)"
        : "=&v"(r[0]), "=&v"(r[1]), "=&v"(r[2]), "=&v"(r[3]), "=&v"(r[4]), "=&v"(r[5]), "=&v"(r[6]), "=&v"(r[7]), "=&v"(r[8]), "=&v"(r[9]), "=&v"(r[10]), "=&v"(r[11]), "=&v"(r[12]), "=&v"(r[13]), "=&v"(r[14]), "=&v"(r[15])
        : "v"(addr) : "memory");
}
__device__ __forceinline__ void sb_wave(const bf16_t* __restrict__ QB, const bf16_t* __restrict__ KB, const bf16_t* __restrict__ VB, int b, int h, int q0, LAS unsigned char* vt, f32x16 (&o)[4]) {
    int lane = threadIdx.x & 63; asm volatile("" : "+v"(lane));
    const int r32 = lane & 31, hi = lane >> 5;
    bf16x8_t bq[8];
    { const bf16_t* qp = QB + (size_t)(b * S + q0 + r32) * 1024 + h * 128 + 64 * hi;
#pragma unroll
      for (int s = 0; s < 8; ++s) bq[s] = *(const bf16x8_t*)(qp + 8 * s); }
#pragma unroll
    for (int c = 0; c < 4; ++c)
#pragma unroll
        for (int i = 0; i < 16; ++i) o[c][i] = 0.f;
    float carry = 0.f;
    const int q16 = lane & 15, tq = q16 >> 2, tp = q16 & 3, blk = (lane >> 4) & 1;
    const unsigned traddr = (unsigned)(uintptr_t)vt + VT_STRIDE * (4 * hi + tq) + 32 * blk + 16 * (tp >> 1) + 8 * (tp & 1);
    const bf16_t* kbase = KB + (size_t)b * S * 1024 + h * 128 + 64 * hi + (size_t)r32 * 1024;
    const bf16_t* vbase = VB + (size_t)b * S * 1024 + h * 128 + (size_t)(lane >> 4) * 1024 + 8 * (lane & 15);
    bf16x8_t kf[8]; u32x4 vr[8];
    { const int kt = q0 >> 5;
#pragma unroll
      for (int s = 0; s < 8; ++s) kf[s] = *(const bf16x8_t*)(kbase + (size_t)kt * 32 * 1024 + 8 * s);
#pragma unroll
      for (int i = 0; i < 8; ++i) vr[i] = *(const u32x4*)(vbase + (size_t)(kt * 32 + 4 * i) * 1024); }
    for (int kt = q0 >> 5; kt >= 0; --kt) {
        const int k0 = kt * 32;
#pragma unroll
        for (int i = 0; i < 8; ++i) *(LAS u32x4*)(vt + (4 * i + (lane >> 4)) * VT_STRIDE + 16 * (lane & 15)) = vr[i];
        f32x16 z;
#pragma unroll
        for (int i = 0; i < 16; ++i) z[i] = 0.f;
#pragma unroll
        for (int s = 0; s < 8; ++s) z = __builtin_amdgcn_mfma_f32_32x32x16_bf16(kf[s], bq[s], z, 0, 0, 0);
        { const int kn = kt > 0 ? kt - 1 : 0;
#pragma unroll
          for (int s = 0; s < 8; ++s) kf[s] = *(const bf16x8_t*)(kbase + (size_t)kn * 32 * 1024 + 8 * s);
#pragma unroll
          for (int i = 0; i < 8; ++i) vr[i] = *(const u32x4*)(vbase + (size_t)(kn * 32 + 4 * i) * 1024); }
        const bool diag = (k0 == q0);
        float lm[16], sg[4];
#pragma unroll
        for (int g = 0; g < 4; ++g) sg[g] = 0.f;
#pragma unroll
        for (int i = 0; i < 16; ++i) { const float zz = z[i]; const float sp = fmaxf(zz, 0.f) + __logf(1.f + __expf(-fabsf(zz)));
            const bool valid = !diag || (crow(i, hi) < r32);
            lm[i] = valid ? -sp : 0.f; z[i] = valid ? (zz - sp) : -INFINITY; sg[i >> 2] += lm[i]; }
        float psg[4];
#pragma unroll
        for (int g = 0; g < 4; ++g) psg[g] = __shfl_xor(sg[g], 32);
        float aft[4];
        { float run = carry;
#pragma unroll
          for (int g = 3; g >= 0; --g) { if (hi == 0) { run += psg[g]; aft[g] = run; run += sg[g]; } else { aft[g] = run; run += sg[g]; run += psg[g]; } }
          carry = run; }
        float av[16];
#pragma unroll
        for (int g = 0; g < 4; ++g) { float run = aft[g];
#pragma unroll
            for (int r = 3; r >= 0; --r) { const int i = 4 * g + r; av[i] = __expf(z[i] + run); run += lm[i]; } }
        bf16x8_t pa[2];
#pragma unroll
        for (int s = 0; s < 2; ++s) { u32x4 p; p.x = pg8::cvt_pk_bf16(av[8 * s], av[8 * s + 1]); p.y = pg8::cvt_pk_bf16(av[8 * s + 2], av[8 * s + 3]); p.z = pg8::cvt_pk_bf16(av[8 * s + 4], av[8 * s + 5]); p.w = pg8::cvt_pk_bf16(av[8 * s + 6], av[8 * s + 7]); pa[s] = __builtin_bit_cast(bf16x8_t, p); }
        LDS_WAIT();
#pragma unroll
        for (int half = 0; half < 2; ++half) {
            s16x4 tr[8];
            if (half == 0) tr8_sb0(traddr, tr); else tr8_sb1(traddr, tr);
#pragma unroll
            for (int cc = 0; cc < 2; ++cc)
#pragma unroll
                for (int s = 0; s < 2; ++s) {
                    const bf16x8_t vf = __builtin_shufflevector(tr[(cc * 2 + s) * 2], tr[(cc * 2 + s) * 2 + 1], 0, 1, 2, 3, 4, 5, 6, 7);
                    o[2 * half + cc] = __builtin_amdgcn_mfma_f32_32x32x16_bf16(vf, pa[s], o[2 * half + cc], 0, 0, 0);
                }
        }
        if (__all(carry <= SB_STOP)) break;
    }
}
__device__ __forceinline__ void tr_read2(unsigned a0, unsigned a1, s16x4& r0, s16x4& r1) {
    asm volatile("ds_read_b64_tr_b16 %0, %2\n\tds_read_b64_tr_b16 %1, %3\n\ts_waitcnt lgkmcnt(0)" : "=&v"(r0), "=&v"(r1) : "v"(a0), "v"(a1) : "memory"); }
__device__ __forceinline__ int wave_sum_i(int v) {
    v += __builtin_amdgcn_update_dpp(0, v, 0xB1, 0xF, 0xF, true);
    v += __builtin_amdgcn_update_dpp(0, v, 0x4E, 0xF, 0xF, true);
    v += __builtin_amdgcn_update_dpp(0, v, 0x141, 0xF, 0xF, true);
    v += __builtin_amdgcn_update_dpp(0, v, 0x140, 0xF, 0xF, true);
    return __builtin_amdgcn_readlane(v, 0) + __builtin_amdgcn_readlane(v, 16) + __builtin_amdgcn_readlane(v, 32) + __builtin_amdgcn_readlane(v, 48);
}
template <int NR>
__device__ __forceinline__ void topk_row(const float* __restrict__ row, int n, LAS unsigned short* sel, int lane_in) {
    int lane = lane_in; asm volatile("" : "+v"(lane));
    unsigned key[NR];
#pragma unroll
    for (int i = 0; i < NR; ++i) { const int s = lane + 64 * i; const float v = __hip_atomic_load(row + s, __ATOMIC_RELAXED, __HIP_MEMORY_SCOPE_AGENT); key[i] = s < n ? fkey(v) : 0u; }
    unsigned T = 0u; bool exact = false;
    for (int bit = 31; bit >= 0; --bit) {
        const unsigned cand = T | (1u << bit);
        int c = 0;
#pragma unroll
        for (int i = 0; i < NR; ++i) c += (key[i] >= cand) ? 1 : 0;
        c = wave_sum_i(c);
        if (c >= 256) { T = cand; if (c == 256) { exact = true; break; } }
    }
    const unsigned long long ltm = (1ull << lane) - 1ull;
    if (exact) {
        int base = 0;
#pragma unroll
        for (int i = 0; i < NR; ++i) {
            const bool take = key[i] >= T;
            const unsigned long long mt = __ballot(take);
            if (take) sel[base + __popcll(mt & ltm)] = (unsigned short)(lane + 64 * i);
            base += __popcll(mt);
        }
    } else {
        int cg = 0;
#pragma unroll
        for (int i = 0; i < NR; ++i) cg += (key[i] > T) ? 1 : 0;
        const int need = 256 - wave_sum_i(cg);
        int base = 0, run_eq = 0;
#pragma unroll 1
        for (int i = 0; i < NR; ++i) {
            unsigned k = key[0];
#pragma unroll
            for (int q = 1; q < NR; ++q) k = (i == q) ? key[q] : k;
            const bool gt = k > T, eq = (k == T);
            const unsigned long long meq = __ballot(eq);
            const bool take = gt || (eq && (run_eq + __popcll(meq & ltm)) < need);
            const unsigned long long mt = __ballot(take);
            if (take) sel[base + __popcll(mt & ltm)] = (unsigned short)(lane + 64 * i);
            base += __popcll(mt); run_eq += __popcll(meq);
        }
    }
}
__device__ __forceinline__ void dsa_token(const bf16_t* __restrict__ B0, const bf16_t* __restrict__ QA, const float* __restrict__ q_gain, const float* __restrict__ gn_a, bf16_t* __restrict__ O,
                                          int b, int t, int cnt, const LAS unsigned short* sel, const LAS float* s_bias, LAS unsigned char* vt) {
    int lane = threadIdx.x & 63; asm volatile("" : "+v"(lane));
    const int fr = lane & 15, g = lane >> 4, hd = fr & 7;
    const size_t m = (size_t)b * S + t;
    bf16x8_t bqa[4];
    {
        const bf16_t* qp = QA + m * 1024 + hd * 128 + 32 * g;
        float qf[32]; float ss = 0.f;
#pragma unroll
        for (int kk = 0; kk < 4; ++kk) { const u32x4 v = *(const u32x4*)(qp + 8 * kk);
#pragma unroll
            for (int j = 0; j < 4; ++j) { const unsigned w = v[j]; qf[8 * kk + 2 * j] = __uint_as_float(w << 16); qf[8 * kk + 2 * j + 1] = __uint_as_float(w & 0xffff0000u); } }
#pragma unroll
        for (int j = 0; j < 32; ++j) ss += qf[j] * qf[j];
        ss += __shfl_xor(ss, 16); ss += __shfl_xor(ss, 32);
        const float rs = (fr < 8) ? rsqrtf(ss * (1.f / 128.f) + EPS) * 0.08838834764831845f : 0.f;
        const float* gp = q_gain + 32 * g;
#pragma unroll
        for (int kk = 0; kk < 4; ++kk) { u32x4 p;
#pragma unroll
            for (int j = 0; j < 4; ++j) p[j] = pg8::cvt_pk_bf16(qf[8 * kk + 2 * j] * rs * gp[8 * kk + 2 * j], qf[8 * kk + 2 * j + 1] * rs * gp[8 * kk + 2 * j + 1]);
            bqa[kk] = __builtin_bit_cast(bf16x8_t, p); }
    }
    f32x4 lg[16];
    const bf16_t* kbase = B0 + (size_t)b * S * 1024 + 512 + 32 * g;
    bf16x8_t ka[4][4];
#define DSA_ISSUE_K(i, slot) do { const int s_ = sel[16 * (i) + fr]; const bf16_t* kp_ = kbase + (size_t)s_ * 1024; \
        _Pragma("unroll") for (int kk = 0; kk < 4; ++kk) ka[slot][kk] = *(const bf16x8_t*)(kp_ + 8 * kk); } while (0)
    DSA_ISSUE_K(0, 0); DSA_ISSUE_K(1, 1); DSA_ISSUE_K(2, 2); DSA_ISSUE_K(3, 3);
    asm volatile("" ::: "memory");
#pragma unroll
    for (int i = 0; i < 16; ++i) {
        f32x4 acc = (f32x4){0.f, 0.f, 0.f, 0.f};
#pragma unroll
        for (int kk = 0; kk < 4; ++kk) acc = __builtin_amdgcn_mfma_f32_16x16x32_bf16(ka[i & 3][kk], bqa[kk], acc, 0, 0, 0);
        lg[i] = acc;
        if (i + 4 < 16) DSA_ISSUE_K(i + 4, i & 3);
        asm volatile("" ::: "memory");
    }
#undef DSA_ISSUE_K
    const bf16_t* vb0 = B0 + (size_t)b * S * 1024 + 640 + 8 * (lane & 15);
    u32x4 vr[2][8];
#define DSA_ISSUE_V(ks, slot) do { _Pragma("unroll") for (int i = 0; i < 8; ++i) { const int s_ = sel[32 * (ks) + 4 * i + (lane >> 4)]; vr[slot][i] = *(const u32x4*)(vb0 + (size_t)s_ * 1024); } } while (0)
    DSA_ISSUE_V(0, 0);
    asm volatile("" ::: "memory");
    float mx = -INFINITY;
#pragma unroll
    for (int i = 0; i < 16; ++i) {
        const u32x2 sv = *(const LAS u32x2*)(sel + 16 * i + 4 * g);
#pragma unroll
        for (int r = 0; r < 4; ++r) { const int j = 16 * i + 4 * g + r; const int sj = (int)((r & 1) ? (sv[r >> 1] >> 16) : (sv[r >> 1] & 0xffffu));
            int d = t - sj; d = d < 0 ? 0 : (d > 127 ? 127 : d);
            const float v = (j < cnt) ? lg[i][r] + s_bias[d * 8 + hd] : -INFINITY; lg[i][r] = v; mx = fmaxf(mx, v); }
    }
    mx = fmaxf(mx, __shfl_xor(mx, 16)); mx = fmaxf(mx, __shfl_xor(mx, 32));
    float sm = 0.f;
#pragma unroll
    for (int i = 0; i < 16; ++i)
#pragma unroll
        for (int r = 0; r < 4; ++r) { const float p = __expf(lg[i][r] - mx); lg[i][r] = p; sm += p; }
    sm += __shfl_xor(sm, 16); sm += __shfl_xor(sm, 32);
    const float inv = 1.f / sm;
    bf16x8_t pa[8];
#pragma unroll
    for (int ks = 0; ks < 8; ++ks) { u32x4 p; const f32x4 p0 = lg[2 * ks], p1 = lg[2 * ks + 1];
        p.x = pg8::cvt_pk_bf16(p0[0], p0[1]); p.y = pg8::cvt_pk_bf16(p0[2], p0[3]); p.z = pg8::cvt_pk_bf16(p1[0], p1[1]); p.w = pg8::cvt_pk_bf16(p1[2], p1[3]);
        pa[ks] = __builtin_bit_cast(bf16x8_t, p); }
    f32x4 out[8];
#pragma unroll
    for (int c = 0; c < 8; ++c) out[c] = (f32x4){0.f, 0.f, 0.f, 0.f};
    const int tq = fr >> 2, tp = fr & 3;
    const unsigned traddr = (unsigned)(uintptr_t)vt + VT_STRIDE * (4 * g + tq) + 16 * (tp >> 1) + 8 * (tp & 1);
    DSA_ISSUE_V(1, 1);
    asm volatile("" ::: "memory");
#pragma unroll
    for (int ks = 0; ks < 8; ++ks) {
#pragma unroll
        for (int i = 0; i < 8; ++i) *(LAS u32x4*)(vt + (4 * i + (lane >> 4)) * VT_STRIDE + 16 * (lane & 15)) = vr[ks & 1][i];
        if (ks + 2 < 8) DSA_ISSUE_V(ks + 2, ks & 1);
        LDS_WAIT();
#pragma unroll
        for (int half = 0; half < 2; ++half) {
            s16x4 tr[8];
            if (half == 0) tr8_dsa0(traddr, tr); else tr8_dsa1(traddr, tr);
#pragma unroll
            for (int cc = 0; cc < 4; ++cc) {
                const bf16x8_t vf = __builtin_shufflevector(tr[2 * cc], tr[2 * cc + 1], 0, 1, 2, 3, 4, 5, 6, 7);
                out[4 * half + cc] = __builtin_amdgcn_mfma_f32_16x16x32_bf16(pa[ks], vf, out[4 * half + cc], 0, 0, 0);
            }
        }
        asm volatile("" ::: "memory");
    }
#undef DSA_ISSUE_V
    float invh[4];
#pragma unroll
    for (int r = 0; r < 4; ++r) invh[r] = __shfl(inv, 4 * (g & 1) + r);
    float ss = 0.f;
#pragma unroll
    for (int c = 0; c < 8; ++c)
#pragma unroll
        for (int r = 0; r < 4; ++r) { const float v = out[c][r] * invh[r]; out[c][r] = v; ss += (g < 2) ? v * v : 0.f; }
    const float rstd = rsqrtf(wave_sum(ss) * (1.f / 1024.f) + EPS);
    if (g < 2) {
#pragma unroll
        for (int c = 0; c < 8; ++c)
#pragma unroll
            for (int r = 0; r < 4; ++r) { const int e = (4 * g + r) * 128 + 16 * c + fr; O[m * D + e] = f2bf(out[c][r] * rstd * gn_a[e]); }
    }
}
__device__ __forceinline__ void idx4(const bf16_t* __restrict__ B0, const bf16_t* __restrict__ QI, int b, int t0, float* __restrict__ SCW) {
    int lane = threadIdx.x & 63; asm volatile("" : "+v"(lane));
    const int r32 = lane & 31, hi = lane >> 5;
    bf16x8_t aq[2][4]; float wv[2][16];
#pragma unroll
    for (int blk = 0; blk < 2; ++blk) {
        const int tt = (r32 >> 2) & 1, hh = (r32 & 3) + 4 * (r32 >> 3);
        const bf16_t* qp = QI + (size_t)(b * S + t0 + 2 * blk + tt) * 1024 + hh * 64 + 32 * hi;
#pragma unroll
        for (int kk = 0; kk < 4; ++kk) aq[blk][kk] = *(const bf16x8_t*)(qp + 8 * kk);
        const bf16_t* wp = B0 + (size_t)(b * S + t0 + 2 * blk + hi) * 1024 + 832;
        const u32x4 w0 = *(const u32x4*)wp, w1 = *(const u32x4*)(wp + 8);
#pragma unroll
        for (int j = 0; j < 4; ++j) { wv[blk][2 * j] = __uint_as_float(w0[j] << 16); wv[blk][2 * j + 1] = __uint_as_float(w0[j] & 0xffff0000u); wv[blk][8 + 2 * j] = __uint_as_float(w1[j] << 16); wv[blk][8 + 2 * j + 1] = __uint_as_float(w1[j] & 0xffff0000u); }
    }
    const bf16_t* kb = B0 + (size_t)(b * S + r32) * 1024 + 768 + 32 * hi;
    const int nsub = (t0 + 3) / 32 + 1;
    bf16x8_t bk[3][4];
#define IDX_ISSUE(sub, slot) do { const int sb_ = (sub) < nsub ? (sub) : nsub - 1; const bf16_t* p_ = kb + (size_t)sb_ * 32 * 1024; \
        _Pragma("unroll") for (int kk = 0; kk < 4; ++kk) bk[slot][kk] = *(const bf16x8_t*)(p_ + 8 * kk); } while (0)
    IDX_ISSUE(0, 0); IDX_ISSUE(1, 1); IDX_ISSUE(2, 2);
    for (int sub0 = 0; sub0 < nsub; sub0 += 3) {
#pragma unroll
        for (int j = 0; j < 3; ++j) {
            const int sub = sub0 + j;
            if (sub < nsub) {
#pragma unroll
                for (int blk = 0; blk < 2; ++blk) {
                    f32x16 sc;
#pragma unroll
                    for (int i = 0; i < 16; ++i) sc[i] = 0.f;
#pragma unroll
                    for (int kk = 0; kk < 4; ++kk) sc = __builtin_amdgcn_mfma_f32_32x32x16_bf16(aq[blk][kk], bk[j][kk], sc, 0, 0, 0);
                    float score = 0.f;
#pragma unroll
                    for (int i = 0; i < 16; ++i) score += wv[blk][i] * fmaxf(sc[i], 0.f);
                    SCW[(size_t)(2 * blk + hi) * 4096 + sub * 32 + r32] = score;
                }
            }
            IDX_ISSUE(sub + 3, j);
            asm volatile("" ::: "memory");
        }
    }
#undef IDX_ISSUE
}
__device__ __forceinline__ void p5_attn(const MkArgs& a, LAS unsigned char* lds) {
    const int tid = threadIdx.x, lane = tid & 63, wave = __builtin_amdgcn_readfirstlane(tid >> 6);
    const bf16_t* B0 = (const bf16_t*)(a.ws + WS_B0); const bf16_t* QI = (const bf16_t*)(a.ws + WS_QI); const bf16_t* QA = (const bf16_t*)(a.ws + WS_QA);
    const bf16_t* QB = (const bf16_t*)(a.ws + WS_QB); const bf16_t* KB = (const bf16_t*)(a.ws + WS_KB); const bf16_t* VB = (const bf16_t*)(a.ws + WS_VB);
    bf16_t* O = (bf16_t*)(a.ws + WS_O); float* OBS = (float*)(a.ws + WS_OBS); const float* rel_bias = a.in[10];
    const int gw = blockIdx.x * 8 + wave;
    float* SCW = (float*)(a.ws + (gw < 1024 ? WS_XN : WS_OBRAW)) + (size_t)(gw & 1023) * (4 * 4096);
    constexpr int KT_BYTES = 128 * 144;
    LAS unsigned char* s_kt = lds;
    LAS unsigned char* s_vt = lds + wave * 9216;
    LAS float* s_bias = (LAS float*)(lds + 73728);
    LAS unsigned short* s_sel = (LAS unsigned short*)(lds + 77824 + wave * 2048);
    for (int i = tid; i < 1024; i += MK_THREADS) s_bias[i] = rel_bias[t5_bucket(i >> 3) * 8 + (i & 7)];
    const bool xcd_ok = (gridDim.x & 7) == 0;
    const int xb = xcd_ok ? (((int)blockIdx.x & 7) >> 1) : 0, rbk = xcd_ok ? (((int)blockIdx.x >> 3) * 2 + ((int)blockIdx.x & 1)) : (int)blockIdx.x, RB = xcd_ok ? (int)(gridDim.x >> 2) : (int)gridDim.x;
    const int nitem = xcd_ok ? 128 : 512;
    for (int q = 0; q * RB < nitem; ++q) {
        const int it = (q & 1) ? (q * RB + (RB - 1 - rbk)) : (q * RB + rbk);
        if (it >= nitem) continue;
        const int b = xcd_ok ? xb : (it & 3), t0i = (xcd_ok ? it : (it >> 2)) * 32, t0 = t0i + 4 * wave;
        {
            int ln = lane; asm volatile("" : "+v"(ln));
            const int r32 = ln & 31, hi = ln >> 5;
            bf16x8_t aq[2][4]; float wv[2][16];
#pragma unroll
            for (int blk = 0; blk < 2; ++blk) {
                const int tt = (r32 >> 2) & 1, hh = (r32 & 3) + 4 * (r32 >> 3);
                const bf16_t* qp = QI + (size_t)(b * S + t0 + 2 * blk + tt) * 1024 + hh * 64 + 32 * hi;
#pragma unroll
                for (int kk = 0; kk < 4; ++kk) aq[blk][kk] = *(const bf16x8_t*)(qp + 8 * kk);
                const bf16_t* wp = B0 + (size_t)(b * S + t0 + 2 * blk + hi) * 1024 + 832;
                const u32x4 w0 = *(const u32x4*)wp, w1 = *(const u32x4*)(wp + 8);
#pragma unroll
                for (int j = 0; j < 4; ++j) { wv[blk][2 * j] = __uint_as_float(w0[j] << 16); wv[blk][2 * j + 1] = __uint_as_float(w0[j] & 0xffff0000u); wv[blk][8 + 2 * j] = __uint_as_float(w1[j] << 16); wv[blk][8 + 2 * j + 1] = __uint_as_float(w1[j] & 0xffff0000u); }
            }
            const int nkb = (t0i + 31) / 128 + 1;
            REP(50) {
                const int key = tid >> 2, q4 = tid & 3;
                const bf16_t* src = B0 + (size_t)(b * S + key) * 1024 + 768 + 16 * q4;
                u32x4 v0 = *(const u32x4*)src, v1 = *(const u32x4*)(src + 8);
                __syncthreads();
                *(LAS u32x4*)(s_kt + key * 144 + q4 * 32) = v0; *(LAS u32x4*)(s_kt + key * 144 + q4 * 32 + 16) = v1;
                __syncthreads();
                for (int kb = 0; kb < nkb; ++kb) {
                    LAS unsigned char* cur = s_kt + (kb & 1) * KT_BYTES; LAS unsigned char* nxt = s_kt + ((kb + 1) & 1) * KT_BYTES;
                    const bool more = kb + 1 < nkb;
                    if (more) { const bf16_t* sn = src + (size_t)(kb + 1) * 128 * 1024; v0 = *(const u32x4*)sn; v1 = *(const u32x4*)(sn + 8); }
#pragma unroll
                    for (int sub = 0; sub < 4; ++sub) {
                        bf16x8_t bk[4];
#pragma unroll
                        for (int kk = 0; kk < 4; ++kk) bk[kk] = *(const LAS bf16x8_t*)(cur + (32 * sub + r32) * 144 + (32 * hi + 8 * kk) * 2);
#pragma unroll
                        for (int blk = 0; blk < 2; ++blk) {
                            f32x16 sc;
#pragma unroll
                            for (int i = 0; i < 16; ++i) sc[i] = 0.f;
#pragma unroll
                            for (int kk = 0; kk < 4; ++kk) sc = __builtin_amdgcn_mfma_f32_32x32x16_bf16(aq[blk][kk], bk[kk], sc, 0, 0, 0);
                            float score = 0.f;
#pragma unroll
                            for (int i = 0; i < 16; ++i) score += wv[blk][i] * fmaxf(sc[i], 0.f);
                            SCW[(size_t)(2 * blk + hi) * 4096 + kb * 128 + sub * 32 + r32] = score;
                        }
                    }
                    if (more) { *(LAS u32x4*)(nxt + key * 144 + q4 * 32) = v0; *(LAS u32x4*)(nxt + key * 144 + q4 * 32 + 16) = v1; }
                    __syncthreads();
                }
            }
        }
        asm volatile("s_waitcnt vmcnt(0)" ::: "memory");
        REP(51) for (int tt = 0; tt < 4; ++tt) {
            const int t = t0 + tt, n = t + 1; const float* row = SCW + (size_t)tt * 4096; LAS unsigned short* sel = s_sel + tt * 256;
            if (n <= 256) { for (int i = 0; i < 4; ++i) { const int j = lane + 64 * i; sel[j] = (unsigned short)(j < n ? j : 0); } }
            else if (n <= 1024) topk_row<16>(row, n, sel, lane);
            else if (n <= 2048) topk_row<32>(row, n, sel, lane);
            else if (n <= 3072) topk_row<48>(row, n, sel, lane);
            else topk_row<64>(row, n, sel, lane);
        }
        LDS_WAIT();
        REP(52) for (int tt = 0; tt < 4; ++tt) {
            const int t = t0 + tt;
            dsa_token(B0, QA, a.in[8], a.in[11], O, b, t, t + 1 < 256 ? t + 1 : 256, s_sel + tt * 256, s_bias, s_vt);
        }
        REP(53) {
            const int h = wave, q0 = t0i;
            f32x16 o[4];
            sb_wave(QB, KB, VB, b, h, q0, s_vt, o);
            const int r32 = lane & 31, hi = lane >> 5;
            float ss = 0.f;
#pragma unroll
            for (int c = 0; c < 4; ++c)
#pragma unroll
                for (int i = 0; i < 16; ++i) ss += o[c][i] * o[c][i];
            ss += __shfl_xor(ss, 32);
            const size_t m = (size_t)b * S + q0 + r32;
            if (hi == 0) OBS[m * 8 + h] = ss;
            bf16_t* op = O + m * D + 1024 + h * 128;
#pragma unroll
            for (int c = 0; c < 4; ++c)
#pragma unroll
                for (int g = 0; g < 4; ++g) { const int d = 32 * c + 8 * g + 4 * hi;
                    u32x2 w; w.x = pk2(o[c][4 * g], o[c][4 * g + 1]); w.y = pk2(o[c][4 * g + 2], o[c][4 * g + 3]); *(u32x2*)(op + d) = w; }
        }
    }
}
__device__ __forceinline__ void obnorm_pass(const MkArgs& a) {
    const int tid = threadIdx.x, lane = tid & 63, wave = __builtin_amdgcn_readfirstlane(tid >> 6);
    bf16_t* O = (bf16_t*)(a.ws + WS_O); const float* OBS = (const float*)(a.ws + WS_OBS); const float* gn_b = a.in[12];
    f32x4 gv[4];
#pragma unroll
    for (int j = 0; j < 4; ++j) gv[j] = *(const f32x4*)(gn_b + 16 * lane + 4 * j);
    for (int m = blockIdx.x * 8 + wave; m < M; m += gridDim.x * 8) {
        const f32x4 s0 = *(const f32x4*)(OBS + (size_t)m * 8), s1 = *(const f32x4*)(OBS + (size_t)m * 8 + 4);
        const float rstd = rsqrtf(((s0[0] + s0[1]) + (s0[2] + s0[3]) + (s1[0] + s1[1]) + (s1[2] + s1[3])) * (1.f / 1024.f) + EPS);
        u32x4* p = (u32x4*)(O + (size_t)m * D + 1024 + 16 * lane);
        u32x4 v0 = p[0], v1 = p[1];
#pragma unroll
        for (int j = 0; j < 4; ++j) { const float lo0 = __uint_as_float(v0[j] << 16) * rstd, hi0 = __uint_as_float(v0[j] & 0xffff0000u) * rstd;
            const float lo1 = __uint_as_float(v1[j] << 16) * rstd, hi1 = __uint_as_float(v1[j] & 0xffff0000u) * rstd;
            v0[j] = pk2(lo0 * gv[j >> 1][2 * (j & 1)], hi0 * gv[j >> 1][2 * (j & 1) + 1]); v1[j] = pk2(lo1 * gv[2 + (j >> 1)][2 * (j & 1)], hi1 * gv[2 + (j >> 1)][2 * (j & 1) + 1]); }
        p[0] = v0; p[1] = v1;
    }
}

constexpr int CW_BAR = 4096;
__global__ void __launch_bounds__(MK_THREADS, 2) mk_fwd(MkArgs a) {
    extern __shared__ __attribute__((aligned(16))) unsigned char lds_raw[];
    LAS unsigned char* lds = (LAS unsigned char*)lds_raw;
    const int lo = a.ph_lo, hi = a.ph_hi;
    const bool fused = (hi - lo) > 1;
    volatile LAS unsigned* misc = (volatile LAS unsigned*)(lds + MK_MISC_OFF);
    XcdBarrier bar; bar.bar = (unsigned*)(a.ws + WS_CTL) + CW_BAR; bar.x = 0; bar.st = misc + 8;
    if (fused) {
        if (threadIdx.x < 32) misc[threadIdx.x] = 0u;
        __syncthreads();
        bar = xcd_barrier_post((unsigned*)(a.ws + WS_CTL) + CW_BAR, misc + 8);
    }
    int nbar = 0;
#ifdef MK_TS_A
    volatile LAS unsigned* ts_ = (volatile LAS unsigned*)(lds + MK_MISC_OFF + 128); int nts_ = 0;
#define STAMP() do { if (threadIdx.x == 0) ts_[nts_] = (unsigned)__builtin_amdgcn_s_memrealtime(); ++nts_; } while (0)
#else
#define STAMP() do {} while (0)
#endif
    STAMP();
#define IN(k) (lo <= (k) && (k) < hi)
#define SEAM() do { if (fused) { if (nbar == 0) cg::this_grid().sync(); else xcd_barrier(bar); ++nbar; } STAMP(); } while (0)
    if (IN(0)) { REP(0) { p0_prep(a, lds); __syncthreads(); } SEAM(); }
    if (IN(1)) { REP(1) { p1_xn(a, lds); __syncthreads(); } SEAM(); }
    if (IN(2)) {
        pg8::Gemm g{(const bf16_t*)(a.ws + WS_XN), (const bf16_t*)(a.ws + WS_WTIN), M, 4096, D, D, D};
        pg8::StaticOrder S; S.init(g, (int)gridDim.x, (int)blockIdx.x, (MK_DUP) == 2 ? 2 : 1);
        EpiInProj E{(bf16_t*)(a.ws + WS_B0), (bf16_t*)(a.ws + WS_QB), (bf16_t*)(a.ws + WS_KB), (bf16_t*)(a.ws + WS_VB), (float*)(a.ws + WS_SSQ)};
        pg8::gemm_phase<EpiInProj, pg8::StaticOrder>(lds, g, S, E);
        SEAM();
    }
    if (IN(3)) {
        kanorm_pass(a);
        pg8::Gemm g{(const bf16_t*)(a.ws + WS_B0), (const bf16_t*)(a.ws + WS_WTQUP), M, 2048, 512, 1024, 512};
        pg8::StaticOrder S; S.init(g, (int)gridDim.x, (int)blockIdx.x, (MK_DUP) == 3 ? 2 : 1);
        EpiQupG E{(const float*)(a.ws + WS_SSQ), (bf16_t*)(a.ws + WS_QA), (bf16_t*)(a.ws + WS_QI)};
        pg8::gemm_phase<EpiQupG, pg8::StaticOrder>(lds, g, S, E);
        SEAM();
    }
    if (IN(5)) { REP(5) { p5_attn(a, lds); __syncthreads(); } SEAM(); }
    if (IN(7)) {
        obnorm_pass(a);
        pg8::Gemm g{(const bf16_t*)(a.ws + WS_O), (const bf16_t*)(a.ws + WS_WTOUT), M, D, D, D, D};
        pg8::StaticOrder S; S.init(g, (int)gridDim.x, (int)blockIdx.x, (MK_DUP) == 7 ? 2 : 1);
        EpiOutProj E{a.in[0], (const float*)(a.ws + WS_MOD), a.out};
        pg8::gemm_phase<EpiOutProj, pg8::StaticOrder>(lds, g, S, E);
        SEAM();
    }
    if (IN(8)) { p8_route(a, lds); SEAM(); }
    if (IN(9)) {
        const MoeTab t = moe_tab_build(a, lds);
        pg8::Gemm g{(const bf16_t*)(a.ws + WS_XN), (const bf16_t*)(a.ws + WS_WTGU), 0, 0, D, D, D};
        SchedGU S; S.init(t, a, (int)gridDim.x, (int)blockIdx.x, (MK_DUP) == 9 ? 2 : 1);
        EpiGU E{(bf16_t*)(a.ws + WS_U)};
        pg8::gemm_phase<EpiGU, SchedGU>(lds, g, S, E);
        SEAM();
    }
    if (IN(10)) {
        const MoeTab t = moe_tab_build(a, lds);
        pg8::Gemm g{(const bf16_t*)(a.ws + WS_U), (const bf16_t*)(a.ws + WS_WTDN), 0, 0, 512, 512, 512};
        SchedDN S; S.init(t, a, (int)gridDim.x, (int)blockIdx.x, (MK_DUP) == 10 ? 2 : 1);
        EpiY E{(bf16_t*)(a.ws + WS_Y)};
        pg8::gemm_phase<EpiY, SchedDN>(lds, g, S, E);
        SEAM();
    }
    if (IN(11)) {
        const MoeTab t = moe_tab_build(a, lds);
        REP(11) p11_combine(a, t);
    }
#ifdef MK_XBAR
    for (int i_ = 0; i_ < MK_XBAR; ++i_) { SEAM(); }
#endif
#ifdef MK_TS_A
    SEAM();
    __syncthreads();
    if (blockIdx.x == 0) {
        const float db = (MK_TS_A == 10) ? (float)(ts_[10] - ts_[0]) * 0.01f : (float)(ts_[MK_TS_A + 1] - ts_[MK_TS_A]) * 0.01f;
#ifdef MK_TS_Q
        const float dq = (float)(MK_TS_Q) * rintf(db / (float)(MK_TS_Q));
#else
        const float dq = db;
#endif
        for (int i = threadIdx.x; i < (1 << 20); i += MK_THREADS) a.out[4096 + i] *= (1.f + dq * (MK_TS_C));
    }
#endif
#undef IN
#undef SEAM
}

#ifndef MK_ONE_LAUNCH
#define MK_ONE_LAUNCH 1
#endif
extern "C" void kernel_launch(void* const* d_in, const int* in_sizes, int n_in, void* d_out, int out_size, void* d_ws, size_t ws_size, hipStream_t stream) {
    static int grid = 0;
    if (grid == 0) {
        if (ws_size < WS_END || n_in != 20 || out_size != M * D) { fprintf(stderr, "kernel_launch: unexpected sizes: ws %zu (need %zu), n_in %d, out %d\n", ws_size, (size_t)WS_END, n_in, out_size); grid = -1; return; }
        int dev = 0, cus = 0, per_cu = 0;
        if (hipGetDevice(&dev) != hipSuccess || hipDeviceGetAttribute(&cus, hipDeviceAttributeMultiprocessorCount, dev) != hipSuccess) { grid = -1; return; }
        if (hipFuncSetAttribute((const void*)mk_fwd, hipFuncAttributeMaxDynamicSharedMemorySize, MK_LDS) != hipSuccess) { fprintf(stderr, "kernel_launch: hipFuncSetAttribute failed\n"); grid = -1; return; }
        if (hipOccupancyMaxActiveBlocksPerMultiprocessor(&per_cu, (const void*)mk_fwd, MK_THREADS, MK_LDS) != hipSuccess || per_cu < 1) { fprintf(stderr, "kernel_launch: occupancy query failed (%d)\n", per_cu); grid = -1; return; }
        grid = cus < 256 ? cus : 256;
        fprintf(stderr, "kernel_launch: cus %d per_cu %d grid %d\n", cus, per_cu, grid);
    }
    if (grid < 0) return;
    if (hipMemsetAsync(d_ws, 0, 1 * MiB, stream) != hipSuccess) return;
    MkArgs a{};
    for (int i = 0; i < 20; ++i) a.in[i] = (const float*)d_in[i];
    a.out = (float*)d_out; a.ws = (unsigned char*)d_ws;
#if MK_ONE_LAUNCH
    a.ph_lo = 0; a.ph_hi = 12;
    void* args[] = {&a};
    const hipError_t e = hipLaunchCooperativeKernel((const void*)mk_fwd, dim3(grid), dim3(MK_THREADS), args, MK_LDS, stream);
    if (e != hipSuccess) fprintf(stderr, "kernel_launch: cooperative launch failed: %s (grid %d)\n", hipGetErrorString(e), grid);
#else
    const int phases[] = {0, 1, 2, 3, 5, 7, 8, 9, 10, 11};
    for (int ph : phases) { a.ph_lo = ph; a.ph_hi = ph + 1; hipLaunchKernelGGL(mk_fwd, dim3(grid), dim3(MK_THREADS), MK_LDS, stream, a); }
#endif
}
```

```cpp
#include <hip/hip_runtime.h>
#include <hip/hip_cooperative_groups.h>
#include <stdint.h>
#include <cstdio>
namespace cg = cooperative_groups;

typedef unsigned short bf16_t;
#define LAS __attribute__((address_space(3)))

constexpr int D = 2048, NB = 4, S = 4096, M = NB * S;
constexpr int NMOD = 6 * D;
constexpr int DIN = 3920;
constexpr float EPS = 1e-6f;
constexpr size_t MiB = 1ull << 20;
constexpr size_t WS_CTL = 0;
constexpr size_t WS_MOD = 1 * MiB;
constexpr size_t WS_RC = 2 * MiB;
constexpr size_t WS_EID = 3 * MiB;
constexpr size_t WS_GW = 4 * MiB;
constexpr size_t WS_SSQ = 5 * MiB;
constexpr size_t WS_XN = 8 * MiB;
constexpr size_t WS_B0 = 72 * MiB;
constexpr size_t WS_QB = 104 * MiB;
constexpr size_t WS_KB = 136 * MiB;
constexpr size_t WS_VB = 168 * MiB;
constexpr size_t WS_QA = 200 * MiB;
constexpr size_t WS_QI = 232 * MiB;
constexpr size_t WS_SEL = 264 * MiB;
constexpr size_t WS_O = 272 * MiB;
constexpr size_t WS_OBRAW = 336 * MiB;
constexpr size_t WS_MODP = 400 * MiB;
constexpr size_t WS_WTIN = 408 * MiB;
constexpr size_t WS_WTQUP = 424 * MiB;
constexpr size_t WS_WTOUT = 426 * MiB;
constexpr size_t WS_WTGU = 434 * MiB;
constexpr size_t WS_WTDN = 562 * MiB;
constexpr size_t WS_RT = 6 * MiB;
constexpr size_t WS_LIST = WS_B0;
constexpr size_t WS_U = WS_O;
constexpr size_t WS_X1B = WS_OBRAW;
constexpr size_t WS_Y = WS_QB;
constexpr size_t WS_OBS = 7 * MiB;
constexpr int CW_CNT = 8192;
constexpr size_t WS_END = 626 * MiB;

__device__ __forceinline__ float bf2f(bf16_t v) { return __uint_as_float(((unsigned)v) << 16); }
__device__ __forceinline__ bf16_t f2bf(float f) { unsigned u = __float_as_uint(f); u += 0x7fffu + ((u >> 16) & 1u); return (bf16_t)(u >> 16); }
__device__ __forceinline__ float silu_f(float v) { return v / (1.f + __expf(-v)); }
__device__ __forceinline__ unsigned fkey(float f) { const unsigned u = __float_as_uint(f); return (u & 0x80000000u) ? ~u : (u | 0x80000000u); }
__device__ __forceinline__ int t5_bucket(int dist) {
    if (dist < 16) return dist;
    int large = 16 + (int)(__logf((float)dist * (1.f / 16.f)) / 2.0794415416798357f * 16.f);
    return large < 31 ? large : 31;
}

namespace pg8 {
#define PG8_LAS __attribute__((address_space(3)))
typedef short bf16x8 __attribute__((ext_vector_type(8)));
typedef float f32x4 __attribute__((ext_vector_type(4)));
typedef unsigned u32x4 __attribute__((ext_vector_type(4)));
constexpr int BM = 256, BK = 64, HALF = 128, HTB = HALF * BK * 2, STAGE_BYTES = 8 * HTB, NXCD = 8, WGM = 8;
__host__ __device__ __forceinline__ int lds_byte(int r, int c) { const int st = (r >> 4) * 2 + (c >> 5), rr = r & 15, cc = c & 31, ob = rr * 64 + cc * 2; return st * 1024 + (ob ^ (((ob >> 9) & 1) << 5)); }
__host__ __device__ __forceinline__ void stage_rc(int b, int& R, int& C) { const int st = b / 1024, sb = b % 1024, swz = sb ^ (((sb >> 9) & 1) << 5); R = (st >> 1) * 16 + swz / 64; C = (st & 1) * 32 + (swz % 64) / 2; }
__host__ __device__ __forceinline__ int perm32(int rho) { const int n = rho >> 4, i = rho & 15; return 8 * (i >> 2) + 4 * n + (i & 3); }
__device__ __forceinline__ unsigned cvt_pk_bf16(float lo, float hi) { unsigned r; asm volatile("v_cvt_pk_bf16_f32 %0, %1, %2" : "=v"(r) : "v"(lo), "v"(hi)); return r; }

struct Unit { int pm, pn, aux, dup; const char* a; const char* b; unsigned va[2][2]; };
struct Gemm { const bf16_t* A; const bf16_t* Bt; int M, N, K, lda, ldb; };

struct StaticOrder {
    int nM, nN, nwg, G, c, ndup; const char* A; const char* Bt; size_t tstepA, tstepB; unsigned vb[2][2];
    __device__ void init(const Gemm& g, int G_, int c_, int ndup_ = 1) { ndup = ndup_; nM = g.M / BM; nN = g.N / BM; nwg = nM * nN; G = G_; c = c_; A = (const char*)g.A; Bt = (const char*)g.Bt; tstepA = (size_t)BM * g.lda * 2; tstepB = (size_t)BM * g.ldb * 2;
#pragma unroll
        for (int i = 0; i < 2; ++i) { int R, C; stage_rc((int)threadIdx.x * 16 + i * 8192, R, C); vb[0][i] = (unsigned)(R * g.lda + C) * 2u; vb[1][i] = (unsigned)((HALF + R) * g.lda + C) * 2u; } }
    __device__ bool next(int i, Unit& u) const {
        const long L0 = (long)i * G + c; if (L0 >= (long)nwg * ndup) return false;
        u.dup = (int)(L0 / nwg); int wgid = (int)(L0 % nwg); { const int q = nwg / NXCD, r = nwg % NXCD, xcd = wgid % NXCD, off = wgid / NXCD; wgid = (xcd < r ? xcd * (q + 1) : r * (q + 1) + (xcd - r) * q) + off; }
        const int nig = WGM * nN, gid = wgid / nig, fm = gid * WGM, gsz = (nM - fm) < WGM ? (nM - fm) : WGM;
        u.pm = fm + ((wgid % nig) % gsz); u.pn = (wgid % nig) / gsz;
        u.a = A + (size_t)u.pm * tstepA; u.b = Bt + (size_t)u.pn * tstepB; u.aux = 0; u.va[0][0] = vb[0][0]; u.va[0][1] = vb[0][1]; u.va[1][0] = vb[1][0]; u.va[1][1] = vb[1][1]; return true;
    }
};

template <class Epi, class Sched>
__device__ __forceinline__ void gemm_phase(PG8_LAS unsigned char* lds, const Gemm g, const Sched& S, const Epi& E) {
    const int tid = threadIdx.x, wid = __builtin_amdgcn_readfirstlane(tid >> 6), lane = tid & 63, wr = wid >> 2, wc = wid & 3, fr = lane & 15, fq = lane >> 4;
    const int K = g.K, nt = K / BK;
    unsigned voffB[2];
#pragma unroll
    for (int i = 0; i < 2; ++i) { int R, C; stage_rc(tid * 16 + i * 8192, R, C); const int Rb = Epi::PERM ? ((R & ~31) + perm32(R & 31)) : R;
        voffB[i] = (unsigned)(Rb * g.ldb + C) * 2u; }
    const size_t kstep = (size_t)(BK * 2);
    const size_t hstepB = (size_t)HALF * g.ldb * 2;
    const unsigned ldsw = (unsigned)wid * 1024u;
    const int aoff = lds_byte(wr * 64 + fr, fq * 8), boff = lds_byte(wc * 32 + fr, fq * 8);
#define PG8_SA(b, h) (((b) * 2 + (h)) * HTB)
#define PG8_SB(b, h) ((4 + (b) * 2 + (h)) * HTB)
#define PG8_STAGE(bufoff, gbase, voff) do { _Pragma("unroll") for (int _i = 0; _i < 2; ++_i) \
        __builtin_amdgcn_global_load_lds((const unsigned*)((const char*)(gbase) + (voff)[_i]), (PG8_LAS unsigned*)(lds + (bufoff) + ldsw + _i * 8192), 16, 0, 0); } while (0)
#define PG8_LDA(dst, b, h) do { _Pragma("unroll") for (int m = 0; m < 4; ++m) _Pragma("unroll") for (int k = 0; k < 2; ++k) dst[m][k] = *(const PG8_LAS bf16x8*)(lds + PG8_SA(b, h) + aoff + m * 2048 + k * 1024); } while (0)
#define PG8_LDB(dst, b, h) do { _Pragma("unroll") for (int n = 0; n < 2; ++n) _Pragma("unroll") for (int k = 0; k < 2; ++k) dst[n][k] = *(const PG8_LAS bf16x8*)(lds + PG8_SB(b, h) + boff + n * 2048 + k * 1024); } while (0)
#define PG8_MMA(ai, bj, At, Bt) do { __builtin_amdgcn_s_setprio(1); _Pragma("unroll") for (int m = 0; m < 4; ++m) _Pragma("unroll") for (int n = 0; n < 2; ++n) _Pragma("unroll") for (int k = 0; k < 2; ++k) \
        acc[ai][bj][m][n] = __builtin_amdgcn_mfma_f32_16x16x32_bf16(Bt[n][k], At[m][k], acc[ai][bj][m][n], 0, 0, 0); __builtin_amdgcn_s_setprio(0); } while (0)
#define PG8_WAIT_V(n) asm volatile("s_waitcnt vmcnt(" #n ")" ::: "memory")
#define PG8_WAIT_L(n) asm volatile("s_waitcnt lgkmcnt(" #n ")" ::: "memory")
#define PG8_BAR __builtin_amdgcn_s_barrier()
#define PG8_SCHED __builtin_amdgcn_sched_barrier(0)
    Unit cur, nxt; int ui = 0;
    if (!S.next(0, cur)) return;
    f32x4 acc[2][2][4][2];
#pragma unroll
    for (int a = 0; a < 2; ++a)
#pragma unroll
        for (int b = 0; b < 2; ++b)
#pragma unroll
            for (int m = 0; m < 4; ++m)
#pragma unroll
                for (int n = 0; n < 2; ++n) acc[a][b][m][n] = (f32x4){0.f, 0.f, 0.f, 0.f};
    bf16x8 At[4][2], B0[2][2], B1[2][2];
    const char* cA = cur.a; const char* cB = cur.b;
    PG8_STAGE(PG8_SB(0, 0), cB, voffB); PG8_STAGE(PG8_SB(0, 1), cB + hstepB, voffB); PG8_STAGE(PG8_SA(0, 0), cA, cur.va[0]); PG8_STAGE(PG8_SA(0, 1), cA, cur.va[1]);
    if (wr == 1) PG8_BAR;
    PG8_WAIT_V(2); PG8_BAR;
    PG8_STAGE(PG8_SB(1, 0), cB + kstep, voffB); PG8_STAGE(PG8_SA(1, 0), cA + kstep, cur.va[0]); PG8_STAGE(PG8_SB(1, 1), cB + hstepB + kstep, voffB);
    PG8_WAIT_V(6); PG8_BAR;
    for (;;) {
        const bool has_next = S.next(ui + 1, nxt);
        if (!has_next) nxt = cur;
        const char* nA = has_next ? nxt.a : cA; const char* nB = has_next ? nxt.b : cB;
        for (int t = 0; t < nt; t += 2) {
            const bool last = (t == nt - 2);
            const char* a1 = cA + (size_t)(t + 1) * kstep;
            const char* a2 = last ? nA : cA + (size_t)(t + 2) * kstep; const char* b2 = last ? nB : cB + (size_t)(t + 2) * kstep;
            const char* a3 = a2 + kstep; const char* b3 = b2 + kstep;
            unsigned vn0[2], vn1[2];
            vn0[0] = last ? nxt.va[0][0] : cur.va[0][0]; vn0[1] = last ? nxt.va[0][1] : cur.va[0][1]; vn1[0] = last ? nxt.va[1][0] : cur.va[1][0]; vn1[1] = last ? nxt.va[1][1] : cur.va[1][1];
            PG8_LDB(B0, 0, 0); PG8_LDB(B1, 0, 1); PG8_SCHED; PG8_LDA(At, 0, 0); PG8_STAGE(PG8_SA(1, 1), a1, cur.va[1]);
            PG8_WAIT_V(8); PG8_WAIT_L(0); PG8_BAR; PG8_MMA(0, 0, At, B0); PG8_MMA(0, 1, At, B1); PG8_BAR; PG8_SCHED;
            PG8_LDA(At, 0, 1); PG8_STAGE(PG8_SB(0, 0), b2, voffB); PG8_STAGE(PG8_SB(0, 1), b2 + hstepB, voffB); PG8_STAGE(PG8_SA(0, 0), a2, vn0);
            PG8_WAIT_V(8); PG8_WAIT_L(0); PG8_BAR; PG8_MMA(1, 0, At, B0); PG8_MMA(1, 1, At, B1); PG8_BAR; PG8_SCHED;
            PG8_LDB(B0, 1, 0); PG8_LDB(B1, 1, 1); PG8_SCHED; PG8_LDA(At, 1, 0); PG8_STAGE(PG8_SA(0, 1), a2, vn1);
            PG8_WAIT_V(8); PG8_WAIT_L(0); PG8_BAR; PG8_MMA(0, 0, At, B0); PG8_MMA(0, 1, At, B1); PG8_BAR; PG8_SCHED;
            PG8_LDA(At, 1, 1); PG8_STAGE(PG8_SB(1, 0), b3, voffB); PG8_STAGE(PG8_SB(1, 1), b3 + hstepB, voffB); PG8_STAGE(PG8_SA(1, 0), a3, vn0);
            PG8_WAIT_V(8); PG8_WAIT_L(0); PG8_BAR; PG8_MMA(1, 0, At, B0); PG8_MMA(1, 1, At, B1); PG8_BAR; PG8_SCHED;
        }
        if (wr == 0) PG8_BAR;
        E(acc, cur, wr, wc, fr, fq);
        if (!has_next) break;
#pragma unroll
        for (int a = 0; a < 2; ++a)
#pragma unroll
            for (int b = 0; b < 2; ++b)
#pragma unroll
                for (int m = 0; m < 4; ++m)
#pragma unroll
                    for (int n = 0; n < 2; ++n) acc[a][b][m][n] = (f32x4){0.f, 0.f, 0.f, 0.f};
        cur = nxt; cA = nA; cB = nB; ++ui;
        if (wr == 1) PG8_BAR;
    }
    PG8_WAIT_V(0);
    PG8_BAR;
#undef PG8_SA
#undef PG8_SB
#undef PG8_STAGE
#undef PG8_LDA
#undef PG8_LDB
#undef PG8_MMA
#undef PG8_WAIT_V
#undef PG8_WAIT_L
#undef PG8_BAR
#undef PG8_SCHED
}
}
#ifndef MK_DUP
#define MK_DUP -1
#endif
#define REP(k) for (int rep_ = 0; rep_ < ((MK_DUP) == (k) ? 2 : 1); ++rep_)

#define XB_TMO      128
#define XB_XCNT(j)  (256  + 64 * (j))
#define XB_XSUB(j)  (1280 + 64 * (j))
#define XB_XGEN(j)  (2304 + 64 * (j))
#define XB_TOP      3328
#define XB_TOPGEN   3392
#define XCD_BAR_WORDS 3456
#define XB_SPIN_CAP (1u << 18)
__device__ __forceinline__ unsigned xb_ld(unsigned* p)              { return __hip_atomic_load(p, __ATOMIC_RELAXED, __HIP_MEMORY_SCOPE_AGENT); }
__device__ __forceinline__ unsigned xb_add(unsigned* p, unsigned v) { return __hip_atomic_fetch_add(p, v, __ATOMIC_RELAXED, __HIP_MEMORY_SCOPE_AGENT); }
__device__ __forceinline__ unsigned xb_xcc_id() { return (unsigned)__builtin_amdgcn_s_getreg((3 << 11) | 20) & 0xFu; }
#define XB_SPIN(cond, bar) do { unsigned _sp = 0; while (cond) { __builtin_amdgcn_s_sleep(1); \
    if ((++_sp & 255u) == 0u) { if (xb_ld(&(bar)[XB_TMO])) break; if (_sp > XB_SPIN_CAP) { atomicAdd(&(bar)[XB_TMO], 1u); break; } } } } while (0)
struct XcdBarrier { unsigned* bar; unsigned x; volatile LAS unsigned* st; };
__device__ __forceinline__ XcdBarrier xcd_barrier_post(unsigned* bar, volatile LAS unsigned* st) {
    XcdBarrier b; b.bar = bar; b.x = xb_xcc_id(); b.st = st;
    if (threadIdx.x == 0) (void)xb_add(&bar[XB_XCNT(b.x)], 1u);
    return b;
}
__device__ __forceinline__ void xcd_barrier_complete(unsigned* bar, unsigned x, unsigned& nloc, unsigned& nx) {
    const unsigned G = gridDim.x * gridDim.y * gridDim.z;
    unsigned sum, cnt, mine, sp = 0u;
    for (;;) {
        sum = 0u; cnt = 0u; mine = 0u;
#pragma unroll
        for (unsigned j = 0; j < 16; ++j) { const unsigned c = xb_ld(&bar[XB_XCNT(j)]); sum += c; cnt += (c > 0u) ? 1u : 0u; mine = (j == x) ? c : mine; }
        if (sum == G) break;
        __builtin_amdgcn_s_sleep(1);
        if ((++sp & 255u) == 0u) { if (xb_ld(&bar[XB_TMO])) break; if (sp > XB_SPIN_CAP) { atomicAdd(&bar[XB_TMO], 1u); break; } }
    }
    nloc = mine > 0u ? mine : 1u; nx = cnt > 0u ? cnt : 1u;
}
__device__ __forceinline__ void xcd_barrier(const XcdBarrier& b) {
    asm volatile("s_waitcnt vmcnt(0)" ::: "memory");
    __syncthreads();
    if (threadIdx.x == 0) {
        unsigned* bar = b.bar;
        __builtin_amdgcn_s_waitcnt(0);
        unsigned nloc = b.st[0], nx = b.st[1];
        if (nloc == 0u) { xcd_barrier_complete(bar, b.x, nloc, nx); b.st[0] = nloc; b.st[1] = nx; }
        const unsigned old = xb_add(&bar[XB_XSUB(b.x)], 1u);
        const unsigned gen = old / nloc;
        if (old + 1u == (gen + 1u) * nloc) {
            __builtin_amdgcn_fence(__ATOMIC_RELEASE, "agent");
            asm volatile("s_waitcnt vmcnt(0)" ::: "memory");
            const unsigned og = xb_add(&bar[XB_TOP], 1u);
            const unsigned tg = og / nx;
            if (og + 1u == (tg + 1u) * nx) xb_add(&bar[XB_TOPGEN], 1u);
            else XB_SPIN(xb_ld(&bar[XB_TOPGEN]) == tg, bar);
            __builtin_amdgcn_fence(__ATOMIC_ACQUIRE, "agent");
            xb_add(&bar[XB_XGEN(b.x)], 1u);
            asm volatile("s_waitcnt vmcnt(0)" ::: "memory");
        } else {
            XB_SPIN(xb_ld(&bar[XB_XGEN(b.x)]) == gen, bar);
            __builtin_amdgcn_fence(__ATOMIC_ACQUIRE, "agent");
            asm volatile("s_waitcnt vmcnt(0)" ::: "memory");
        }
    }
    __syncthreads();
}

constexpr int MK_THREADS = 512, MK_LDS = 155648, MK_MISC_OFF = 147456, MK_MOE_OFF = 147456 + 256;
struct MkArgs { const float* in[20]; float* out; unsigned char* ws; int ph_lo, ph_hi; };
typedef float f32x4 __attribute__((ext_vector_type(4)));
typedef unsigned u32x4 __attribute__((ext_vector_type(4)));
typedef unsigned u32x2 __attribute__((ext_vector_type(2)));
#define LDS_WAIT() asm volatile("s_waitcnt lgkmcnt(0)" ::: "memory")
__device__ __forceinline__ unsigned pk2(float lo, float hi) { return (unsigned)f2bf(lo) | ((unsigned)f2bf(hi) << 16); }
__device__ __forceinline__ float wave_sum(float v) {
#pragma unroll
    for (int o = 1; o < 64; o <<= 1) v += __shfl_xor(v, o);
    return v;
}

constexpr int TR_SCR = 64 * 68 * 4;
template <class RowMap>
__device__ __forceinline__ void tr_item(const float* __restrict__ W, int K, int N, bf16_t* __restrict__ WT, LAS float* scr, int item, int lane, const float* __restrict__ kscale, RowMap rm) {
    const int nblk = (N + 63) / 64, kb = item / nblk, nb = item % nblk, k0 = 64 * kb, n0 = 64 * nb;
    const int n4 = lane & 15, ks = lane >> 4, nn = n0 + 4 * n4;
    f32x4 v[16];
    if (nn + 3 < N) {
#pragma unroll
        for (int i = 0; i < 16; ++i) v[i] = *(const f32x4*)(W + (size_t)(k0 + 4 * i + ks) * N + nn);
    } else {
#pragma unroll
        for (int i = 0; i < 16; ++i) { const float* p = W + (size_t)(k0 + 4 * i + ks) * N; v[i] = (f32x4){nn < N ? p[nn] : 0.f, nn + 1 < N ? p[nn + 1] : 0.f, nn + 2 < N ? p[nn + 2] : 0.f, 0.f}; }
    }
#pragma unroll
    for (int i = 0; i < 16; ++i) { f32x4 x = v[i]; if (kscale) x = x * kscale[k0 + 4 * i + ks]; *(LAS f32x4*)(scr + (4 * i + ks) * 68 + 4 * n4) = x; }
    LDS_WAIT(); asm volatile("" ::: "memory");
    const int n = n0 + lane;
    float sc = 1.f; int r = 0;
    if (n < N) r = rm(n, sc);
#pragma unroll
    for (int j = 0; j < 8; ++j) {
        const LAS float* s = scr + (8 * j) * 68 + lane;
        u32x4 o; o.x = pk2(s[0 * 68] * sc, s[1 * 68] * sc); o.y = pk2(s[2 * 68] * sc, s[3 * 68] * sc); o.z = pk2(s[4 * 68] * sc, s[5 * 68] * sc); o.w = pk2(s[6 * 68] * sc, s[7 * 68] * sc);
        if (n < N) *(u32x4*)(WT + (size_t)r * K + k0 + 8 * j) = o;
    }
    LDS_WAIT(); asm volatile("" ::: "memory");
}

__device__ __forceinline__ void p0_prep(const MkArgs& a, LAS unsigned char* lds) {
    const int tid = threadIdx.x, lane = tid & 63, wave = __builtin_amdgcn_readfirstlane(tid >> 6);
    const float* c = a.in[1]; const float* w_mod = a.in[2];
    float* MODP = (float*)(a.ws + WS_MODP);
    LAS float* s_c = (LAS float*)lds;
    for (int item = blockIdx.x; item < 256; item += gridDim.x) {
        const int kc = item >> 3, cc = item & 7;
        __syncthreads();
        if (tid < 256) { const int b = tid >> 6, k = tid & 63; s_c[tid] = silu_f(c[b * D + kc * 64 + k]); }
        __syncthreads();
        float acc[4][3];
#pragma unroll
        for (int b = 0; b < 4; ++b)
#pragma unroll
            for (int j = 0; j < 3; ++j) acc[b][j] = 0.f;
        const int col0 = cc * 1536 + tid;
        for (int k0 = 0; k0 < 64; k0 += 16) {
            float w0[16], w1[16], w2[16];
#pragma unroll
            for (int k = 0; k < 16; ++k) { const float* wr = w_mod + (size_t)(kc * 64 + k0 + k) * NMOD + col0; w0[k] = wr[0]; w1[k] = wr[512]; w2[k] = wr[1024]; }
#pragma unroll
            for (int k = 0; k < 16; ++k)
#pragma unroll
                for (int b = 0; b < 4; ++b) { const float sv = s_c[b * 64 + k0 + k]; acc[b][0] += sv * w0[k]; acc[b][1] += sv * w1[k]; acc[b][2] += sv * w2[k]; }
        }
#pragma unroll
        for (int b = 0; b < 4; ++b)
#pragma unroll
            for (int j = 0; j < 3; ++j) MODP[(size_t)(kc * 4 + b) * NMOD + col0 + 512 * j] = acc[b][j];
    }
    __syncthreads();
    LAS float* scr = (LAS float*)(lds + wave * TR_SCR);
    const int gw = blockIdx.x * 8 + wave, NGW = gridDim.x * 8;
    constexpr int I_IN = 32 * 62, I_QUP = 8 * 32, I_OUT = 32 * 32;
    bf16_t* Wt_in = (bf16_t*)(a.ws + WS_WTIN); bf16_t* Wt_qup = (bf16_t*)(a.ws + WS_WTQUP); bf16_t* Wt_out = (bf16_t*)(a.ws + WS_WTOUT);
    for (int it = gw; it < I_IN + I_QUP + I_OUT; it += NGW) {
        int r = it;
        if (r < I_IN) { tr_item(a.in[5], D, DIN, Wt_in, scr, r, lane, (const float*)nullptr, [](int n, float& sc) { if (n >= 832 && n < 848) sc = 0.25f; else if (n >= 848 && n < 1872) sc = 0.08838834764831845f; return n < 848 ? n : n + 176; }); continue; }
        r -= I_IN;
        if (r < I_QUP) { tr_item(a.in[7], 512, 2048, Wt_qup, scr, r, lane, a.in[6], [](int n, float& sc) { if (n >= 1024) sc = 0.125f; return n; }); continue; }
        r -= I_QUP;
        tr_item(a.in[13], D, D, Wt_out, scr, r, lane, (const float*)nullptr, [](int n, float& sc) { return n; });
    }
    {
        bf16_t* Wt_gu = (bf16_t*)(a.ws + WS_WTGU); bf16_t* Wt_dn = (bf16_t*)(a.ws + WS_WTDN);
        for (int it = gw; it < 32 * 768; it += NGW) {
            const int e = it / 768; int r = it % 768;
            if (r < 256) { tr_item(a.in[17] + (size_t)e * D * 512, D, 512, Wt_gu + (size_t)e * 1024 * D, scr, r, lane, (const float*)nullptr, [](int n, float& sc) { return 8 * (n >> 2) + (n & 3); }); continue; }
            r -= 256;
            if (r < 256) { tr_item(a.in[18] + (size_t)e * D * 512, D, 512, Wt_gu + (size_t)e * 1024 * D, scr, r, lane, (const float*)nullptr, [](int n, float& sc) { return 8 * (n >> 2) + 4 + (n & 3); }); continue; }
            r -= 256;
            tr_item(a.in[19] + (size_t)e * 512 * D, 512, D, Wt_dn + (size_t)e * D * 512, scr, r, lane, (const float*)nullptr, [](int n, float& sc) { return n; });
        }
        bf16_t* RT = (bf16_t*)(a.ws + WS_RT); const float* rg = a.in[15]; const float* re = a.in[16];
        for (int i = blockIdx.x * MK_THREADS + tid; i < 48 * D; i += gridDim.x * MK_THREADS) { const int o = i >> 11, k = i & 2047; RT[i] = f2bf(o < 4 ? rg[k * 4 + o] : (o < 36 ? re[k * 32 + (o - 4)] : 0.f)); }
    }
    u32x4* z = (u32x4*)(Wt_in + (size_t)848 * D);
    for (int i = blockIdx.x * MK_THREADS + tid; i < 176 * 256; i += gridDim.x * MK_THREADS) z[i] = (u32x4){0u, 0u, 0u, 0u};
}

__device__ __forceinline__ void p1_xn(const MkArgs& a, LAS unsigned char* lds) {
    const int tid = threadIdx.x, lane = tid & 63, wave = __builtin_amdgcn_readfirstlane(tid >> 6);
    const float* x = a.in[0]; const float* b_mod = a.in[3]; const float* ln1_g = a.in[4];
    const float* MODP = (const float*)(a.ws + WS_MODP); float* MOD = (float*)(a.ws + WS_MOD); bf16_t* XN = (bf16_t*)(a.ws + WS_XN);
    LAS float* s_gs = (LAS float*)lds; LAS float* s_sh = s_gs + D;
    for (int i = blockIdx.x * MK_THREADS + tid; i < NB * NMOD; i += gridDim.x * MK_THREADS) {
        const int b = i / NMOD, n = i % NMOD; float s = b_mod[n];
        for (int kc = 0; kc < 32; ++kc) s += MODP[(size_t)(kc * 4 + b) * NMOD + n];
        MOD[i] = s;
    }
    for (int chunk = blockIdx.x; chunk < M / 64; chunk += gridDim.x) {
        const int b = chunk >> 6;
        __syncthreads();
        for (int k = tid; k < D; k += MK_THREADS) {
            float sh = b_mod[k], sc = b_mod[D + k];
            for (int kc = 0; kc < 32; ++kc) { sh += MODP[(size_t)(kc * 4 + b) * NMOD + k]; sc += MODP[(size_t)(kc * 4 + b) * NMOD + D + k]; }
            s_sh[k] = sh; s_gs[k] = ln1_g[k] * (1.f + sc);
        }
        __syncthreads();
        f32x4 v[8], vn[8];
        { const f32x4* xr = (const f32x4*)(x + (size_t)(chunk * 64 + wave) * D) + lane;
#pragma unroll
          for (int j = 0; j < 8; ++j) v[j] = xr[64 * j]; }
        for (int r = wave; r < 64; r += 8) {
            const int m = chunk * 64 + r;
            if (r + 8 < 64) { const f32x4* xn = (const f32x4*)(x + (size_t)(m + 8) * D) + lane;
#pragma unroll
                for (int j = 0; j < 8; ++j) vn[j] = xn[64 * j]; }
            float ss = 0.f;
#pragma unroll
            for (int j = 0; j < 8; ++j) ss += (v[j].x * v[j].x + v[j].y * v[j].y) + (v[j].z * v[j].z + v[j].w * v[j].w);
            const float rstd = rsqrtf(wave_sum(ss) * (1.f / D) + EPS);
            u32x2* o8 = (u32x2*)(XN + (size_t)m * D) + lane;
#pragma unroll
            for (int j = 0; j < 8; ++j) { const int k = 4 * (lane + 64 * j); const f32x4 gs = *(const LAS f32x4*)(s_gs + k), sh = *(const LAS f32x4*)(s_sh + k);
                const f32x4 y = v[j] * rstd * gs + sh; u32x2 w; w.x = pk2(y.x, y.y); w.y = pk2(y.z, y.w); o8[64 * j] = w; }
#pragma unroll
            for (int j = 0; j < 8; ++j) v[j] = vn[j];
        }
    }
}

struct EpiInProj {
    static constexpr bool PERM = true;
    bf16_t* B0; bf16_t* QB; bf16_t* KB; bf16_t* VB; float* SSQ;
    __device__ __forceinline__ void operator()(const pg8::f32x4 (&acc)[2][2][4][2], const pg8::Unit& u, int wr, int wc, int fr, int fq) const {
        if (u.dup) return;
        const int t = u.pn >> 2; bf16_t* base = t == 0 ? B0 : (t == 1 ? QB : (t == 2 ? KB : VB));
        const int row0 = u.pm * 256 + wr * 64 + fr, col0 = (u.pn & 3) * 256 + wc * 32 + 8 * fq;
#pragma unroll
        for (int ai = 0; ai < 2; ++ai)
#pragma unroll
            for (int m = 0; m < 4; ++m) { const int row = row0 + ai * 128 + m * 16; bf16_t* rowp = base + (size_t)row * 1024 + col0; float ss = 0.f;
#pragma unroll
                for (int bj = 0; bj < 2; ++bj) { const pg8::f32x4 v0 = acc[ai][bj][m][0], v1 = acc[ai][bj][m][1];
                    ss += (v0[0] * v0[0] + v0[1] * v0[1]) + (v0[2] * v0[2] + v0[3] * v0[3]) + (v1[0] * v1[0] + v1[1] * v1[1]) + (v1[2] * v1[2] + v1[3] * v1[3]);
                    pg8::u32x4 w; w.x = pg8::cvt_pk_bf16(v0[0], v0[1]); w.y = pg8::cvt_pk_bf16(v0[2], v0[3]); w.z = pg8::cvt_pk_bf16(v1[0], v1[1]); w.w = pg8::cvt_pk_bf16(v1[2], v1[3]);
                    *(pg8::u32x4*)(rowp + bj * 128) = w; }
                if (u.pn < 2) { ss += __shfl_xor(ss, 16); ss += __shfl_xor(ss, 32); if (fq == 0) SSQ[(size_t)row * 8 + u.pn * 4 + wc] = ss; } }
    }
};


struct EpiQupG {
    static constexpr bool PERM = true;
    const float* SSQ; bf16_t* QA; bf16_t* QI;
    __device__ __forceinline__ void operator()(const pg8::f32x4 (&acc)[2][2][4][2], const pg8::Unit& u, int wr, int wc, int fr, int fq) const {
        if (u.dup) return;
        bf16_t* base = (u.pn >> 2) ? QI : QA;
        const int row0 = u.pm * 256 + wr * 64 + fr, col0 = (u.pn & 3) * 256 + wc * 32 + 8 * fq;
#pragma unroll
        for (int ai = 0; ai < 2; ++ai)
#pragma unroll
            for (int m = 0; m < 4; ++m) { const int row = row0 + ai * 128 + m * 16; bf16_t* rowp = base + (size_t)row * 1024 + col0;
                const pg8::f32x4 s0 = *(const pg8::f32x4*)(SSQ + (size_t)row * 8), s1 = *(const pg8::f32x4*)(SSQ + (size_t)row * 8 + 4);
                const float rs = rsqrtf(((s0[0] + s0[1]) + (s0[2] + s0[3]) + (s1[0] + s1[1]) + (s1[2] + s1[3])) * (1.f / 512.f) + EPS);
#pragma unroll
                for (int bj = 0; bj < 2; ++bj) { const pg8::f32x4 v0 = acc[ai][bj][m][0] * rs, v1 = acc[ai][bj][m][1] * rs;
                    pg8::u32x4 w; w.x = pg8::cvt_pk_bf16(v0[0], v0[1]); w.y = pg8::cvt_pk_bf16(v0[2], v0[3]); w.z = pg8::cvt_pk_bf16(v1[0], v1[1]); w.w = pg8::cvt_pk_bf16(v1[2], v1[3]);
                    *(pg8::u32x4*)(rowp + bj * 128) = w; } }
    }
};
struct EpiOutProj {
    static constexpr bool PERM = true;
    const float* x; const float* MOD; bf16_t* X1B;
    __device__ __forceinline__ void operator()(const pg8::f32x4 (&acc)[2][2][4][2], const pg8::Unit& u, int wr, int wc, int fr, int fq) const {
        if (u.dup) return;
        const int b = (u.pm * 256) >> 12;
        const int row0 = u.pm * 256 + wr * 64 + fr, col0 = u.pn * 256 + wc * 32 + 8 * fq;
        const float* gp = MOD + (size_t)b * NMOD + 2 * D + col0;
        pg8::f32x4 g[2][2];
#pragma unroll
        for (int bj = 0; bj < 2; ++bj) { g[bj][0] = *(const pg8::f32x4*)(gp + bj * 128); g[bj][1] = *(const pg8::f32x4*)(gp + bj * 128 + 4); }
#pragma unroll
        for (int ai = 0; ai < 2; ++ai)
#pragma unroll
            for (int m = 0; m < 4; ++m) { const size_t off = (size_t)(row0 + ai * 128 + m * 16) * D + col0;
#pragma unroll
                for (int bj = 0; bj < 2; ++bj) { const pg8::f32x4 x0 = *(const pg8::f32x4*)(x + off + bj * 128), x1 = *(const pg8::f32x4*)(x + off + bj * 128 + 4);
                    const pg8::f32x4 o0 = x0 + g[bj][0] * acc[ai][bj][m][0], o1 = x1 + g[bj][1] * acc[ai][bj][m][1];
                    pg8::u32x4 w; w.x = pg8::cvt_pk_bf16(o0[0], o0[1]); w.y = pg8::cvt_pk_bf16(o0[2], o0[3]); w.z = pg8::cvt_pk_bf16(o1[0], o1[1]); w.w = pg8::cvt_pk_bf16(o1[2], o1[3]);
                    *(pg8::u32x4*)(X1B + off + bj * 128) = w; } }
    }
};
__device__ __forceinline__ void kanorm_pass(const MkArgs& a) {
    const int tid = threadIdx.x, lane = tid & 63, wave = __builtin_amdgcn_readfirstlane(tid >> 6);
    bf16_t* B0 = (bf16_t*)(a.ws + WS_B0); const float* k_gain = a.in[9];
    const float g0 = k_gain[2 * lane], g1 = k_gain[2 * lane + 1];
    for (int m = blockIdx.x * 8 + wave; m < M; m += gridDim.x * 8) {
        unsigned* p = (unsigned*)(B0 + (size_t)m * 1024 + 512) + lane;
        const unsigned v = *p; const float k0 = __uint_as_float(v << 16), k1 = __uint_as_float(v & 0xffff0000u);
        const float rs = rsqrtf(wave_sum(k0 * k0 + k1 * k1) * (1.f / 128.f) + EPS);
        *p = pk2(k0 * rs * g0, k1 * rs * g1);
    }
}

typedef short bf16x8_t __attribute__((ext_vector_type(8)));
__device__ __forceinline__ void p8_route(const MkArgs& a, LAS unsigned char* lds) {
    const int tid = threadIdx.x, lane = tid & 63, wave = __builtin_amdgcn_readfirstlane(tid >> 6);
    const bf16_t* X1B = (const bf16_t*)(a.ws + WS_X1B); const float* ln2_g = a.in[14]; const float* MOD = (const float*)(a.ws + WS_MOD);
    bf16_t* H2 = (bf16_t*)(a.ws + WS_XN); const bf16_t* RT = (const bf16_t*)(a.ws + WS_RT);
    int* EID = (int*)(a.ws + WS_EID); float* GW = (float*)(a.ws + WS_GW);
    unsigned* cnt = (unsigned*)(a.ws + WS_CTL) + CW_CNT; int* list = (int*)(a.ws + WS_LIST);
    constexpr int RS = 4112;
    LAS float* s_part = (LAS float*)lds;
    LAS float* s_lg = (LAS float*)(lds + 49152);
    for (int item = blockIdx.x; item < M / 32; item += gridDim.x) {
        const int m0 = item * 32, b = m0 >> 12;
        const float* mb = MOD + (size_t)b * NMOD;
        __syncthreads();
        u32x2 xb[4][8];
#pragma unroll
        for (int rr = 0; rr < 4; ++rr) { const u32x2* xr = (const u32x2*)(X1B + (size_t)(m0 + wave * 4 + rr) * D) + lane;
#pragma unroll
            for (int j = 0; j < 8; ++j) xb[rr][j] = xr[64 * j]; }
#pragma unroll
        for (int rr = 0; rr < 4; ++rr) {
            const int r = wave * 4 + rr, m = m0 + r;
            f32x4 v[8]; float ss = 0.f;
#pragma unroll
            for (int j = 0; j < 8; ++j) { v[j] = (f32x4){__uint_as_float(xb[rr][j].x << 16), __uint_as_float(xb[rr][j].x & 0xffff0000u), __uint_as_float(xb[rr][j].y << 16), __uint_as_float(xb[rr][j].y & 0xffff0000u)};
                ss += (v[j].x * v[j].x + v[j].y * v[j].y) + (v[j].z * v[j].z + v[j].w * v[j].w); }
            const float rstd = rsqrtf(wave_sum(ss) * (1.f / D) + EPS);
            u32x2* o8 = (u32x2*)(H2 + (size_t)m * D) + lane;
#pragma unroll
            for (int j = 0; j < 8; ++j) { const int k = 4 * (lane + 64 * j);
                const f32x4 g = *(const f32x4*)(ln2_g + k), sc = *(const f32x4*)(mb + 4 * D + k), sh = *(const f32x4*)(mb + 3 * D + k);
                const f32x4 y = v[j] * rstd * g * (sc + 1.f) + sh; u32x2 w; w.x = pk2(y.x, y.y); w.y = pk2(y.z, y.w); o8[64 * j] = w;
                *(LAS u32x2*)(lds + r * RS + k * 2) = w; }
        }
        __syncthreads();
        f32x4 acc[2][3];
#pragma unroll
        for (int rt = 0; rt < 2; ++rt)
#pragma unroll
            for (int ct = 0; ct < 3; ++ct) acc[rt][ct] = (f32x4){0.f, 0.f, 0.f, 0.f};
        const int fr = lane & 15, fq = lane >> 4;
#pragma unroll 2
        for (int kk = 0; kk < 8; ++kk) {
            const int k0 = 32 * (wave * 8 + kk) + 8 * fq;
            bf16x8_t af[2], bfr[3];
#pragma unroll
            for (int rt = 0; rt < 2; ++rt) af[rt] = *(const LAS bf16x8_t*)(lds + (16 * rt + fr) * RS + k0 * 2);
#pragma unroll
            for (int ct = 0; ct < 3; ++ct) bfr[ct] = *(const bf16x8_t*)(RT + (size_t)(16 * ct + fr) * D + k0);
#pragma unroll
            for (int rt = 0; rt < 2; ++rt)
#pragma unroll
                for (int ct = 0; ct < 3; ++ct) acc[rt][ct] = __builtin_amdgcn_mfma_f32_16x16x32_bf16(af[rt], bfr[ct], acc[rt][ct], 0, 0, 0);
        }
        __syncthreads();
#pragma unroll
        for (int rt = 0; rt < 2; ++rt)
#pragma unroll
            for (int ct = 0; ct < 3; ++ct)
#pragma unroll
                for (int i = 0; i < 4; ++i) s_part[(wave * 32 + 16 * rt + 4 * fq + i) * 48 + 16 * ct + fr] = acc[rt][ct][i];
        __syncthreads();
        for (int i = tid; i < 32 * 36; i += MK_THREADS) { const int r = i / 36, o = i % 36; float s = 0.f;
#pragma unroll
            for (int w = 0; w < 8; ++w) s += s_part[(w * 32 + r) * 48 + o];
            s_lg[i] = s; }
        __syncthreads();
        if (tid < 32) {
            const LAS float* lg = s_lg + tid * 36; const int m = m0 + tid;
            int gi = 0; float gm = lg[0];
            for (int i = 1; i < 4; ++i) if (lg[i] > gm) { gm = lg[i]; gi = i; }
            float gs = 0.f;
            for (int i = 0; i < 4; ++i) gs += __expf(lg[i] - gm);
            const float gw = 1.f / gs;
            const LAS float* le = lg + 4 + gi * 8;
            float em = le[0];
            for (int i = 1; i < 8; ++i) em = fmaxf(em, le[i]);
            float es = 0.f;
            for (int i = 0; i < 8; ++i) es += __expf(le[i] - em);
            int i0 = 0; float p0 = -1.f;
            for (int i = 0; i < 8; ++i) { const float p = __expf(le[i] - em) / es; if (p > p0) { p0 = p; i0 = i; } }
            int i1 = 0; float p1 = -1.f;
            for (int i = 0; i < 8; ++i) { const float p = __expf(le[i] - em) / es; if (i != i0 && p > p1) { p1 = p; i1 = i; } }
            const float den = p0 + p1;
            const int e0 = gi * 8 + i0, e1 = gi * 8 + i1;
            GW[m * 2] = gw * p0 / den; GW[m * 2 + 1] = gw * p1 / den;
            const unsigned q0 = __hip_atomic_fetch_add(cnt + e0, 1u, __ATOMIC_RELAXED, __HIP_MEMORY_SCOPE_AGENT);
            const unsigned q1 = __hip_atomic_fetch_add(cnt + 32 + e1, 1u, __ATOMIC_RELAXED, __HIP_MEMORY_SCOPE_AGENT);
            EID[m * 2] = (e0 << 16) | (int)q0; EID[m * 2 + 1] = (e1 << 16) | (int)q1;
            list[(size_t)e0 * 16384 + q0] = m; list[(size_t)(32 + e1) * 16384 + q1] = m;
        }
    }
}

__device__ __forceinline__ int rfl(int v) { return __builtin_amdgcn_readfirstlane(v); }
struct MoeTab { LAS int* tsm; LAS int* c0; LAS int* c1; LAS int* ts0; LAS int* ts1; };
__device__ __forceinline__ MoeTab moe_tab_build(const MkArgs& a, LAS unsigned char* lds) {
    MoeTab t; LAS int* p = (LAS int*)(lds + MK_MOE_OFF); t.tsm = p; t.c0 = p + 40; t.c1 = p + 80; t.ts0 = p + 120; t.ts1 = p + 160;
    const unsigned* cnt = (const unsigned*)(a.ws + WS_CTL) + CW_CNT;
    __syncthreads();
    if (threadIdx.x == 0) {
        int am = 0, a0 = 0, a1 = 0;
        for (int e = 0; e < 32; ++e) { const int n0 = (int)__hip_atomic_load(cnt + e, __ATOMIC_RELAXED, __HIP_MEMORY_SCOPE_AGENT), n1 = (int)__hip_atomic_load(cnt + 32 + e, __ATOMIC_RELAXED, __HIP_MEMORY_SCOPE_AGENT);
            t.c0[e] = n0; t.c1[e] = n1; t.tsm[e] = am; t.ts0[e] = a0; t.ts1[e] = a1; am += (n0 + n1 + 255) >> 8; a0 += (n0 + 255) >> 8; a1 += (n1 + 255) >> 8; }
        t.tsm[32] = am; t.ts0[32] = a0; t.ts1[32] = a1;
    }
    __syncthreads();
    return t;
}
struct SchedGU {
    MoeTab t; const int* list; const char* H2; const char* Wt; int G, c, nunit, ndup; int R[2], C[2];
    __device__ void init(const MoeTab& t_, const MkArgs& a, int G_, int c_, int ndup_ = 1) { ndup = ndup_; t = t_; list = (const int*)(a.ws + WS_LIST); H2 = (const char*)(a.ws + WS_XN); Wt = (const char*)(a.ws + WS_WTGU); G = G_; c = c_; nunit = rfl(t.tsm[32]) * 4;
#pragma unroll
        for (int i = 0; i < 2; ++i) pg8::stage_rc((int)threadIdx.x * 16 + i * 8192, R[i], C[i]); }
    __device__ bool next(int i, pg8::Unit& u) const {
        const int L0 = i * G + c; if (L0 >= nunit * ndup) return false;
        const int L = L0 % nunit; u.dup = L0 / nunit;
        const int mt = L >> 2, pn = L & 3; int e = 0;
        for (int j = 1; j < 32; ++j) e += (mt >= t.tsm[j]) ? 1 : 0;
        e = rfl(e);
        u.pm = mt; u.pn = pn; u.aux = e; u.a = H2; u.b = Wt + ((size_t)(e * 1024 + pn * 256) * D) * 2;
        const int n0 = rfl(t.c0[e]), n1 = rfl(t.c1[e]), rb = (mt - rfl(t.tsm[e])) * 256;
#pragma unroll
        for (int h = 0; h < 2; ++h)
#pragma unroll
            for (int j = 0; j < 2; ++j) { const int r = rb + h * 128 + R[j]; int tok = 0;
                if (r < n0) tok = list[(size_t)e * 16384 + r]; else if (r - n0 < n1) tok = list[(size_t)(32 + e) * 16384 + (r - n0)];
                u.va[h][j] = (unsigned)(tok * D + C[j]) * 2u; }
        return true;
    }
};
struct EpiGU {
    static constexpr bool PERM = true;
    bf16_t* U;
    __device__ __forceinline__ void operator()(const pg8::f32x4 (&acc)[2][2][4][2], const pg8::Unit& u, int wr, int wc, int fr, int fq) const {
        if (u.dup) return;
        const int row0 = u.pm * 256 + wr * 64 + fr, j0 = u.pn * 128 + wc * 16 + 4 * fq;
#pragma unroll
        for (int ai = 0; ai < 2; ++ai)
#pragma unroll
            for (int m = 0; m < 4; ++m) { bf16_t* rowp = U + (size_t)(row0 + ai * 128 + m * 16) * 512 + j0;
#pragma unroll
                for (int bj = 0; bj < 2; ++bj) { const pg8::f32x4 gv = acc[ai][bj][m][0], uv = acc[ai][bj][m][1]; float o[4];
#pragma unroll
                    for (int i = 0; i < 4; ++i) o[i] = gv[i] / (1.f + __expf(-gv[i])) * uv[i];
                    u32x2 w; w.x = pg8::cvt_pk_bf16(o[0], o[1]); w.y = pg8::cvt_pk_bf16(o[2], o[3]); *(u32x2*)(rowp + bj * 64) = w; } }
    }
};
struct SchedDN {
    MoeTab t; const char* U; const char* Wt; int G, c, nunit, ndup; unsigned vb[2][2];
    __device__ void init(const MoeTab& t_, const MkArgs& a, int G_, int c_, int ndup_ = 1) { ndup = ndup_; t = t_; U = (const char*)(a.ws + WS_U); Wt = (const char*)(a.ws + WS_WTDN); G = G_; c = c_; nunit = rfl(t.tsm[32]) * 8;
#pragma unroll
        for (int i = 0; i < 2; ++i) { int R, C; pg8::stage_rc((int)threadIdx.x * 16 + i * 8192, R, C); vb[0][i] = (unsigned)(R * 512 + C) * 2u; vb[1][i] = (unsigned)((128 + R) * 512 + C) * 2u; } }
    __device__ bool next(int i, pg8::Unit& u) const {
        const int L0 = i * G + c; if (L0 >= nunit * ndup) return false;
        const int L = L0 % nunit; u.dup = L0 / nunit;
        const int mt = L >> 3, pn = L & 7; int e = 0;
        for (int j = 1; j < 32; ++j) e += (mt >= t.tsm[j]) ? 1 : 0;
        e = rfl(e);
        u.pm = mt; u.pn = pn; u.aux = e;
        u.a = U + ((size_t)mt * 256 * 512) * 2; u.b = Wt + ((size_t)(e * D + pn * 256) * 512) * 2;
        u.va[0][0] = vb[0][0]; u.va[0][1] = vb[0][1]; u.va[1][0] = vb[1][0]; u.va[1][1] = vb[1][1];
        return true;
    }
};
struct EpiY {
    static constexpr bool PERM = true;
    bf16_t* Y;
    __device__ __forceinline__ void operator()(const pg8::f32x4 (&acc)[2][2][4][2], const pg8::Unit& u, int wr, int wc, int fr, int fq) const {
        if (u.dup) return;
        const int row0 = u.pm * 256 + wr * 64 + fr, col0 = u.pn * 256 + wc * 32 + 8 * fq;
#pragma unroll
        for (int ai = 0; ai < 2; ++ai)
#pragma unroll
            for (int m = 0; m < 4; ++m) { bf16_t* rowp = Y + (size_t)(row0 + ai * 128 + m * 16) * D + col0;
#pragma unroll
                for (int bj = 0; bj < 2; ++bj) { const pg8::f32x4 v0 = acc[ai][bj][m][0], v1 = acc[ai][bj][m][1];
                    pg8::u32x4 w; w.x = pg8::cvt_pk_bf16(v0[0], v0[1]); w.y = pg8::cvt_pk_bf16(v0[2], v0[3]); w.z = pg8::cvt_pk_bf16(v1[0], v1[1]); w.w = pg8::cvt_pk_bf16(v1[2], v1[3]);
                    *(pg8::u32x4*)(rowp + bj * 128) = w; } }
    }
};
__device__ __forceinline__ void p11_combine(const MkArgs& a, const MoeTab& t) {
    const int tid = threadIdx.x, lane = tid & 63, wave = __builtin_amdgcn_readfirstlane(tid >> 6);
    const bf16_t* Y = (const bf16_t*)(a.ws + WS_Y); const bf16_t* X1B = (const bf16_t*)(a.ws + WS_X1B); const int* POSL = (const int*)(a.ws + WS_EID); const float* GW = (const float*)(a.ws + WS_GW); const float* MOD = (const float*)(a.ws + WS_MOD);
    for (int m = blockIdx.x * 8 + wave; m < M; m += gridDim.x * 8) {
        const int p0 = rfl(POSL[m * 2]), p1 = rfl(POSL[m * 2 + 1]);
        const int e0 = p0 >> 16, e1 = p1 >> 16;
        const size_t r0 = (size_t)rfl(t.tsm[e0]) * 256 + (p0 & 0xffff), r1 = (size_t)rfl(t.tsm[e1]) * 256 + rfl(t.c0[e1]) + (p1 & 0xffff);
        const float w0 = GW[m * 2], w1 = GW[m * 2 + 1];
        const float* gp = MOD + (size_t)(m >> 12) * NMOD + 5 * D;
        float* op = a.out + (size_t)m * D;
        u32x4 y0[4], y1[4], xb[4];
#pragma unroll
        for (int j = 0; j < 4; ++j) { const int c = 8 * (lane + 64 * j); y0[j] = *(const u32x4*)(Y + r0 * D + c); y1[j] = *(const u32x4*)(Y + r1 * D + c); xb[j] = *(const u32x4*)(X1B + (size_t)m * D + c); }
#pragma unroll
        for (int j = 0; j < 4; ++j) { const int c = 8 * (lane + 64 * j);
            const f32x4 g0 = *(const f32x4*)(gp + c), g1 = *(const f32x4*)(gp + c + 4);
            f32x4 s0, s1;
#pragma unroll
            for (int q = 0; q < 2; ++q) { s0[2 * q] = w0 * __uint_as_float(y0[j][q] << 16) + w1 * __uint_as_float(y1[j][q] << 16); s0[2 * q + 1] = w0 * __uint_as_float(y0[j][q] & 0xffff0000u) + w1 * __uint_as_float(y1[j][q] & 0xffff0000u);
                s1[2 * q] = w0 * __uint_as_float(y0[j][2 + q] << 16) + w1 * __uint_as_float(y1[j][2 + q] << 16); s1[2 * q + 1] = w0 * __uint_as_float(y0[j][2 + q] & 0xffff0000u) + w1 * __uint_as_float(y1[j][2 + q] & 0xffff0000u); }
            const f32x4 x0 = (f32x4){__uint_as_float(xb[j][0] << 16), __uint_as_float(xb[j][0] & 0xffff0000u), __uint_as_float(xb[j][1] << 16), __uint_as_float(xb[j][1] & 0xffff0000u)};
            const f32x4 x1 = (f32x4){__uint_as_float(xb[j][2] << 16), __uint_as_float(xb[j][2] & 0xffff0000u), __uint_as_float(xb[j][3] << 16), __uint_as_float(xb[j][3] & 0xffff0000u)};
            *(f32x4*)(op + c) = x0 + g0 * s0; *(f32x4*)(op + c + 4) = x1 + g1 * s1; }
    }
}
typedef float f32x16 __attribute__((ext_vector_type(16)));
typedef short s16x4 __attribute__((ext_vector_type(4)));
__device__ __forceinline__ s16x4 tr_read(unsigned lds_addr) { s16x4 r; asm volatile("ds_read_b64_tr_b16 %0, %1\n\ts_waitcnt lgkmcnt(0)" : "=&v"(r) : "v"(lds_addr) : "memory"); return r; }
__device__ __forceinline__ unsigned off_b(unsigned row, unsigned ch) { return 256u * row + 16u * (ch ^ (((row & 3) << 2) | ((row >> 2) & 3))); }
__device__ __forceinline__ int crow(int reg, int h) { return (reg & 3) + 8 * (reg >> 2) + 4 * h; }
constexpr float SB_STOP = -104.0f;

constexpr int VT_STRIDE = 272;
__device__ __forceinline__ void tr8_sb0(unsigned addr, s16x4 (&r)[8]) {
    asm volatile(
        "ds_read_b64_tr_b16 %0, %8 offset:0\n\t"
        "ds_read_b64_tr_b16 %1, %8 offset:2176\n\t"
        "ds_read_b64_tr_b16 %2, %8 offset:4352\n\t"
        "ds_read_b64_tr_b16 %3, %8 offset:6528\n\t"
        "ds_read_b64_tr_b16 %4, %8 offset:64\n\t"
        "ds_read_b64_tr_b16 %5, %8 offset:2240\n\t"
        "ds_read_b64_tr_b16 %6, %8 offset:4416\n\t"
        "ds_read_b64_tr_b16 %7, %8 offset:6592\n\t"
        "s_waitcnt lgkmcnt(0)"
        : "=&v"(r[0]), "=&v"(r[1]), "=&v"(r[2]), "=&v"(r[3]), "=&v"(r[4]), "=&v"(r[5]), "=&v"(r[6]), "=&v"(r[7])
        : "v"(addr) : "memory");
}
__device__ __forceinline__ void tr8_sb1(unsigned addr, s16x4 (&r)[8]) {
    asm volatile(
        "ds_read_b64_tr_b16 %0, %8 offset:128\n\t"
        "ds_read_b64_tr_b16 %1, %8 offset:2304\n\t"
        "ds_read_b64_tr_b16 %2, %8 offset:4480\n\t"
        "ds_read_b64_tr_b16 %3, %8 offset:6656\n\t"
        "ds_read_b64_tr_b16 %4, %8 offset:192\n\t"
        "ds_read_b64_tr_b16 %5, %8 offset:2368\n\t"
        "ds_read_b64_tr_b16 %6, %8 offset:4544\n\t"
        "ds_read_b64_tr_b16 %7, %8 offset:6720\n\t"
        "s_waitcnt lgkmcnt(0)"
        : "=&v"(r[0]), "=&v"(r[1]), "=&v"(r[2]), "=&v"(r[3]), "=&v"(r[4]), "=&v"(r[5]), "=&v"(r[6]), "=&v"(r[7])
        : "v"(addr) : "memory");
}
__device__ __forceinline__ void tr8_dsa0(unsigned addr, s16x4 (&r)[8]) {
    asm volatile(
        "ds_read_b64_tr_b16 %0, %8 offset:0\n\t"
        "ds_read_b64_tr_b16 %1, %8 offset:4352\n\t"
        "ds_read_b64_tr_b16 %2, %8 offset:32\n\t"
        "ds_read_b64_tr_b16 %3, %8 offset:4384\n\t"
        "ds_read_b64_tr_b16 %4, %8 offset:64\n\t"
        "ds_read_b64_tr_b16 %5, %8 offset:4416\n\t"
        "ds_read_b64_tr_b16 %6, %8 offset:96\n\t"
        "ds_read_b64_tr_b16 %7, %8 offset:4448\n\t"
        "s_waitcnt lgkmcnt(0)"
        : "=&v"(r[0]), "=&v"(r[1]), "=&v"(r[2]), "=&v"(r[3]), "=&v"(r[4]), "=&v"(r[5]), "=&v"(r[6]), "=&v"(r[7])
        : "v"(addr) : "memory");
}
__device__ __forceinline__ void tr8_dsa1(unsigned addr, s16x4 (&r)[8]) {
    asm volatile(
        "ds_read_b64_tr_b16 %0, %8 offset:128\n\t"
        "ds_read_b64_tr_b16 %1, %8 offset:4480\n\t"
        "ds_read_b64_tr_b16 %2, %8 offset:160\n\t"
        "ds_read_b64_tr_b16 %3, %8 offset:4512\n\t"
        "ds_read_b64_tr_b16 %4, %8 offset:192\n\t"
        "ds_read_b64_tr_b16 %5, %8 offset:4544\n\t"
        "ds_read_b64_tr_b16 %6, %8 offset:224\n\t"
        "ds_read_b64_tr_b16 %7, %8 offset:4576\n\t"
        "s_waitcnt lgkmcnt(0)"
        : "=&v"(r[0]), "=&v"(r[1]), "=&v"(r[2]), "=&v"(r[3]), "=&v"(r[4]), "=&v"(r[5]), "=&v"(r[6]), "=&v"(r[7])
        : "v"(addr) : "memory");
}
__device__ __forceinline__ void tr16_sb(unsigned addr, s16x4 (&r)[16]) {
    asm volatile(
        "ds_read_b64_tr_b16 %0, %16 offset:0\n\t"
        "ds_read_b64_tr_b16 %1, %16 offset:2176\n\t"
        "ds_read_b64_tr_b16 %2, %16 offset:4352\n\t"
        "ds_read_b64_tr_b16 %3, %16 offset:6528\n\t"
        "ds_read_b64_tr_b16 %4, %16 offset:64\n\t"
        "ds_read_b64_tr_b16 %5, %16 offset:2240\n\t"
        "ds_read_b64_tr_b16 %6, %16 offset:4416\n\t"
        "ds_read_b64_tr_b16 %7, %16 offset:6592\n\t"
        "ds_read_b64_tr_b16 %8, %16 offset:128\n\t"
        "ds_read_b64_tr_b16 %9, %16 offset:2304\n\t"
        "ds_read_b64_tr_b16 %10, %16 offset:4480\n\t"
        "ds_read_b64_tr_b16 %11, %16 offset:6656\n\t"
        "ds_read_b64_tr_b16 %12, %16 offset:192\n\t"
        "ds_read_b64_tr_b16 %13, %16 offset:2368\n\t"
        "ds_read_b64_tr_b16 %14, %16 offset:4544\n\t"
        "ds_read_b64_tr_b16 %15, %16 offset:6720\n\t"
        "s_waitcnt lgkmcnt(0)"
        : "=&v"(r[0]), "=&v"(r[1]), "=&v"(r[2]), "=&v"(r[3]), "=&v"(r[4]), "=&v"(r[5]), "=&v"(r[6]), "=&v"(r[7]), "=&v"(r[8]), "=&v"(r[9]), "=&v"(r[10]), "=&v"(r[11]), "=&v"(r[12]), "=&v"(r[13]), "=&v"(r[14]), "=&v"(r[15])
        : "v"(addr) : "memory");
}
__device__ __forceinline__ void tr16_dsa(unsigned addr, s16x4 (&r)[16]) {
    asm volatile(
        "ds_read_b64_tr_b16 %0, %16 offset:0\n\t"
        "ds_read_b64_tr_b16 %1, %16 offset:4352\n\t"
        "ds_read_b64_tr_b16 %2, %16 offset:32\n\t"
        "ds_read_b64_tr_b16 %3, %16 offset:4384\n\t"
        "ds_read_b64_tr_b16 %4, %16 offset:64\n\t"
        "ds_read_b64_tr_b16 %5, %16 offset:4416\n\t"
        "ds_read_b64_tr_b16 %6, %16 offset:96\n\t"
        "ds_read_b64_tr_b16 %7, %16 offset:4448\n\t"
        "ds_read_b64_tr_b16 %8, %16 offset:128\n\t"
        "ds_read_b64_tr_b16 %9, %16 offset:4480\n\t"
        "ds_read_b64_tr_b16 %10, %16 offset:160\n\t"
        "ds_read_b64_tr_b16 %11, %16 offset:4512\n\t"
        "ds_read_b64_tr_b16 %12, %16 offset:192\n\t"
        "ds_read_b64_tr_b16 %13, %16 offset:4544\n\t"
        "ds_read_b64_tr_b16 %14, %16 offset:224\n\t"
        "ds_read_b64_tr_b16 %15, %16 offset:4576\n\t"
        "s_waitcnt lgkmcnt(0)"
        : "=&v"(r[0]), "=&v"(r[1]), "=&v"(r[2]), "=&v"(r[3]), "=&v"(r[4]), "=&v"(r[5]), "=&v"(r[6]), "=&v"(r[7]), "=&v"(r[8]), "=&v"(r[9]), "=&v"(r[10]), "=&v"(r[11]), "=&v"(r[12]), "=&v"(r[13]), "=&v"(r[14]), "=&v"(r[15])
        : "v"(addr) : "memory");
}
__device__ __forceinline__ void sb_wave(const bf16_t* __restrict__ QB, const bf16_t* __restrict__ KB, const bf16_t* __restrict__ VB, int b, int h, int q0, LAS unsigned char* vt, f32x16 (&o)[4]) {
    int lane = threadIdx.x & 63; asm volatile("" : "+v"(lane));
    const int r32 = lane & 31, hi = lane >> 5;
    bf16x8_t bq[8];
    { const bf16_t* qp = QB + (size_t)(b * S + q0 + r32) * 1024 + h * 128 + 64 * hi;
#pragma unroll
      for (int s = 0; s < 8; ++s) bq[s] = *(const bf16x8_t*)(qp + 8 * s); }
#pragma unroll
    for (int c = 0; c < 4; ++c)
#pragma unroll
        for (int i = 0; i < 16; ++i) o[c][i] = 0.f;
    float carry = 0.f;
    const int q16 = lane & 15, tq = q16 >> 2, tp = q16 & 3, blk = (lane >> 4) & 1;
    const unsigned traddr = (unsigned)(uintptr_t)vt + VT_STRIDE * (4 * hi + tq) + 32 * blk + 16 * (tp >> 1) + 8 * (tp & 1);
    const bf16_t* kbase = KB + (size_t)b * S * 1024 + h * 128 + 64 * hi + (size_t)r32 * 1024;
    const bf16_t* vbase = VB + (size_t)b * S * 1024 + h * 128 + (size_t)(lane >> 4) * 1024 + 8 * (lane & 15);
    bf16x8_t kf[8]; u32x4 vr[8];
    { const int kt = q0 >> 5;
#pragma unroll
      for (int s = 0; s < 8; ++s) kf[s] = *(const bf16x8_t*)(kbase + (size_t)kt * 32 * 1024 + 8 * s);
#pragma unroll
      for (int i = 0; i < 8; ++i) vr[i] = *(const u32x4*)(vbase + (size_t)(kt * 32 + 4 * i) * 1024); }
    for (int kt = q0 >> 5; kt >= 0; --kt) {
        const int k0 = kt * 32;
#pragma unroll
        for (int i = 0; i < 8; ++i) *(LAS u32x4*)(vt + (4 * i + (lane >> 4)) * VT_STRIDE + 16 * (lane & 15)) = vr[i];
        f32x16 z;
#pragma unroll
        for (int i = 0; i < 16; ++i) z[i] = 0.f;
#pragma unroll
        for (int s = 0; s < 8; ++s) z = __builtin_amdgcn_mfma_f32_32x32x16_bf16(kf[s], bq[s], z, 0, 0, 0);
        { const int kn = kt > 0 ? kt - 1 : 0;
#pragma unroll
          for (int s = 0; s < 8; ++s) kf[s] = *(const bf16x8_t*)(kbase + (size_t)kn * 32 * 1024 + 8 * s);
#pragma unroll
          for (int i = 0; i < 8; ++i) vr[i] = *(const u32x4*)(vbase + (size_t)(kn * 32 + 4 * i) * 1024); }
        const bool diag = (k0 == q0);
        float lm[16], sg[4];
#pragma unroll
        for (int g = 0; g < 4; ++g) sg[g] = 0.f;
#pragma unroll
        for (int i = 0; i < 16; ++i) { const float zz = z[i]; const float sp = fmaxf(zz, 0.f) + __logf(1.f + __expf(-fabsf(zz)));
            const bool valid = !diag || (crow(i, hi) < r32);
            lm[i] = valid ? -sp : 0.f; z[i] = valid ? (zz - sp) : -INFINITY; sg[i >> 2] += lm[i]; }
        float psg[4];
#pragma unroll
        for (int g = 0; g < 4; ++g) psg[g] = __shfl_xor(sg[g], 32);
        float aft[4];
        { float run = carry;
#pragma unroll
          for (int g = 3; g >= 0; --g) { if (hi == 0) { run += psg[g]; aft[g] = run; run += sg[g]; } else { aft[g] = run; run += sg[g]; run += psg[g]; } }
          carry = run; }
        float av[16];
#pragma unroll
        for (int g = 0; g < 4; ++g) { float run = aft[g];
#pragma unroll
            for (int r = 3; r >= 0; --r) { const int i = 4 * g + r; av[i] = __expf(z[i] + run); run += lm[i]; } }
        bf16x8_t pa[2];
#pragma unroll
        for (int s = 0; s < 2; ++s) { u32x4 p; p.x = pg8::cvt_pk_bf16(av[8 * s], av[8 * s + 1]); p.y = pg8::cvt_pk_bf16(av[8 * s + 2], av[8 * s + 3]); p.z = pg8::cvt_pk_bf16(av[8 * s + 4], av[8 * s + 5]); p.w = pg8::cvt_pk_bf16(av[8 * s + 6], av[8 * s + 7]); pa[s] = __builtin_bit_cast(bf16x8_t, p); }
        LDS_WAIT();
#pragma unroll
        for (int half = 0; half < 2; ++half) {
            s16x4 tr[8];
            if (half == 0) tr8_sb0(traddr, tr); else tr8_sb1(traddr, tr);
#pragma unroll
            for (int cc = 0; cc < 2; ++cc)
#pragma unroll
                for (int s = 0; s < 2; ++s) {
                    const bf16x8_t vf = __builtin_shufflevector(tr[(cc * 2 + s) * 2], tr[(cc * 2 + s) * 2 + 1], 0, 1, 2, 3, 4, 5, 6, 7);
                    o[2 * half + cc] = __builtin_amdgcn_mfma_f32_32x32x16_bf16(vf, pa[s], o[2 * half + cc], 0, 0, 0);
                }
        }
        if (__all(carry <= SB_STOP)) break;
    }
}
__device__ __forceinline__ void tr_read2(unsigned a0, unsigned a1, s16x4& r0, s16x4& r1) {
    asm volatile("ds_read_b64_tr_b16 %0, %2\n\tds_read_b64_tr_b16 %1, %3\n\ts_waitcnt lgkmcnt(0)" : "=&v"(r0), "=&v"(r1) : "v"(a0), "v"(a1) : "memory"); }
__device__ __forceinline__ int wave_sum_i(int v) {
    v += __builtin_amdgcn_update_dpp(0, v, 0xB1, 0xF, 0xF, true);
    v += __builtin_amdgcn_update_dpp(0, v, 0x4E, 0xF, 0xF, true);
    v += __builtin_amdgcn_update_dpp(0, v, 0x141, 0xF, 0xF, true);
    v += __builtin_amdgcn_update_dpp(0, v, 0x140, 0xF, 0xF, true);
    return __builtin_amdgcn_readlane(v, 0) + __builtin_amdgcn_readlane(v, 16) + __builtin_amdgcn_readlane(v, 32) + __builtin_amdgcn_readlane(v, 48);
}
template <int NR>
__device__ __forceinline__ void topk_row(const float* __restrict__ row, int n, LAS unsigned short* sel, int lane_in) {
    int lane = lane_in; asm volatile("" : "+v"(lane));
    unsigned key[NR];
#pragma unroll
    for (int i = 0; i < NR; ++i) { const int s = lane + 64 * i; const float v = __hip_atomic_load(row + s, __ATOMIC_RELAXED, __HIP_MEMORY_SCOPE_AGENT); key[i] = s < n ? fkey(v) : 0u; }
    unsigned T = 0u; bool exact = false;
    for (int bit = 31; bit >= 0; --bit) {
        const unsigned cand = T | (1u << bit);
        int c = 0;
#pragma unroll
        for (int i = 0; i < NR; ++i) c += (key[i] >= cand) ? 1 : 0;
        c = wave_sum_i(c);
        if (c >= 256) { T = cand; if (c == 256) { exact = true; break; } }
    }
    const unsigned long long ltm = (1ull << lane) - 1ull;
    if (exact) {
        int base = 0;
#pragma unroll
        for (int i = 0; i < NR; ++i) {
            const bool take = key[i] >= T;
            const unsigned long long mt = __ballot(take);
            if (take) sel[base + __popcll(mt & ltm)] = (unsigned short)(lane + 64 * i);
            base += __popcll(mt);
        }
    } else {
        int cg = 0;
#pragma unroll
        for (int i = 0; i < NR; ++i) cg += (key[i] > T) ? 1 : 0;
        const int need = 256 - wave_sum_i(cg);
        int base = 0, run_eq = 0;
#pragma unroll 1
        for (int i = 0; i < NR; ++i) {
            unsigned k = key[0];
#pragma unroll
            for (int q = 1; q < NR; ++q) k = (i == q) ? key[q] : k;
            const bool gt = k > T, eq = (k == T);
            const unsigned long long meq = __ballot(eq);
            const bool take = gt || (eq && (run_eq + __popcll(meq & ltm)) < need);
            const unsigned long long mt = __ballot(take);
            if (take) sel[base + __popcll(mt & ltm)] = (unsigned short)(lane + 64 * i);
            base += __popcll(mt); run_eq += __popcll(meq);
        }
    }
}
__device__ __forceinline__ void dsa_token(const bf16_t* __restrict__ B0, const bf16_t* __restrict__ QA, const float* __restrict__ q_gain, const float* __restrict__ gn_a, bf16_t* __restrict__ O,
                                          int b, int t, int cnt, const LAS unsigned short* sel, const LAS float* s_bias, LAS unsigned char* vt) {
    int lane = threadIdx.x & 63; asm volatile("" : "+v"(lane));
    const int fr = lane & 15, g = lane >> 4, hd = fr & 7;
    const size_t m = (size_t)b * S + t;
    bf16x8_t bqa[4];
    {
        const bf16_t* qp = QA + m * 1024 + hd * 128 + 32 * g;
        float qf[32]; float ss = 0.f;
#pragma unroll
        for (int kk = 0; kk < 4; ++kk) { const u32x4 v = *(const u32x4*)(qp + 8 * kk);
#pragma unroll
            for (int j = 0; j < 4; ++j) { const unsigned w = v[j]; qf[8 * kk + 2 * j] = __uint_as_float(w << 16); qf[8 * kk + 2 * j + 1] = __uint_as_float(w & 0xffff0000u); } }
#pragma unroll
        for (int j = 0; j < 32; ++j) ss += qf[j] * qf[j];
        ss += __shfl_xor(ss, 16); ss += __shfl_xor(ss, 32);
        const float rs = (fr < 8) ? rsqrtf(ss * (1.f / 128.f) + EPS) * 0.08838834764831845f : 0.f;
        const float* gp = q_gain + 32 * g;
#pragma unroll
        for (int kk = 0; kk < 4; ++kk) { u32x4 p;
#pragma unroll
            for (int j = 0; j < 4; ++j) p[j] = pg8::cvt_pk_bf16(qf[8 * kk + 2 * j] * rs * gp[8 * kk + 2 * j], qf[8 * kk + 2 * j + 1] * rs * gp[8 * kk + 2 * j + 1]);
            bqa[kk] = __builtin_bit_cast(bf16x8_t, p); }
    }
    f32x4 lg[16];
    const bf16_t* kbase = B0 + (size_t)b * S * 1024 + 512 + 32 * g;
    bf16x8_t ka[4][4];
#define DSA_ISSUE_K(i, slot) do { const int s_ = sel[16 * (i) + fr]; const bf16_t* kp_ = kbase + (size_t)s_ * 1024; \
        _Pragma("unroll") for (int kk = 0; kk < 4; ++kk) ka[slot][kk] = *(const bf16x8_t*)(kp_ + 8 * kk); } while (0)
    DSA_ISSUE_K(0, 0); DSA_ISSUE_K(1, 1); DSA_ISSUE_K(2, 2); DSA_ISSUE_K(3, 3);
    asm volatile("" ::: "memory");
#pragma unroll
    for (int i = 0; i < 16; ++i) {
        f32x4 acc = (f32x4){0.f, 0.f, 0.f, 0.f};
#pragma unroll
        for (int kk = 0; kk < 4; ++kk) acc = __builtin_amdgcn_mfma_f32_16x16x32_bf16(ka[i & 3][kk], bqa[kk], acc, 0, 0, 0);
        lg[i] = acc;
        if (i + 4 < 16) DSA_ISSUE_K(i + 4, i & 3);
        asm volatile("" ::: "memory");
    }
#undef DSA_ISSUE_K
    const bf16_t* vb0 = B0 + (size_t)b * S * 1024 + 640 + 8 * (lane & 15);
    u32x4 vr[2][8];
#define DSA_ISSUE_V(ks, slot) do { _Pragma("unroll") for (int i = 0; i < 8; ++i) { const int s_ = sel[32 * (ks) + 4 * i + (lane >> 4)]; vr[slot][i] = *(const u32x4*)(vb0 + (size_t)s_ * 1024); } } while (0)
    DSA_ISSUE_V(0, 0);
    asm volatile("" ::: "memory");
    float mx = -INFINITY;
#pragma unroll
    for (int i = 0; i < 16; ++i) {
        const u32x2 sv = *(const LAS u32x2*)(sel + 16 * i + 4 * g);
#pragma unroll
        for (int r = 0; r < 4; ++r) { const int j = 16 * i + 4 * g + r; const int sj = (int)((r & 1) ? (sv[r >> 1] >> 16) : (sv[r >> 1] & 0xffffu));
            int d = t - sj; d = d < 0 ? 0 : (d > 127 ? 127 : d);
            const float v = (j < cnt) ? lg[i][r] + s_bias[d * 8 + hd] : -INFINITY; lg[i][r] = v; mx = fmaxf(mx, v); }
    }
    mx = fmaxf(mx, __shfl_xor(mx, 16)); mx = fmaxf(mx, __shfl_xor(mx, 32));
    float sm = 0.f;
#pragma unroll
    for (int i = 0; i < 16; ++i)
#pragma unroll
        for (int r = 0; r < 4; ++r) { const float p = __expf(lg[i][r] - mx); lg[i][r] = p; sm += p; }
    sm += __shfl_xor(sm, 16); sm += __shfl_xor(sm, 32);
    const float inv = 1.f / sm;
    bf16x8_t pa[8];
#pragma unroll
    for (int ks = 0; ks < 8; ++ks) { u32x4 p; const f32x4 p0 = lg[2 * ks], p1 = lg[2 * ks + 1];
        p.x = pg8::cvt_pk_bf16(p0[0], p0[1]); p.y = pg8::cvt_pk_bf16(p0[2], p0[3]); p.z = pg8::cvt_pk_bf16(p1[0], p1[1]); p.w = pg8::cvt_pk_bf16(p1[2], p1[3]);
        pa[ks] = __builtin_bit_cast(bf16x8_t, p); }
    f32x4 out[8];
#pragma unroll
    for (int c = 0; c < 8; ++c) out[c] = (f32x4){0.f, 0.f, 0.f, 0.f};
    const int tq = fr >> 2, tp = fr & 3;
    const unsigned traddr = (unsigned)(uintptr_t)vt + VT_STRIDE * (4 * g + tq) + 16 * (tp >> 1) + 8 * (tp & 1);
    DSA_ISSUE_V(1, 1);
    asm volatile("" ::: "memory");
#pragma unroll
    for (int ks = 0; ks < 8; ++ks) {
#pragma unroll
        for (int i = 0; i < 8; ++i) *(LAS u32x4*)(vt + (4 * i + (lane >> 4)) * VT_STRIDE + 16 * (lane & 15)) = vr[ks & 1][i];
        if (ks + 2 < 8) DSA_ISSUE_V(ks + 2, ks & 1);
        LDS_WAIT();
#pragma unroll
        for (int half = 0; half < 2; ++half) {
            s16x4 tr[8];
            if (half == 0) tr8_dsa0(traddr, tr); else tr8_dsa1(traddr, tr);
#pragma unroll
            for (int cc = 0; cc < 4; ++cc) {
                const bf16x8_t vf = __builtin_shufflevector(tr[2 * cc], tr[2 * cc + 1], 0, 1, 2, 3, 4, 5, 6, 7);
                out[4 * half + cc] = __builtin_amdgcn_mfma_f32_16x16x32_bf16(pa[ks], vf, out[4 * half + cc], 0, 0, 0);
            }
        }
        asm volatile("" ::: "memory");
    }
#undef DSA_ISSUE_V
    float invh[4];
#pragma unroll
    for (int r = 0; r < 4; ++r) invh[r] = __shfl(inv, 4 * (g & 1) + r);
    float ss = 0.f;
#pragma unroll
    for (int c = 0; c < 8; ++c)
#pragma unroll
        for (int r = 0; r < 4; ++r) { const float v = out[c][r] * invh[r]; out[c][r] = v; ss += (g < 2) ? v * v : 0.f; }
    const float rstd = rsqrtf(wave_sum(ss) * (1.f / 1024.f) + EPS);
    if (g < 2) {
#pragma unroll
        for (int c = 0; c < 8; ++c)
#pragma unroll
            for (int r = 0; r < 4; ++r) { const int e = (4 * g + r) * 128 + 16 * c + fr; O[m * D + e] = f2bf(out[c][r] * rstd * gn_a[e]); }
    }
}
__device__ __forceinline__ void idx4(const bf16_t* __restrict__ B0, const bf16_t* __restrict__ QI, int b, int t0, float* __restrict__ SCW) {
    int lane = threadIdx.x & 63; asm volatile("" : "+v"(lane));
    const int r32 = lane & 31, hi = lane >> 5;
    bf16x8_t aq[2][4]; float wv[2][16];
#pragma unroll
    for (int blk = 0; blk < 2; ++blk) {
        const int tt = (r32 >> 2) & 1, hh = (r32 & 3) + 4 * (r32 >> 3);
        const bf16_t* qp = QI + (size_t)(b * S + t0 + 2 * blk + tt) * 1024 + hh * 64 + 32 * hi;
#pragma unroll
        for (int kk = 0; kk < 4; ++kk) aq[blk][kk] = *(const bf16x8_t*)(qp + 8 * kk);
        const bf16_t* wp = B0 + (size_t)(b * S + t0 + 2 * blk + hi) * 1024 + 832;
        const u32x4 w0 = *(const u32x4*)wp, w1 = *(const u32x4*)(wp + 8);
#pragma unroll
        for (int j = 0; j < 4; ++j) { wv[blk][2 * j] = __uint_as_float(w0[j] << 16); wv[blk][2 * j + 1] = __uint_as_float(w0[j] & 0xffff0000u); wv[blk][8 + 2 * j] = __uint_as_float(w1[j] << 16); wv[blk][8 + 2 * j + 1] = __uint_as_float(w1[j] & 0xffff0000u); }
    }
    const bf16_t* kb = B0 + (size_t)(b * S + r32) * 1024 + 768 + 32 * hi;
    const int nsub = (t0 + 3) / 32 + 1;
    bf16x8_t bk[3][4];
#define IDX_ISSUE(sub, slot) do { const int sb_ = (sub) < nsub ? (sub) : nsub - 1; const bf16_t* p_ = kb + (size_t)sb_ * 32 * 1024; \
        _Pragma("unroll") for (int kk = 0; kk < 4; ++kk) bk[slot][kk] = *(const bf16x8_t*)(p_ + 8 * kk); } while (0)
    IDX_ISSUE(0, 0); IDX_ISSUE(1, 1); IDX_ISSUE(2, 2);
    for (int sub0 = 0; sub0 < nsub; sub0 += 3) {
#pragma unroll
        for (int j = 0; j < 3; ++j) {
            const int sub = sub0 + j;
            if (sub < nsub) {
#pragma unroll
                for (int blk = 0; blk < 2; ++blk) {
                    f32x16 sc;
#pragma unroll
                    for (int i = 0; i < 16; ++i) sc[i] = 0.f;
#pragma unroll
                    for (int kk = 0; kk < 4; ++kk) sc = __builtin_amdgcn_mfma_f32_32x32x16_bf16(aq[blk][kk], bk[j][kk], sc, 0, 0, 0);
                    float score = 0.f;
#pragma unroll
                    for (int i = 0; i < 16; ++i) score += wv[blk][i] * fmaxf(sc[i], 0.f);
                    SCW[(size_t)(2 * blk + hi) * 4096 + sub * 32 + r32] = score;
                }
            }
            IDX_ISSUE(sub + 3, j);
            asm volatile("" ::: "memory");
        }
    }
#undef IDX_ISSUE
}
__device__ __forceinline__ void p5_attn(const MkArgs& a, LAS unsigned char* lds) {
    const int tid = threadIdx.x, lane = tid & 63, wave = __builtin_amdgcn_readfirstlane(tid >> 6);
    const bf16_t* B0 = (const bf16_t*)(a.ws + WS_B0); const bf16_t* QI = (const bf16_t*)(a.ws + WS_QI); const bf16_t* QA = (const bf16_t*)(a.ws + WS_QA);
    const bf16_t* QB = (const bf16_t*)(a.ws + WS_QB); const bf16_t* KB = (const bf16_t*)(a.ws + WS_KB); const bf16_t* VB = (const bf16_t*)(a.ws + WS_VB);
    bf16_t* O = (bf16_t*)(a.ws + WS_O); float* OBS = (float*)(a.ws + WS_OBS); const float* rel_bias = a.in[10];
    const int gw = blockIdx.x * 8 + wave;
    float* SCW = (float*)(a.ws + (gw < 1024 ? WS_XN : WS_OBRAW)) + (size_t)(gw & 1023) * (4 * 4096);
    constexpr int KT_BYTES = 128 * 144;
    LAS unsigned char* s_kt = lds;
    LAS unsigned char* s_vt = lds + wave * 9216;
    LAS float* s_bias = (LAS float*)(lds + 73728);
    LAS unsigned short* s_sel = (LAS unsigned short*)(lds + 77824 + wave * 2048);
    for (int i = tid; i < 1024; i += MK_THREADS) s_bias[i] = rel_bias[t5_bucket(i >> 3) * 8 + (i & 7)];
    const bool xcd_ok = (gridDim.x & 7) == 0;
    const int xb = xcd_ok ? (((int)blockIdx.x & 7) >> 1) : 0, rbk = xcd_ok ? (((int)blockIdx.x >> 3) * 2 + ((int)blockIdx.x & 1)) : (int)blockIdx.x, RB = xcd_ok ? (int)(gridDim.x >> 2) : (int)gridDim.x;
    const int nitem = xcd_ok ? 128 : 512;
    for (int q = 0; q * RB < nitem; ++q) {
        const int it = (q & 1) ? (q * RB + (RB - 1 - rbk)) : (q * RB + rbk);
        if (it >= nitem) continue;
        const int b = xcd_ok ? xb : (it & 3), t0i = (xcd_ok ? it : (it >> 2)) * 32, t0 = t0i + 4 * wave;
        {
            int ln = lane; asm volatile("" : "+v"(ln));
            const int r32 = ln & 31, hi = ln >> 5;
            bf16x8_t aq[2][4]; float wv[2][16];
#pragma unroll
            for (int blk = 0; blk < 2; ++blk) {
                const int tt = (r32 >> 2) & 1, hh = (r32 & 3) + 4 * (r32 >> 3);
                const bf16_t* qp = QI + (size_t)(b * S + t0 + 2 * blk + tt) * 1024 + hh * 64 + 32 * hi;
#pragma unroll
                for (int kk = 0; kk < 4; ++kk) aq[blk][kk] = *(const bf16x8_t*)(qp + 8 * kk);
                const bf16_t* wp = B0 + (size_t)(b * S + t0 + 2 * blk + hi) * 1024 + 832;
                const u32x4 w0 = *(const u32x4*)wp, w1 = *(const u32x4*)(wp + 8);
#pragma unroll
                for (int j = 0; j < 4; ++j) { wv[blk][2 * j] = __uint_as_float(w0[j] << 16); wv[blk][2 * j + 1] = __uint_as_float(w0[j] & 0xffff0000u); wv[blk][8 + 2 * j] = __uint_as_float(w1[j] << 16); wv[blk][8 + 2 * j + 1] = __uint_as_float(w1[j] & 0xffff0000u); }
            }
            const int nkb = (t0i + 31) / 128 + 1;
            REP(50) {
                const int key = tid >> 2, q4 = tid & 3;
                const bf16_t* src = B0 + (size_t)(b * S + key) * 1024 + 768 + 16 * q4;
                u32x4 v0 = *(const u32x4*)src, v1 = *(const u32x4*)(src + 8);
                __syncthreads();
                *(LAS u32x4*)(s_kt + key * 144 + q4 * 32) = v0; *(LAS u32x4*)(s_kt + key * 144 + q4 * 32 + 16) = v1;
                __syncthreads();
                for (int kb = 0; kb < nkb; ++kb) {
                    LAS unsigned char* cur = s_kt + (kb & 1) * KT_BYTES; LAS unsigned char* nxt = s_kt + ((kb + 1) & 1) * KT_BYTES;
                    const bool more = kb + 1 < nkb;
                    if (more) { const bf16_t* sn = src + (size_t)(kb + 1) * 128 * 1024; v0 = *(const u32x4*)sn; v1 = *(const u32x4*)(sn + 8); }
#pragma unroll
                    for (int sub = 0; sub < 4; ++sub) {
                        bf16x8_t bk[4];
#pragma unroll
                        for (int kk = 0; kk < 4; ++kk) bk[kk] = *(const LAS bf16x8_t*)(cur + (32 * sub + r32) * 144 + (32 * hi + 8 * kk) * 2);
#pragma unroll
                        for (int blk = 0; blk < 2; ++blk) {
                            f32x16 sc;
#pragma unroll
                            for (int i = 0; i < 16; ++i) sc[i] = 0.f;
#pragma unroll
                            for (int kk = 0; kk < 4; ++kk) sc = __builtin_amdgcn_mfma_f32_32x32x16_bf16(aq[blk][kk], bk[kk], sc, 0, 0, 0);
                            float score = 0.f;
#pragma unroll
                            for (int i = 0; i < 16; ++i) score += wv[blk][i] * fmaxf(sc[i], 0.f);
                            SCW[(size_t)(2 * blk + hi) * 4096 + kb * 128 + sub * 32 + r32] = score;
                        }
                    }
                    if (more) { *(LAS u32x4*)(nxt + key * 144 + q4 * 32) = v0; *(LAS u32x4*)(nxt + key * 144 + q4 * 32 + 16) = v1; }
                    __syncthreads();
                }
            }
        }
        asm volatile("s_waitcnt vmcnt(0)" ::: "memory");
        REP(51) for (int tt = 0; tt < 4; ++tt) {
            const int t = t0 + tt, n = t + 1; const float* row = SCW + (size_t)tt * 4096; LAS unsigned short* sel = s_sel + tt * 256;
            if (n <= 256) { for (int i = 0; i < 4; ++i) { const int j = lane + 64 * i; sel[j] = (unsigned short)(j < n ? j : 0); } }
            else if (n <= 1024) topk_row<16>(row, n, sel, lane);
            else if (n <= 2048) topk_row<32>(row, n, sel, lane);
            else if (n <= 3072) topk_row<48>(row, n, sel, lane);
            else topk_row<64>(row, n, sel, lane);
        }
        LDS_WAIT();
        REP(52) for (int tt = 0; tt < 4; ++tt) {
            const int t = t0 + tt;
            dsa_token(B0, QA, a.in[8], a.in[11], O, b, t, t + 1 < 256 ? t + 1 : 256, s_sel + tt * 256, s_bias, s_vt);
        }
        REP(53) {
            const int h = wave, q0 = t0i;
            f32x16 o[4];
            sb_wave(QB, KB, VB, b, h, q0, s_vt, o);
            const int r32 = lane & 31, hi = lane >> 5;
            float ss = 0.f;
#pragma unroll
            for (int c = 0; c < 4; ++c)
#pragma unroll
                for (int i = 0; i < 16; ++i) ss += o[c][i] * o[c][i];
            ss += __shfl_xor(ss, 32);
            const size_t m = (size_t)b * S + q0 + r32;
            if (hi == 0) OBS[m * 8 + h] = ss;
            bf16_t* op = O + m * D + 1024 + h * 128;
#pragma unroll
            for (int c = 0; c < 4; ++c)
#pragma unroll
                for (int g = 0; g < 4; ++g) { const int d = 32 * c + 8 * g + 4 * hi;
                    u32x2 w; w.x = pk2(o[c][4 * g], o[c][4 * g + 1]); w.y = pk2(o[c][4 * g + 2], o[c][4 * g + 3]); *(u32x2*)(op + d) = w; }
        }
    }
}
__device__ __forceinline__ void obnorm_pass(const MkArgs& a) {
    const int tid = threadIdx.x, lane = tid & 63, wave = __builtin_amdgcn_readfirstlane(tid >> 6);
    bf16_t* O = (bf16_t*)(a.ws + WS_O); const float* OBS = (const float*)(a.ws + WS_OBS); const float* gn_b = a.in[12];
    f32x4 gv[4];
#pragma unroll
    for (int j = 0; j < 4; ++j) gv[j] = *(const f32x4*)(gn_b + 16 * lane + 4 * j);
    for (int m = blockIdx.x * 8 + wave; m < M; m += gridDim.x * 8) {
        const f32x4 s0 = *(const f32x4*)(OBS + (size_t)m * 8), s1 = *(const f32x4*)(OBS + (size_t)m * 8 + 4);
        const float rstd = rsqrtf(((s0[0] + s0[1]) + (s0[2] + s0[3]) + (s1[0] + s1[1]) + (s1[2] + s1[3])) * (1.f / 1024.f) + EPS);
        u32x4* p = (u32x4*)(O + (size_t)m * D + 1024 + 16 * lane);
        u32x4 v0 = p[0], v1 = p[1];
#pragma unroll
        for (int j = 0; j < 4; ++j) { const float lo0 = __uint_as_float(v0[j] << 16) * rstd, hi0 = __uint_as_float(v0[j] & 0xffff0000u) * rstd;
            const float lo1 = __uint_as_float(v1[j] << 16) * rstd, hi1 = __uint_as_float(v1[j] & 0xffff0000u) * rstd;
            v0[j] = pk2(lo0 * gv[j >> 1][2 * (j & 1)], hi0 * gv[j >> 1][2 * (j & 1) + 1]); v1[j] = pk2(lo1 * gv[2 + (j >> 1)][2 * (j & 1)], hi1 * gv[2 + (j >> 1)][2 * (j & 1) + 1]); }
        p[0] = v0; p[1] = v1;
    }
}

constexpr int CW_BAR = 4096;
__global__ void __launch_bounds__(MK_THREADS, 2) mk_fwd(MkArgs a) {
    extern __shared__ __attribute__((aligned(16))) unsigned char lds_raw[];
    LAS unsigned char* lds = (LAS unsigned char*)lds_raw;
    const int lo = a.ph_lo, hi = a.ph_hi;
    const bool fused = (hi - lo) > 1;
    volatile LAS unsigned* misc = (volatile LAS unsigned*)(lds + MK_MISC_OFF);
    XcdBarrier bar; bar.bar = (unsigned*)(a.ws + WS_CTL) + CW_BAR; bar.x = 0; bar.st = misc + 8;
    if (fused) {
        if (threadIdx.x < 32) misc[threadIdx.x] = 0u;
        __syncthreads();
        bar = xcd_barrier_post((unsigned*)(a.ws + WS_CTL) + CW_BAR, misc + 8);
    }
    int nbar = 0;
    if (a.ph_lo < 0) cg::this_grid().sync();
#ifdef MK_TS_A
    volatile LAS unsigned* ts_ = (volatile LAS unsigned*)(lds + MK_MISC_OFF + 128); int nts_ = 0;
#define STAMP() do { if (threadIdx.x == 0) ts_[nts_] = (unsigned)__builtin_amdgcn_s_memrealtime(); ++nts_; } while (0)
#else
#define STAMP() do {} while (0)
#endif
    STAMP();
#define IN(k) (lo <= (k) && (k) < hi)
#define SEAM() do { if (fused) { xcd_barrier(bar); ++nbar; } STAMP(); } while (0)
    if (IN(0)) { REP(0) { p0_prep(a, lds); __syncthreads(); } SEAM(); }
    if (IN(1)) { REP(1) { p1_xn(a, lds); __syncthreads(); } SEAM(); }
    if (IN(2)) {
        pg8::Gemm g{(const bf16_t*)(a.ws + WS_XN), (const bf16_t*)(a.ws + WS_WTIN), M, 4096, D, D, D};
        pg8::StaticOrder S; S.init(g, (int)gridDim.x, (int)blockIdx.x, (MK_DUP) == 2 ? 2 : 1);
        EpiInProj E{(bf16_t*)(a.ws + WS_B0), (bf16_t*)(a.ws + WS_QB), (bf16_t*)(a.ws + WS_KB), (bf16_t*)(a.ws + WS_VB), (float*)(a.ws + WS_SSQ)};
        pg8::gemm_phase<EpiInProj, pg8::StaticOrder>(lds, g, S, E);
        SEAM();
    }
    if (IN(3)) {
        kanorm_pass(a);
        pg8::Gemm g{(const bf16_t*)(a.ws + WS_B0), (const bf16_t*)(a.ws + WS_WTQUP), M, 2048, 512, 1024, 512};
        pg8::StaticOrder S; S.init(g, (int)gridDim.x, (int)blockIdx.x, (MK_DUP) == 3 ? 2 : 1);
        EpiQupG E{(const float*)(a.ws + WS_SSQ), (bf16_t*)(a.ws + WS_QA), (bf16_t*)(a.ws + WS_QI)};
        pg8::gemm_phase<EpiQupG, pg8::StaticOrder>(lds, g, S, E);
        SEAM();
    }
    if (IN(5)) { REP(5) { p5_attn(a, lds); __syncthreads(); } SEAM(); }
    if (IN(7)) {
        obnorm_pass(a);
        pg8::Gemm g{(const bf16_t*)(a.ws + WS_O), (const bf16_t*)(a.ws + WS_WTOUT), M, D, D, D, D};
        pg8::StaticOrder S; S.init(g, (int)gridDim.x, (int)blockIdx.x, (MK_DUP) == 7 ? 2 : 1);
        EpiOutProj E{a.in[0], (const float*)(a.ws + WS_MOD), (bf16_t*)(a.ws + WS_X1B)};
        pg8::gemm_phase<EpiOutProj, pg8::StaticOrder>(lds, g, S, E);
        SEAM();
    }
    if (IN(8)) { p8_route(a, lds); SEAM(); }
    if (IN(9)) {
        const MoeTab t = moe_tab_build(a, lds);
        pg8::Gemm g{(const bf16_t*)(a.ws + WS_XN), (const bf16_t*)(a.ws + WS_WTGU), 0, 0, D, D, D};
        SchedGU S; S.init(t, a, (int)gridDim.x, (int)blockIdx.x, (MK_DUP) == 9 ? 2 : 1);
        EpiGU E{(bf16_t*)(a.ws + WS_U)};
        pg8::gemm_phase<EpiGU, SchedGU>(lds, g, S, E);
        SEAM();
    }
    if (IN(10)) {
        const MoeTab t = moe_tab_build(a, lds);
        pg8::Gemm g{(const bf16_t*)(a.ws + WS_U), (const bf16_t*)(a.ws + WS_WTDN), 0, 0, 512, 512, 512};
        SchedDN S; S.init(t, a, (int)gridDim.x, (int)blockIdx.x, (MK_DUP) == 10 ? 2 : 1);
        EpiY E{(bf16_t*)(a.ws + WS_Y)};
        pg8::gemm_phase<EpiY, SchedDN>(lds, g, S, E);
        SEAM();
    }
    if (IN(11)) {
        const MoeTab t = moe_tab_build(a, lds);
        REP(11) p11_combine(a, t);
    }
#ifdef MK_XBAR
    for (int i_ = 0; i_ < MK_XBAR; ++i_) { SEAM(); }
#endif
#ifdef MK_TS_A
    SEAM();
    __syncthreads();
    if (blockIdx.x == 0) {
        const float db = (MK_TS_A == 10) ? (float)(ts_[10] - ts_[0]) * 0.01f : (float)(ts_[MK_TS_A + 1] - ts_[MK_TS_A]) * 0.01f;
#ifdef MK_TS_Q
        const float dq = (float)(MK_TS_Q) * rintf(db / (float)(MK_TS_Q));
#else
        const float dq = db;
#endif
        for (int i = threadIdx.x; i < (1 << 20); i += MK_THREADS) a.out[4096 + i] *= (1.f + dq * (MK_TS_C));
    }
#endif
#undef IN
#undef SEAM
}

#ifndef MK_ONE_LAUNCH
#define MK_ONE_LAUNCH 1
#endif
extern "C" void kernel_launch(void* const* d_in, const int* in_sizes, int n_in, void* d_out, int out_size, void* d_ws, size_t ws_size, hipStream_t stream) {
    static int grid = 0;
    if (grid == 0) {
        if (ws_size < WS_END || n_in != 20 || out_size != M * D) { fprintf(stderr, "kernel_launch: unexpected sizes: ws %zu (need %zu), n_in %d, out %d\n", ws_size, (size_t)WS_END, n_in, out_size); grid = -1; return; }
        int dev = 0, cus = 0, per_cu = 0;
        if (hipGetDevice(&dev) != hipSuccess || hipDeviceGetAttribute(&cus, hipDeviceAttributeMultiprocessorCount, dev) != hipSuccess) { grid = -1; return; }
        if (hipFuncSetAttribute((const void*)mk_fwd, hipFuncAttributeMaxDynamicSharedMemorySize, MK_LDS) != hipSuccess) { fprintf(stderr, "kernel_launch: hipFuncSetAttribute failed\n"); grid = -1; return; }
        if (hipOccupancyMaxActiveBlocksPerMultiprocessor(&per_cu, (const void*)mk_fwd, MK_THREADS, MK_LDS) != hipSuccess || per_cu < 1) { fprintf(stderr, "kernel_launch: occupancy query failed (%d)\n", per_cu); grid = -1; return; }
        grid = cus < 256 ? cus : 256;
        fprintf(stderr, "kernel_launch: cus %d per_cu %d grid %d\n", cus, per_cu, grid);
    }
    if (grid < 0) return;
    if (hipMemsetAsync(d_ws, 0, 1 * MiB, stream) != hipSuccess) return;
    MkArgs a{};
    for (int i = 0; i < 20; ++i) a.in[i] = (const float*)d_in[i];
    a.out = (float*)d_out; a.ws = (unsigned char*)d_ws;
#if MK_ONE_LAUNCH
    a.ph_lo = 0; a.ph_hi = 12;
    void* args[] = {&a};
    const hipError_t e = hipLaunchCooperativeKernel((const void*)mk_fwd, dim3(grid), dim3(MK_THREADS), args, MK_LDS, stream);
    if (e != hipSuccess) fprintf(stderr, "kernel_launch: cooperative launch failed: %s (grid %d)\n", hipGetErrorString(e), grid);
#else
    const int phases[] = {0, 1, 2, 3, 5, 7, 8, 9, 10, 11};
    for (int ph : phases) { a.ph_lo = ph; a.ph_hi = ph + 1; hipLaunchKernelGGL(mk_fwd, dim3(grid), dim3(MK_THREADS), MK_LDS, stream, a); }
#endif
}
```

```cpp
#include <hip/hip_runtime.h>
#include <hip/hip_cooperative_groups.h>
#include <stdint.h>
#include <cstdio>
namespace cg = cooperative_groups;

typedef unsigned short bf16_t;
#define LAS __attribute__((address_space(3)))

constexpr int D = 2048, NB = 4, S = 4096, M = NB * S;
constexpr int NMOD = 6 * D;
constexpr int DIN = 3920;
constexpr float EPS = 1e-6f;
constexpr size_t MiB = 1ull << 20;
constexpr size_t WS_CTL = 0;
constexpr size_t WS_MOD = 1 * MiB;
constexpr size_t WS_RC = 2 * MiB;
constexpr size_t WS_EID = 3 * MiB;
constexpr size_t WS_GW = 4 * MiB;
constexpr size_t WS_SSQ = 5 * MiB;
constexpr size_t WS_XN = 8 * MiB;
constexpr size_t WS_B0 = 72 * MiB;
constexpr size_t WS_QB = 104 * MiB;
constexpr size_t WS_KB = 136 * MiB;
constexpr size_t WS_VB = 168 * MiB;
constexpr size_t WS_QA = 200 * MiB;
constexpr size_t WS_QI = 232 * MiB;
constexpr size_t WS_SEL = 264 * MiB;
constexpr size_t WS_O = 272 * MiB;
constexpr size_t WS_OBRAW = 336 * MiB;
constexpr size_t WS_MODP = 400 * MiB;
constexpr size_t WS_WTIN = 408 * MiB;
constexpr size_t WS_WTQUP = 424 * MiB;
constexpr size_t WS_WTOUT = 426 * MiB;
constexpr size_t WS_WTGU = 434 * MiB;
constexpr size_t WS_WTDN = 562 * MiB;
constexpr size_t WS_RT = 6 * MiB;
constexpr size_t WS_LIST = WS_B0;
constexpr size_t WS_U = WS_O;
constexpr size_t WS_KV8 = WS_MODP;
constexpr size_t WS_X1B = WS_OBRAW;
constexpr size_t WS_Y = WS_QB;
constexpr size_t WS_OBS = 7 * MiB;
constexpr int CW_CNT = 8192;
constexpr size_t WS_END = 626 * MiB;

__device__ __forceinline__ float bf2f(bf16_t v) { return __uint_as_float(((unsigned)v) << 16); }
__device__ __forceinline__ bf16_t f2bf(float f) { unsigned u = __float_as_uint(f); u += 0x7fffu + ((u >> 16) & 1u); return (bf16_t)(u >> 16); }
__device__ __forceinline__ float silu_f(float v) { return v / (1.f + __expf(-v)); }
__device__ __forceinline__ unsigned fkey(float f) { const unsigned u = __float_as_uint(f); return (u & 0x80000000u) ? ~u : (u | 0x80000000u); }
__device__ __forceinline__ int t5_bucket(int dist) {
    if (dist < 16) return dist;
    int large = 16 + (int)(__logf((float)dist * (1.f / 16.f)) / 2.0794415416798357f * 16.f);
    return large < 31 ? large : 31;
}

namespace pg8 {
#define PG8_LAS __attribute__((address_space(3)))
typedef short bf16x8 __attribute__((ext_vector_type(8)));
typedef float f32x4 __attribute__((ext_vector_type(4)));
typedef unsigned u32x4 __attribute__((ext_vector_type(4)));
constexpr int BM = 256, BK = 64, HALF = 128, HTB = HALF * BK * 2, STAGE_BYTES = 8 * HTB, NXCD = 8, WGM = 8;
__host__ __device__ __forceinline__ int lds_byte(int r, int c) { const int st = (r >> 4) * 2 + (c >> 5), rr = r & 15, cc = c & 31, ob = rr * 64 + cc * 2; return st * 1024 + (ob ^ (((ob >> 9) & 1) << 5)); }
__host__ __device__ __forceinline__ void stage_rc(int b, int& R, int& C) { const int st = b / 1024, sb = b % 1024, swz = sb ^ (((sb >> 9) & 1) << 5); R = (st >> 1) * 16 + swz / 64; C = (st & 1) * 32 + (swz % 64) / 2; }
__host__ __device__ __forceinline__ int perm32(int rho) { const int n = rho >> 4, i = rho & 15; return 8 * (i >> 2) + 4 * n + (i & 3); }
__device__ __forceinline__ unsigned cvt_pk_bf16(float lo, float hi) { unsigned r; asm volatile("v_cvt_pk_bf16_f32 %0, %1, %2" : "=v"(r) : "v"(lo), "v"(hi)); return r; }

struct Unit { int pm, pn, aux, dup; const char* a; const char* b; unsigned va[2][2]; };
struct Gemm { const bf16_t* A; const bf16_t* Bt; int M, N, K, lda, ldb; };

struct StaticOrder {
    int nM, nN, nwg, G, c, ndup; const char* A; const char* Bt; size_t tstepA, tstepB; unsigned vb[2][2];
    __device__ void init(const Gemm& g, int G_, int c_, int ndup_ = 1) { ndup = ndup_; nM = g.M / BM; nN = g.N / BM; nwg = nM * nN; G = G_; c = c_; A = (const char*)g.A; Bt = (const char*)g.Bt; tstepA = (size_t)BM * g.lda * 2; tstepB = (size_t)BM * g.ldb * 2;
#pragma unroll
        for (int i = 0; i < 2; ++i) { int R, C; stage_rc((int)threadIdx.x * 16 + i * 8192, R, C); vb[0][i] = (unsigned)(R * g.lda + C) * 2u; vb[1][i] = (unsigned)((HALF + R) * g.lda + C) * 2u; } }
    __device__ bool next(int i, Unit& u) const {
        const long L0 = (long)i * G + c; if (L0 >= (long)nwg * ndup) return false;
        u.dup = (int)(L0 / nwg); int wgid = (int)(L0 % nwg); { const int q = nwg / NXCD, r = nwg % NXCD, xcd = wgid % NXCD, off = wgid / NXCD; wgid = (xcd < r ? xcd * (q + 1) : r * (q + 1) + (xcd - r) * q) + off; }
        const int nig = WGM * nN, gid = wgid / nig, fm = gid * WGM, gsz = (nM - fm) < WGM ? (nM - fm) : WGM;
        u.pm = fm + ((wgid % nig) % gsz); u.pn = (wgid % nig) / gsz;
        u.a = A + (size_t)u.pm * tstepA; u.b = Bt + (size_t)u.pn * tstepB; u.aux = 0; u.va[0][0] = vb[0][0]; u.va[0][1] = vb[0][1]; u.va[1][0] = vb[1][0]; u.va[1][1] = vb[1][1]; return true;
    }
};

template <class Epi, class Sched>
__device__ __forceinline__ void gemm_phase(PG8_LAS unsigned char* lds, const Gemm g, const Sched& S, const Epi& E) {
    const int tid = threadIdx.x, wid = __builtin_amdgcn_readfirstlane(tid >> 6), lane = tid & 63, wr = wid >> 2, wc = wid & 3, fr = lane & 15, fq = lane >> 4;
    const int K = g.K, nt = K / BK;
    unsigned voffB[2];
#pragma unroll
    for (int i = 0; i < 2; ++i) { int R, C; stage_rc(tid * 16 + i * 8192, R, C); const int Rb = Epi::PERM ? ((R & ~31) + perm32(R & 31)) : R;
        voffB[i] = (unsigned)(Rb * g.ldb + C) * 2u; }
    const size_t kstep = (size_t)(BK * 2);
    const size_t hstepB = (size_t)HALF * g.ldb * 2;
    const unsigned ldsw = (unsigned)wid * 1024u;
    const int aoff = lds_byte(wr * 64 + fr, fq * 8), boff = lds_byte(wc * 32 + fr, fq * 8);
#define PG8_SA(b, h) (((b) * 2 + (h)) * HTB)
#define PG8_SB(b, h) ((4 + (b) * 2 + (h)) * HTB)
#define PG8_STAGE(bufoff, gbase, voff) do { _Pragma("unroll") for (int _i = 0; _i < 2; ++_i) \
        __builtin_amdgcn_global_load_lds((const unsigned*)((const char*)(gbase) + (voff)[_i]), (PG8_LAS unsigned*)(lds + (bufoff) + ldsw + _i * 8192), 16, 0, 0); } while (0)
#define PG8_LDA(dst, b, h) do { _Pragma("unroll") for (int m = 0; m < 4; ++m) _Pragma("unroll") for (int k = 0; k < 2; ++k) dst[m][k] = *(const PG8_LAS bf16x8*)(lds + PG8_SA(b, h) + aoff + m * 2048 + k * 1024); } while (0)
#define PG8_LDB(dst, b, h) do { _Pragma("unroll") for (int n = 0; n < 2; ++n) _Pragma("unroll") for (int k = 0; k < 2; ++k) dst[n][k] = *(const PG8_LAS bf16x8*)(lds + PG8_SB(b, h) + boff + n * 2048 + k * 1024); } while (0)
#define PG8_MMA(ai, bj, At, Bt) do { __builtin_amdgcn_s_setprio(1); _Pragma("unroll") for (int m = 0; m < 4; ++m) _Pragma("unroll") for (int n = 0; n < 2; ++n) _Pragma("unroll") for (int k = 0; k < 2; ++k) \
        acc[ai][bj][m][n] = __builtin_amdgcn_mfma_f32_16x16x32_bf16(Bt[n][k], At[m][k], acc[ai][bj][m][n], 0, 0, 0); __builtin_amdgcn_s_setprio(0); } while (0)
#define PG8_WAIT_V(n) asm volatile("s_waitcnt vmcnt(" #n ")" ::: "memory")
#define PG8_WAIT_L(n) asm volatile("s_waitcnt lgkmcnt(" #n ")" ::: "memory")
#define PG8_BAR __builtin_amdgcn_s_barrier()
#define PG8_SCHED __builtin_amdgcn_sched_barrier(0)
    Unit cur, nxt; int ui = 0;
    if (!S.next(0, cur)) return;
    f32x4 acc[2][2][4][2];
#pragma unroll
    for (int a = 0; a < 2; ++a)
#pragma unroll
        for (int b = 0; b < 2; ++b)
#pragma unroll
            for (int m = 0; m < 4; ++m)
#pragma unroll
                for (int n = 0; n < 2; ++n) acc[a][b][m][n] = (f32x4){0.f, 0.f, 0.f, 0.f};
    bf16x8 At[4][2], B0[2][2], B1[2][2];
    const char* cA = cur.a; const char* cB = cur.b;
    PG8_STAGE(PG8_SB(0, 0), cB, voffB); PG8_STAGE(PG8_SB(0, 1), cB + hstepB, voffB); PG8_STAGE(PG8_SA(0, 0), cA, cur.va[0]); PG8_STAGE(PG8_SA(0, 1), cA, cur.va[1]);
    if (wr == 1) PG8_BAR;
    PG8_WAIT_V(2); PG8_BAR;
    PG8_STAGE(PG8_SB(1, 0), cB + kstep, voffB); PG8_STAGE(PG8_SA(1, 0), cA + kstep, cur.va[0]); PG8_STAGE(PG8_SB(1, 1), cB + hstepB + kstep, voffB);
    PG8_WAIT_V(6); PG8_BAR;
    for (;;) {
        const bool has_next = S.next(ui + 1, nxt);
        if (!has_next) nxt = cur;
        const char* nA = has_next ? nxt.a : cA; const char* nB = has_next ? nxt.b : cB;
        for (int t = 0; t < nt; t += 2) {
            const bool last = (t == nt - 2);
            const char* a1 = cA + (size_t)(t + 1) * kstep;
            const char* a2 = last ? nA : cA + (size_t)(t + 2) * kstep; const char* b2 = last ? nB : cB + (size_t)(t + 2) * kstep;
            const char* a3 = a2 + kstep; const char* b3 = b2 + kstep;
            unsigned vn0[2], vn1[2];
            vn0[0] = last ? nxt.va[0][0] : cur.va[0][0]; vn0[1] = last ? nxt.va[0][1] : cur.va[0][1]; vn1[0] = last ? nxt.va[1][0] : cur.va[1][0]; vn1[1] = last ? nxt.va[1][1] : cur.va[1][1];
            PG8_LDB(B0, 0, 0); PG8_LDB(B1, 0, 1); PG8_SCHED; PG8_LDA(At, 0, 0); PG8_STAGE(PG8_SA(1, 1), a1, cur.va[1]);
            PG8_WAIT_V(8); PG8_WAIT_L(0); PG8_BAR; PG8_MMA(0, 0, At, B0); PG8_MMA(0, 1, At, B1); PG8_BAR; PG8_SCHED;
            PG8_LDA(At, 0, 1); PG8_STAGE(PG8_SB(0, 0), b2, voffB); PG8_STAGE(PG8_SB(0, 1), b2 + hstepB, voffB); PG8_STAGE(PG8_SA(0, 0), a2, vn0);
            PG8_WAIT_V(8); PG8_WAIT_L(0); PG8_BAR; PG8_MMA(1, 0, At, B0); PG8_MMA(1, 1, At, B1); PG8_BAR; PG8_SCHED;
            PG8_LDB(B0, 1, 0); PG8_LDB(B1, 1, 1); PG8_SCHED; PG8_LDA(At, 1, 0); PG8_STAGE(PG8_SA(0, 1), a2, vn1);
            PG8_WAIT_V(8); PG8_WAIT_L(0); PG8_BAR; PG8_MMA(0, 0, At, B0); PG8_MMA(0, 1, At, B1); PG8_BAR; PG8_SCHED;
            PG8_LDA(At, 1, 1); PG8_STAGE(PG8_SB(1, 0), b3, voffB); PG8_STAGE(PG8_SB(1, 1), b3 + hstepB, voffB); PG8_STAGE(PG8_SA(1, 0), a3, vn0);
            PG8_WAIT_V(8); PG8_WAIT_L(0); PG8_BAR; PG8_MMA(1, 0, At, B0); PG8_MMA(1, 1, At, B1); PG8_BAR; PG8_SCHED;
        }
        if (wr == 0) PG8_BAR;
        E(acc, cur, wr, wc, fr, fq);
        if (!has_next) break;
#pragma unroll
        for (int a = 0; a < 2; ++a)
#pragma unroll
            for (int b = 0; b < 2; ++b)
#pragma unroll
                for (int m = 0; m < 4; ++m)
#pragma unroll
                    for (int n = 0; n < 2; ++n) acc[a][b][m][n] = (f32x4){0.f, 0.f, 0.f, 0.f};
        cur = nxt; cA = nA; cB = nB; ++ui;
        if (wr == 1) PG8_BAR;
    }
    PG8_WAIT_V(0);
    PG8_BAR;
#undef PG8_SA
#undef PG8_SB
#undef PG8_STAGE
#undef PG8_LDA
#undef PG8_LDB
#undef PG8_MMA
#undef PG8_WAIT_V
#undef PG8_WAIT_L
#undef PG8_BAR
#undef PG8_SCHED
}
}
#ifndef MK_DUP
#define MK_DUP -1
#endif
#define REP(k) for (int rep_ = 0; rep_ < ((MK_DUP) == (k) ? 2 : 1); ++rep_)

#define XB_TMO      128
#define XB_XCNT(j)  (256  + 64 * (j))
#define XB_XSUB(j)  (1280 + 64 * (j))
#define XB_XGEN(j)  (2304 + 64 * (j))
#define XB_TOP      3328
#define XB_TOPGEN   3392
#define XCD_BAR_WORDS 3456
#define XB_SPIN_CAP (1u << 18)
__device__ __forceinline__ unsigned xb_ld(unsigned* p)              { return __hip_atomic_load(p, __ATOMIC_RELAXED, __HIP_MEMORY_SCOPE_AGENT); }
__device__ __forceinline__ unsigned xb_add(unsigned* p, unsigned v) { return __hip_atomic_fetch_add(p, v, __ATOMIC_RELAXED, __HIP_MEMORY_SCOPE_AGENT); }
__device__ __forceinline__ unsigned xb_xcc_id() { return (unsigned)__builtin_amdgcn_s_getreg((3 << 11) | 20) & 0xFu; }
#define XB_SPIN(cond, bar) do { unsigned _sp = 0; while (cond) { __builtin_amdgcn_s_sleep(1); \
    if ((++_sp & 255u) == 0u) { if (xb_ld(&(bar)[XB_TMO])) break; if (_sp > XB_SPIN_CAP) { atomicAdd(&(bar)[XB_TMO], 1u); break; } } } } while (0)
struct XcdBarrier { unsigned* bar; unsigned x; volatile LAS unsigned* st; };
__device__ __forceinline__ XcdBarrier xcd_barrier_post(unsigned* bar, volatile LAS unsigned* st) {
    XcdBarrier b; b.bar = bar; b.x = xb_xcc_id(); b.st = st;
    if (threadIdx.x == 0) (void)xb_add(&bar[XB_XCNT(b.x)], 1u);
    return b;
}
__device__ __forceinline__ void xcd_barrier_complete(unsigned* bar, unsigned x, unsigned& nloc, unsigned& nx) {
    const unsigned G = gridDim.x * gridDim.y * gridDim.z;
    unsigned sum, cnt, mine, sp = 0u;
    for (;;) {
        sum = 0u; cnt = 0u; mine = 0u;
#pragma unroll
        for (unsigned j = 0; j < 16; ++j) { const unsigned c = xb_ld(&bar[XB_XCNT(j)]); sum += c; cnt += (c > 0u) ? 1u : 0u; mine = (j == x) ? c : mine; }
        if (sum == G) break;
        __builtin_amdgcn_s_sleep(1);
        if ((++sp & 255u) == 0u) { if (xb_ld(&bar[XB_TMO])) break; if (sp > XB_SPIN_CAP) { atomicAdd(&bar[XB_TMO], 1u); break; } }
    }
    nloc = mine > 0u ? mine : 1u; nx = cnt > 0u ? cnt : 1u;
}
__device__ __forceinline__ void xcd_barrier(const XcdBarrier& b) {
    asm volatile("s_waitcnt vmcnt(0)" ::: "memory");
    __syncthreads();
    if (threadIdx.x == 0) {
        unsigned* bar = b.bar;
        __builtin_amdgcn_s_waitcnt(0);
        unsigned nloc = b.st[0], nx = b.st[1];
        if (nloc == 0u) { xcd_barrier_complete(bar, b.x, nloc, nx); b.st[0] = nloc; b.st[1] = nx; }
        const unsigned old = xb_add(&bar[XB_XSUB(b.x)], 1u);
        const unsigned gen = old / nloc;
        if (old + 1u == (gen + 1u) * nloc) {
            __builtin_amdgcn_fence(__ATOMIC_RELEASE, "agent");
            asm volatile("s_waitcnt vmcnt(0)" ::: "memory");
            const unsigned og = xb_add(&bar[XB_TOP], 1u);
            const unsigned tg = og / nx;
            if (og + 1u == (tg + 1u) * nx) xb_add(&bar[XB_TOPGEN], 1u);
            else XB_SPIN(xb_ld(&bar[XB_TOPGEN]) == tg, bar);
            __builtin_amdgcn_fence(__ATOMIC_ACQUIRE, "agent");
            xb_add(&bar[XB_XGEN(b.x)], 1u);
            asm volatile("s_waitcnt vmcnt(0)" ::: "memory");
        } else {
            XB_SPIN(xb_ld(&bar[XB_XGEN(b.x)]) == gen, bar);
            __builtin_amdgcn_fence(__ATOMIC_ACQUIRE, "agent");
            asm volatile("s_waitcnt vmcnt(0)" ::: "memory");
        }
    }
    __syncthreads();
}

constexpr int MK_THREADS = 512, MK_LDS = 155648, MK_MISC_OFF = 147456, MK_MOE_OFF = 147456 + 256;
struct MkArgs { const float* in[20]; float* out; unsigned char* ws; int ph_lo, ph_hi; };
typedef float f32x4 __attribute__((ext_vector_type(4)));
typedef unsigned u32x4 __attribute__((ext_vector_type(4)));
typedef unsigned u32x2 __attribute__((ext_vector_type(2)));
#define LDS_WAIT() asm volatile("s_waitcnt lgkmcnt(0)" ::: "memory")
__device__ __forceinline__ unsigned pk2(float lo, float hi) { return (unsigned)f2bf(lo) | ((unsigned)f2bf(hi) << 16); }
__device__ __forceinline__ float wave_sum(float v) {
#pragma unroll
    for (int o = 1; o < 64; o <<= 1) v += __shfl_xor(v, o);
    return v;
}

constexpr int TR_SCR = 64 * 68 * 4;
template <class RowMap>
__device__ __forceinline__ void tr_item(const float* __restrict__ W, int K, int N, bf16_t* __restrict__ WT, LAS float* scr, int item, int lane, const float* __restrict__ kscale, RowMap rm) {
    const int nblk = (N + 63) / 64, kb = item / nblk, nb = item % nblk, k0 = 64 * kb, n0 = 64 * nb;
    const int n4 = lane & 15, ks = lane >> 4, nn = n0 + 4 * n4;
    f32x4 v[16];
    if (nn + 3 < N) {
#pragma unroll
        for (int i = 0; i < 16; ++i) v[i] = *(const f32x4*)(W + (size_t)(k0 + 4 * i + ks) * N + nn);
    } else {
#pragma unroll
        for (int i = 0; i < 16; ++i) { const float* p = W + (size_t)(k0 + 4 * i + ks) * N; v[i] = (f32x4){nn < N ? p[nn] : 0.f, nn + 1 < N ? p[nn + 1] : 0.f, nn + 2 < N ? p[nn + 2] : 0.f, 0.f}; }
    }
#pragma unroll
    for (int i = 0; i < 16; ++i) { f32x4 x = v[i]; if (kscale) x = x * kscale[k0 + 4 * i + ks]; *(LAS f32x4*)(scr + (4 * i + ks) * 68 + 4 * n4) = x; }
    LDS_WAIT(); asm volatile("" ::: "memory");
    const int n = n0 + lane;
    float sc = 1.f; int r = 0;
    if (n < N) r = rm(n, sc);
#pragma unroll
    for (int j = 0; j < 8; ++j) {
        const LAS float* s = scr + (8 * j) * 68 + lane;
        u32x4 o; o.x = pk2(s[0 * 68] * sc, s[1 * 68] * sc); o.y = pk2(s[2 * 68] * sc, s[3 * 68] * sc); o.z = pk2(s[4 * 68] * sc, s[5 * 68] * sc); o.w = pk2(s[6 * 68] * sc, s[7 * 68] * sc);
        if (n < N) *(u32x4*)(WT + (size_t)r * K + k0 + 8 * j) = o;
    }
    LDS_WAIT(); asm volatile("" ::: "memory");
}

__device__ __forceinline__ void p0_prep(const MkArgs& a, LAS unsigned char* lds) {
    const int tid = threadIdx.x, lane = tid & 63, wave = __builtin_amdgcn_readfirstlane(tid >> 6);
    const float* c = a.in[1]; const float* w_mod = a.in[2];
    float* MODP = (float*)(a.ws + WS_MODP);
    LAS float* s_c = (LAS float*)lds;
    for (int item = blockIdx.x; item < 256; item += gridDim.x) {
        const int kc = item >> 3, cc = item & 7;
        __syncthreads();
        if (tid < 256) { const int b = tid >> 6, k = tid & 63; s_c[tid] = silu_f(c[b * D + kc * 64 + k]); }
        __syncthreads();
        float acc[4][3];
#pragma unroll
        for (int b = 0; b < 4; ++b)
#pragma unroll
            for (int j = 0; j < 3; ++j) acc[b][j] = 0.f;
        const int col0 = cc * 1536 + tid;
        for (int k0 = 0; k0 < 64; k0 += 16) {
            float w0[16], w1[16], w2[16];
#pragma unroll
            for (int k = 0; k < 16; ++k) { const float* wr = w_mod + (size_t)(kc * 64 + k0 + k) * NMOD + col0; w0[k] = wr[0]; w1[k] = wr[512]; w2[k] = wr[1024]; }
#pragma unroll
            for (int k = 0; k < 16; ++k)
#pragma unroll
                for (int b = 0; b < 4; ++b) { const float sv = s_c[b * 64 + k0 + k]; acc[b][0] += sv * w0[k]; acc[b][1] += sv * w1[k]; acc[b][2] += sv * w2[k]; }
        }
#pragma unroll
        for (int b = 0; b < 4; ++b)
#pragma unroll
            for (int j = 0; j < 3; ++j) MODP[(size_t)(kc * 4 + b) * NMOD + col0 + 512 * j] = acc[b][j];
    }
    __syncthreads();
    LAS float* scr = (LAS float*)(lds + wave * TR_SCR);
    const int gw = blockIdx.x * 8 + wave, NGW = gridDim.x * 8;
    constexpr int I_IN = 32 * 62, I_QUP = 8 * 32, I_OUT = 32 * 32;
    bf16_t* Wt_in = (bf16_t*)(a.ws + WS_WTIN); bf16_t* Wt_qup = (bf16_t*)(a.ws + WS_WTQUP); bf16_t* Wt_out = (bf16_t*)(a.ws + WS_WTOUT);
    for (int it = gw; it < I_IN + I_QUP + I_OUT; it += NGW) {
        int r = it;
        if (r < I_IN) { tr_item(a.in[5], D, DIN, Wt_in, scr, r, lane, (const float*)nullptr, [](int n, float& sc) { if (n >= 832 && n < 848) sc = 0.25f; else if (n >= 848 && n < 1872) sc = 0.08838834764831845f; return n < 848 ? n : n + 176; }); continue; }
        r -= I_IN;
        if (r < I_QUP) { tr_item(a.in[7], 512, 2048, Wt_qup, scr, r, lane, a.in[6], [](int n, float& sc) { if (n >= 1024) sc = 0.125f; return n; }); continue; }
        r -= I_QUP;
        tr_item(a.in[13], D, D, Wt_out, scr, r, lane, (const float*)nullptr, [](int n, float& sc) { return n; });
    }
    {
        bf16_t* Wt_gu = (bf16_t*)(a.ws + WS_WTGU); bf16_t* Wt_dn = (bf16_t*)(a.ws + WS_WTDN);
        for (int it = gw; it < 32 * 768; it += NGW) {
            const int e = it / 768; int r = it % 768;
            if (r < 256) { tr_item(a.in[17] + (size_t)e * D * 512, D, 512, Wt_gu + (size_t)e * 1024 * D, scr, r, lane, (const float*)nullptr, [](int n, float& sc) { return 8 * (n >> 2) + (n & 3); }); continue; }
            r -= 256;
            if (r < 256) { tr_item(a.in[18] + (size_t)e * D * 512, D, 512, Wt_gu + (size_t)e * 1024 * D, scr, r, lane, (const float*)nullptr, [](int n, float& sc) { return 8 * (n >> 2) + 4 + (n & 3); }); continue; }
            r -= 256;
            tr_item(a.in[19] + (size_t)e * 512 * D, 512, D, Wt_dn + (size_t)e * D * 512, scr, r, lane, (const float*)nullptr, [](int n, float& sc) { return n; });
        }
        bf16_t* RT = (bf16_t*)(a.ws + WS_RT); const float* rg = a.in[15]; const float* re = a.in[16];
        for (int i = blockIdx.x * MK_THREADS + tid; i < 48 * D; i += gridDim.x * MK_THREADS) { const int o = i >> 11, k = i & 2047; RT[i] = f2bf(o < 4 ? rg[k * 4 + o] : (o < 36 ? re[k * 32 + (o - 4)] : 0.f)); }
    }
    u32x4* z = (u32x4*)(Wt_in + (size_t)848 * D);
    for (int i = blockIdx.x * MK_THREADS + tid; i < 176 * 256; i += gridDim.x * MK_THREADS) z[i] = (u32x4){0u, 0u, 0u, 0u};
}

__device__ __forceinline__ void p1_xn(const MkArgs& a, LAS unsigned char* lds) {
    const int tid = threadIdx.x, lane = tid & 63, wave = __builtin_amdgcn_readfirstlane(tid >> 6);
    const float* x = a.in[0]; const float* b_mod = a.in[3]; const float* ln1_g = a.in[4];
    const float* MODP = (const float*)(a.ws + WS_MODP); float* MOD = (float*)(a.ws + WS_MOD); bf16_t* XN = (bf16_t*)(a.ws + WS_XN);
    LAS float* s_gs = (LAS float*)lds; LAS float* s_sh = s_gs + D;
    for (int i = blockIdx.x * MK_THREADS + tid; i < NB * NMOD; i += gridDim.x * MK_THREADS) {
        const int b = i / NMOD, n = i % NMOD; float s = b_mod[n];
        for (int kc = 0; kc < 32; ++kc) s += MODP[(size_t)(kc * 4 + b) * NMOD + n];
        MOD[i] = s;
    }
    for (int chunk = blockIdx.x; chunk < M / 64; chunk += gridDim.x) {
        const int b = chunk >> 6;
        __syncthreads();
        for (int k = tid; k < D; k += MK_THREADS) {
            float sh = b_mod[k], sc = b_mod[D + k];
            for (int kc = 0; kc < 32; ++kc) { sh += MODP[(size_t)(kc * 4 + b) * NMOD + k]; sc += MODP[(size_t)(kc * 4 + b) * NMOD + D + k]; }
            s_sh[k] = sh; s_gs[k] = ln1_g[k] * (1.f + sc);
        }
        __syncthreads();
        f32x4 v[8], vn[8];
        { const f32x4* xr = (const f32x4*)(x + (size_t)(chunk * 64 + wave) * D) + lane;
#pragma unroll
          for (int j = 0; j < 8; ++j) v[j] = xr[64 * j]; }
        for (int r = wave; r < 64; r += 8) {
            const int m = chunk * 64 + r;
            if (r + 8 < 64) { const f32x4* xn = (const f32x4*)(x + (size_t)(m + 8) * D) + lane;
#pragma unroll
                for (int j = 0; j < 8; ++j) vn[j] = xn[64 * j]; }
            float ss = 0.f;
#pragma unroll
            for (int j = 0; j < 8; ++j) ss += (v[j].x * v[j].x + v[j].y * v[j].y) + (v[j].z * v[j].z + v[j].w * v[j].w);
            const float rstd = rsqrtf(wave_sum(ss) * (1.f / D) + EPS);
            u32x2* o8 = (u32x2*)(XN + (size_t)m * D) + lane;
#pragma unroll
            for (int j = 0; j < 8; ++j) { const int k = 4 * (lane + 64 * j); const f32x4 gs = *(const LAS f32x4*)(s_gs + k), sh = *(const LAS f32x4*)(s_sh + k);
                const f32x4 y = v[j] * rstd * gs + sh; u32x2 w; w.x = pk2(y.x, y.y); w.y = pk2(y.z, y.w); o8[64 * j] = w; }
#pragma unroll
            for (int j = 0; j < 8; ++j) v[j] = vn[j];
        }
    }
}

struct EpiInProj {
    static constexpr bool PERM = true;
    bf16_t* B0; bf16_t* QB; bf16_t* KB; bf16_t* VB; float* SSQ;
    __device__ __forceinline__ void operator()(const pg8::f32x4 (&acc)[2][2][4][2], const pg8::Unit& u, int wr, int wc, int fr, int fq) const {
        if (u.dup) return;
        const int t = u.pn >> 2; bf16_t* base = t == 0 ? B0 : (t == 1 ? QB : (t == 2 ? KB : VB));
        const int row0 = u.pm * 256 + wr * 64 + fr, col0 = (u.pn & 3) * 256 + wc * 32 + 8 * fq;
#pragma unroll
        for (int ai = 0; ai < 2; ++ai)
#pragma unroll
            for (int m = 0; m < 4; ++m) { const int row = row0 + ai * 128 + m * 16; bf16_t* rowp = base + (size_t)row * 1024 + col0; float ss = 0.f;
#pragma unroll
                for (int bj = 0; bj < 2; ++bj) { const pg8::f32x4 v0 = acc[ai][bj][m][0], v1 = acc[ai][bj][m][1];
                    ss += (v0[0] * v0[0] + v0[1] * v0[1]) + (v0[2] * v0[2] + v0[3] * v0[3]) + (v1[0] * v1[0] + v1[1] * v1[1]) + (v1[2] * v1[2] + v1[3] * v1[3]);
                    pg8::u32x4 w; w.x = pg8::cvt_pk_bf16(v0[0], v0[1]); w.y = pg8::cvt_pk_bf16(v0[2], v0[3]); w.z = pg8::cvt_pk_bf16(v1[0], v1[1]); w.w = pg8::cvt_pk_bf16(v1[2], v1[3]);
                    *(pg8::u32x4*)(rowp + bj * 128) = w; }
                if (u.pn < 2) { ss += __shfl_xor(ss, 16); ss += __shfl_xor(ss, 32); if (fq == 0) SSQ[(size_t)row * 8 + u.pn * 4 + wc] = ss; } }
    }
};


struct EpiQupG {
    static constexpr bool PERM = true;
    const float* SSQ; bf16_t* QA; bf16_t* QI;
    __device__ __forceinline__ void operator()(const pg8::f32x4 (&acc)[2][2][4][2], const pg8::Unit& u, int wr, int wc, int fr, int fq) const {
        if (u.dup) return;
        bf16_t* base = (u.pn >> 2) ? QI : QA;
        const int row0 = u.pm * 256 + wr * 64 + fr, col0 = (u.pn & 3) * 256 + wc * 32 + 8 * fq;
#pragma unroll
        for (int ai = 0; ai < 2; ++ai)
#pragma unroll
            for (int m = 0; m < 4; ++m) { const int row = row0 + ai * 128 + m * 16; bf16_t* rowp = base + (size_t)row * 1024 + col0;
                const pg8::f32x4 s0 = *(const pg8::f32x4*)(SSQ + (size_t)row * 8), s1 = *(const pg8::f32x4*)(SSQ + (size_t)row * 8 + 4);
                const float rs = rsqrtf(((s0[0] + s0[1]) + (s0[2] + s0[3]) + (s1[0] + s1[1]) + (s1[2] + s1[3])) * (1.f / 512.f) + EPS);
#pragma unroll
                for (int bj = 0; bj < 2; ++bj) { const pg8::f32x4 v0 = acc[ai][bj][m][0] * rs, v1 = acc[ai][bj][m][1] * rs;
                    pg8::u32x4 w; w.x = pg8::cvt_pk_bf16(v0[0], v0[1]); w.y = pg8::cvt_pk_bf16(v0[2], v0[3]); w.z = pg8::cvt_pk_bf16(v1[0], v1[1]); w.w = pg8::cvt_pk_bf16(v1[2], v1[3]);
                    *(pg8::u32x4*)(rowp + bj * 128) = w; } }
    }
};
struct EpiOutProj {
    static constexpr bool PERM = true;
    const float* x; const float* MOD; bf16_t* X1B;
    __device__ __forceinline__ void operator()(const pg8::f32x4 (&acc)[2][2][4][2], const pg8::Unit& u, int wr, int wc, int fr, int fq) const {
        if (u.dup) return;
        const int b = (u.pm * 256) >> 12;
        const int row0 = u.pm * 256 + wr * 64 + fr, col0 = u.pn * 256 + wc * 32 + 8 * fq;
        const float* gp = MOD + (size_t)b * NMOD + 2 * D + col0;
        pg8::f32x4 g[2][2];
#pragma unroll
        for (int bj = 0; bj < 2; ++bj) { g[bj][0] = *(const pg8::f32x4*)(gp + bj * 128); g[bj][1] = *(const pg8::f32x4*)(gp + bj * 128 + 4); }
#pragma unroll
        for (int ai = 0; ai < 2; ++ai)
#pragma unroll
            for (int m = 0; m < 4; ++m) { const size_t off = (size_t)(row0 + ai * 128 + m * 16) * D + col0;
#pragma unroll
                for (int bj = 0; bj < 2; ++bj) { const pg8::f32x4 x0 = *(const pg8::f32x4*)(x + off + bj * 128), x1 = *(const pg8::f32x4*)(x + off + bj * 128 + 4);
                    const pg8::f32x4 o0 = x0 + g[bj][0] * acc[ai][bj][m][0], o1 = x1 + g[bj][1] * acc[ai][bj][m][1];
                    pg8::u32x4 w; w.x = pg8::cvt_pk_bf16(o0[0], o0[1]); w.y = pg8::cvt_pk_bf16(o0[2], o0[3]); w.z = pg8::cvt_pk_bf16(o1[0], o1[1]); w.w = pg8::cvt_pk_bf16(o1[2], o1[3]);
                    *(pg8::u32x4*)(X1B + off + bj * 128) = w; } }
    }
};
__device__ __forceinline__ void kanorm_pass(const MkArgs& a) {
    const int tid = threadIdx.x, lane = tid & 63, wave = __builtin_amdgcn_readfirstlane(tid >> 6);
    bf16_t* B0 = (bf16_t*)(a.ws + WS_B0); const float* k_gain = a.in[9]; unsigned char* KV8 = a.ws + WS_KV8;
    const float g0 = k_gain[2 * lane], g1 = k_gain[2 * lane + 1];
    for (int m = blockIdx.x * 8 + wave; m < M; m += gridDim.x * 8) {
        unsigned* p = (unsigned*)(B0 + (size_t)m * 1024 + 512) + lane;
        const unsigned v = *p, vv = p[64];
        const float k0 = __uint_as_float(v << 16), k1 = __uint_as_float(v & 0xffff0000u);
        const float rs = rsqrtf(wave_sum(k0 * k0 + k1 * k1) * (1.f / 128.f) + EPS);
        const float n0 = k0 * rs * g0, n1 = k1 * rs * g1;
        *p = pk2(n0, n1);
        const int pk = __builtin_amdgcn_cvt_pk_fp8_f32(n0, n1, 0, false);
        const int pv = __builtin_amdgcn_cvt_pk_fp8_f32(__uint_as_float(vv << 16), __uint_as_float(vv & 0xffff0000u), 0, false);
        unsigned short* q = (unsigned short*)(KV8 + (size_t)m * 256) + lane;
        q[0] = (unsigned short)pk; q[64] = (unsigned short)pv;
    }
}
typedef short bf16x8_t __attribute__((ext_vector_type(8)));
__device__ __forceinline__ void p8_route(const MkArgs& a, LAS unsigned char* lds) {
    const int tid = threadIdx.x, lane = tid & 63, wave = __builtin_amdgcn_readfirstlane(tid >> 6);
    const bf16_t* X1B = (const bf16_t*)(a.ws + WS_X1B); const float* ln2_g = a.in[14]; const float* MOD = (const float*)(a.ws + WS_MOD);
    bf16_t* H2 = (bf16_t*)(a.ws + WS_XN); const bf16_t* RT = (const bf16_t*)(a.ws + WS_RT);
    int* EID = (int*)(a.ws + WS_EID); float* GW = (float*)(a.ws + WS_GW);
    unsigned* cnt = (unsigned*)(a.ws + WS_CTL) + CW_CNT; int* list = (int*)(a.ws + WS_LIST);
    constexpr int RS = 4112;
    LAS float* s_part = (LAS float*)lds;
    LAS float* s_lg = (LAS float*)(lds + 49152);
    for (int item = blockIdx.x; item < M / 32; item += gridDim.x) {
        const int m0 = item * 32, b = m0 >> 12;
        const float* mb = MOD + (size_t)b * NMOD;
        __syncthreads();
        u32x2 xb[4][8];
#pragma unroll
        for (int rr = 0; rr < 4; ++rr) { const u32x2* xr = (const u32x2*)(X1B + (size_t)(m0 + wave * 4 + rr) * D) + lane;
#pragma unroll
            for (int j = 0; j < 8; ++j) xb[rr][j] = xr[64 * j]; }
#pragma unroll
        for (int rr = 0; rr < 4; ++rr) {
            const int r = wave * 4 + rr, m = m0 + r;
            f32x4 v[8]; float ss = 0.f;
#pragma unroll
            for (int j = 0; j < 8; ++j) { v[j] = (f32x4){__uint_as_float(xb[rr][j].x << 16), __uint_as_float(xb[rr][j].x & 0xffff0000u), __uint_as_float(xb[rr][j].y << 16), __uint_as_float(xb[rr][j].y & 0xffff0000u)};
                ss += (v[j].x * v[j].x + v[j].y * v[j].y) + (v[j].z * v[j].z + v[j].w * v[j].w); }
            const float rstd = rsqrtf(wave_sum(ss) * (1.f / D) + EPS);
            u32x2* o8 = (u32x2*)(H2 + (size_t)m * D) + lane;
#pragma unroll
            for (int j = 0; j < 8; ++j) { const int k = 4 * (lane + 64 * j);
                const f32x4 g = *(const f32x4*)(ln2_g + k), sc = *(const f32x4*)(mb + 4 * D + k), sh = *(const f32x4*)(mb + 3 * D + k);
                const f32x4 y = v[j] * rstd * g * (sc + 1.f) + sh; u32x2 w; w.x = pk2(y.x, y.y); w.y = pk2(y.z, y.w); o8[64 * j] = w;
                *(LAS u32x2*)(lds + r * RS + k * 2) = w; }
        }
        __syncthreads();
        f32x4 acc[2][3];
#pragma unroll
        for (int rt = 0; rt < 2; ++rt)
#pragma unroll
            for (int ct = 0; ct < 3; ++ct) acc[rt][ct] = (f32x4){0.f, 0.f, 0.f, 0.f};
        const int fr = lane & 15, fq = lane >> 4;
#pragma unroll 2
        for (int kk = 0; kk < 8; ++kk) {
            const int k0 = 32 * (wave * 8 + kk) + 8 * fq;
            bf16x8_t af[2], bfr[3];
#pragma unroll
            for (int rt = 0; rt < 2; ++rt) af[rt] = *(const LAS bf16x8_t*)(lds + (16 * rt + fr) * RS + k0 * 2);
#pragma unroll
            for (int ct = 0; ct < 3; ++ct) bfr[ct] = *(const bf16x8_t*)(RT + (size_t)(16 * ct + fr) * D + k0);
#pragma unroll
            for (int rt = 0; rt < 2; ++rt)
#pragma unroll
                for (int ct = 0; ct < 3; ++ct) acc[rt][ct] = __builtin_amdgcn_mfma_f32_16x16x32_bf16(af[rt], bfr[ct], acc[rt][ct], 0, 0, 0);
        }
        __syncthreads();
#pragma unroll
        for (int rt = 0; rt < 2; ++rt)
#pragma unroll
            for (int ct = 0; ct < 3; ++ct)
#pragma unroll
                for (int i = 0; i < 4; ++i) s_part[(wave * 32 + 16 * rt + 4 * fq + i) * 48 + 16 * ct + fr] = acc[rt][ct][i];
        __syncthreads();
        for (int i = tid; i < 32 * 36; i += MK_THREADS) { const int r = i / 36, o = i % 36; float s = 0.f;
#pragma unroll
            for (int w = 0; w < 8; ++w) s += s_part[(w * 32 + r) * 48 + o];
            s_lg[i] = s; }
        __syncthreads();
        if (tid < 32) {
            const LAS float* lg = s_lg + tid * 36; const int m = m0 + tid;
            int gi = 0; float gm = lg[0];
            for (int i = 1; i < 4; ++i) if (lg[i] > gm) { gm = lg[i]; gi = i; }
            float gs = 0.f;
            for (int i = 0; i < 4; ++i) gs += __expf(lg[i] - gm);
            const float gw = 1.f / gs;
            const LAS float* le = lg + 4 + gi * 8;
            float em = le[0];
            for (int i = 1; i < 8; ++i) em = fmaxf(em, le[i]);
            float es = 0.f;
            for (int i = 0; i < 8; ++i) es += __expf(le[i] - em);
            int i0 = 0; float p0 = -1.f;
            for (int i = 0; i < 8; ++i) { const float p = __expf(le[i] - em) / es; if (p > p0) { p0 = p; i0 = i; } }
            int i1 = 0; float p1 = -1.f;
            for (int i = 0; i < 8; ++i) { const float p = __expf(le[i] - em) / es; if (i != i0 && p > p1) { p1 = p; i1 = i; } }
            const float den = p0 + p1;
            const int e0 = gi * 8 + i0, e1 = gi * 8 + i1;
            GW[m * 2] = gw * p0 / den; GW[m * 2 + 1] = gw * p1 / den;
            const unsigned q0 = __hip_atomic_fetch_add(cnt + 32 * e0, 1u, __ATOMIC_RELAXED, __HIP_MEMORY_SCOPE_AGENT);
            const unsigned q1 = __hip_atomic_fetch_add(cnt + 32 * (32 + e1), 1u, __ATOMIC_RELAXED, __HIP_MEMORY_SCOPE_AGENT);
            EID[m * 2] = (e0 << 16) | (int)q0; EID[m * 2 + 1] = (e1 << 16) | (int)q1;
            list[(size_t)e0 * 16384 + q0] = m; list[(size_t)(32 + e1) * 16384 + q1] = m;
        }
    }
}

__device__ __forceinline__ int rfl(int v) { return __builtin_amdgcn_readfirstlane(v); }
struct MoeTab { LAS int* tsm; LAS int* c0; LAS int* c1; LAS int* ts0; LAS int* ts1; };
__device__ __forceinline__ MoeTab moe_tab_build(const MkArgs& a, LAS unsigned char* lds) {
    MoeTab t; LAS int* p = (LAS int*)(lds + MK_MOE_OFF); t.tsm = p; t.c0 = p + 40; t.c1 = p + 80; t.ts0 = p + 120; t.ts1 = p + 160;
    const unsigned* cnt = (const unsigned*)(a.ws + WS_CTL) + CW_CNT;
    __syncthreads();
    if (threadIdx.x == 0) {
        int am = 0, a0 = 0, a1 = 0;
        for (int e = 0; e < 32; ++e) { const int n0 = (int)__hip_atomic_load(cnt + 32 * e, __ATOMIC_RELAXED, __HIP_MEMORY_SCOPE_AGENT), n1 = (int)__hip_atomic_load(cnt + 32 * (32 + e), __ATOMIC_RELAXED, __HIP_MEMORY_SCOPE_AGENT);
            t.c0[e] = n0; t.c1[e] = n1; t.tsm[e] = am; t.ts0[e] = a0; t.ts1[e] = a1; am += (n0 + n1 + 255) >> 8; a0 += (n0 + 255) >> 8; a1 += (n1 + 255) >> 8; }
        t.tsm[32] = am; t.ts0[32] = a0; t.ts1[32] = a1;
    }
    __syncthreads();
    return t;
}
struct SchedGU {
    MoeTab t; const int* list; const char* H2; const char* Wt; int G, c, nunit, ndup; int R[2], C[2];
    __device__ void init(const MoeTab& t_, const MkArgs& a, int G_, int c_, int ndup_ = 1) { ndup = ndup_; t = t_; list = (const int*)(a.ws + WS_LIST); H2 = (const char*)(a.ws + WS_XN); Wt = (const char*)(a.ws + WS_WTGU); G = G_; c = c_; nunit = rfl(t.tsm[32]) * 4;
#pragma unroll
        for (int i = 0; i < 2; ++i) pg8::stage_rc((int)threadIdx.x * 16 + i * 8192, R[i], C[i]); }
    __device__ bool next(int i, pg8::Unit& u) const {
        const int L0 = i * G + c; if (L0 >= nunit * ndup) return false;
        const int L = L0 % nunit; u.dup = L0 / nunit;
        const int mt = L >> 2, pn = L & 3; int e = 0;
        for (int j = 1; j < 32; ++j) e += (mt >= t.tsm[j]) ? 1 : 0;
        e = rfl(e);
        u.pm = mt; u.pn = pn; u.aux = e; u.a = H2; u.b = Wt + ((size_t)(e * 1024 + pn * 256) * D) * 2;
        const int n0 = rfl(t.c0[e]), n1 = rfl(t.c1[e]), rb = (mt - rfl(t.tsm[e])) * 256;
#pragma unroll
        for (int h = 0; h < 2; ++h)
#pragma unroll
            for (int j = 0; j < 2; ++j) { const int r = rb + h * 128 + R[j]; int tok = 0;
                if (r < n0) tok = list[(size_t)e * 16384 + r]; else if (r - n0 < n1) tok = list[(size_t)(32 + e) * 16384 + (r - n0)];
                u.va[h][j] = (unsigned)(tok * D + C[j]) * 2u; }
        return true;
    }
};
struct EpiGU {
    static constexpr bool PERM = true;
    bf16_t* U;
    __device__ __forceinline__ void operator()(const pg8::f32x4 (&acc)[2][2][4][2], const pg8::Unit& u, int wr, int wc, int fr, int fq) const {
        if (u.dup) return;
        const int row0 = u.pm * 256 + wr * 64 + fr, j0 = u.pn * 128 + wc * 16 + 4 * fq;
#pragma unroll
        for (int ai = 0; ai < 2; ++ai)
#pragma unroll
            for (int m = 0; m < 4; ++m) { bf16_t* rowp = U + (size_t)(row0 + ai * 128 + m * 16) * 512 + j0;
#pragma unroll
                for (int bj = 0; bj < 2; ++bj) { const pg8::f32x4 gv = acc[ai][bj][m][0], uv = acc[ai][bj][m][1]; float o[4];
#pragma unroll
                    for (int i = 0; i < 4; ++i) o[i] = gv[i] / (1.f + __expf(-gv[i])) * uv[i];
                    u32x2 w; w.x = pg8::cvt_pk_bf16(o[0], o[1]); w.y = pg8::cvt_pk_bf16(o[2], o[3]); *(u32x2*)(rowp + bj * 64) = w; } }
    }
};
struct SchedDN {
    MoeTab t; const char* U; const char* Wt; int G, c, nunit, ndup; unsigned vb[2][2];
    __device__ void init(const MoeTab& t_, const MkArgs& a, int G_, int c_, int ndup_ = 1) { ndup = ndup_; t = t_; U = (const char*)(a.ws + WS_U); Wt = (const char*)(a.ws + WS_WTDN); G = G_; c = c_; nunit = rfl(t.tsm[32]) * 8;
#pragma unroll
        for (int i = 0; i < 2; ++i) { int R, C; pg8::stage_rc((int)threadIdx.x * 16 + i * 8192, R, C); vb[0][i] = (unsigned)(R * 512 + C) * 2u; vb[1][i] = (unsigned)((128 + R) * 512 + C) * 2u; } }
    __device__ bool next(int i, pg8::Unit& u) const {
        const int L0 = i * G + c; if (L0 >= nunit * ndup) return false;
        const int L = L0 % nunit; u.dup = L0 / nunit;
        const int mt = L >> 3, pn = L & 7; int e = 0;
        for (int j = 1; j < 32; ++j) e += (mt >= t.tsm[j]) ? 1 : 0;
        e = rfl(e);
        u.pm = mt; u.pn = pn; u.aux = e;
        u.a = U + ((size_t)mt * 256 * 512) * 2; u.b = Wt + ((size_t)(e * D + pn * 256) * 512) * 2;
        u.va[0][0] = vb[0][0]; u.va[0][1] = vb[0][1]; u.va[1][0] = vb[1][0]; u.va[1][1] = vb[1][1];
        return true;
    }
};
struct EpiY {
    static constexpr bool PERM = true;
    bf16_t* Y;
    __device__ __forceinline__ void operator()(const pg8::f32x4 (&acc)[2][2][4][2], const pg8::Unit& u, int wr, int wc, int fr, int fq) const {
        if (u.dup) return;
        const int row0 = u.pm * 256 + wr * 64 + fr, col0 = u.pn * 256 + wc * 32 + 8 * fq;
#pragma unroll
        for (int ai = 0; ai < 2; ++ai)
#pragma unroll
            for (int m = 0; m < 4; ++m) { bf16_t* rowp = Y + (size_t)(row0 + ai * 128 + m * 16) * D + col0;
#pragma unroll
                for (int bj = 0; bj < 2; ++bj) { const pg8::f32x4 v0 = acc[ai][bj][m][0], v1 = acc[ai][bj][m][1];
                    pg8::u32x4 w; w.x = pg8::cvt_pk_bf16(v0[0], v0[1]); w.y = pg8::cvt_pk_bf16(v0[2], v0[3]); w.z = pg8::cvt_pk_bf16(v1[0], v1[1]); w.w = pg8::cvt_pk_bf16(v1[2], v1[3]);
                    *(pg8::u32x4*)(rowp + bj * 128) = w; } }
    }
};
__device__ __forceinline__ void p11_combine(const MkArgs& a, const MoeTab& t) {
    const int tid = threadIdx.x, lane = tid & 63, wave = __builtin_amdgcn_readfirstlane(tid >> 6);
    const bf16_t* Y = (const bf16_t*)(a.ws + WS_Y); const bf16_t* X1B = (const bf16_t*)(a.ws + WS_X1B); const int* POSL = (const int*)(a.ws + WS_EID); const float* GW = (const float*)(a.ws + WS_GW); const float* MOD = (const float*)(a.ws + WS_MOD);
    for (int m = blockIdx.x * 8 + wave; m < M; m += gridDim.x * 8) {
        const int p0 = rfl(POSL[m * 2]), p1 = rfl(POSL[m * 2 + 1]);
        const int e0 = p0 >> 16, e1 = p1 >> 16;
        const size_t r0 = (size_t)rfl(t.tsm[e0]) * 256 + (p0 & 0xffff), r1 = (size_t)rfl(t.tsm[e1]) * 256 + rfl(t.c0[e1]) + (p1 & 0xffff);
        const float w0 = GW[m * 2], w1 = GW[m * 2 + 1];
        const float* gp = MOD + (size_t)(m >> 12) * NMOD + 5 * D;
        float* op = a.out + (size_t)m * D;
        u32x4 y0[4], y1[4], xb[4];
#pragma unroll
        for (int j = 0; j < 4; ++j) { const int c = 8 * (lane + 64 * j); y0[j] = *(const u32x4*)(Y + r0 * D + c); y1[j] = *(const u32x4*)(Y + r1 * D + c); xb[j] = *(const u32x4*)(X1B + (size_t)m * D + c); }
#pragma unroll
        for (int j = 0; j < 4; ++j) { const int c = 8 * (lane + 64 * j);
            const f32x4 g0 = *(const f32x4*)(gp + c), g1 = *(const f32x4*)(gp + c + 4);
            f32x4 s0, s1;
#pragma unroll
            for (int q = 0; q < 2; ++q) { s0[2 * q] = w0 * __uint_as_float(y0[j][q] << 16) + w1 * __uint_as_float(y1[j][q] << 16); s0[2 * q + 1] = w0 * __uint_as_float(y0[j][q] & 0xffff0000u) + w1 * __uint_as_float(y1[j][q] & 0xffff0000u);
                s1[2 * q] = w0 * __uint_as_float(y0[j][2 + q] << 16) + w1 * __uint_as_float(y1[j][2 + q] << 16); s1[2 * q + 1] = w0 * __uint_as_float(y0[j][2 + q] & 0xffff0000u) + w1 * __uint_as_float(y1[j][2 + q] & 0xffff0000u); }
            const f32x4 x0 = (f32x4){__uint_as_float(xb[j][0] << 16), __uint_as_float(xb[j][0] & 0xffff0000u), __uint_as_float(xb[j][1] << 16), __uint_as_float(xb[j][1] & 0xffff0000u)};
            const f32x4 x1 = (f32x4){__uint_as_float(xb[j][2] << 16), __uint_as_float(xb[j][2] & 0xffff0000u), __uint_as_float(xb[j][3] << 16), __uint_as_float(xb[j][3] & 0xffff0000u)};
            *(f32x4*)(op + c) = x0 + g0 * s0; *(f32x4*)(op + c + 4) = x1 + g1 * s1; }
    }
}
typedef float f32x16 __attribute__((ext_vector_type(16)));
typedef short s16x4 __attribute__((ext_vector_type(4)));
__device__ __forceinline__ s16x4 tr_read(unsigned lds_addr) { s16x4 r; asm volatile("ds_read_b64_tr_b16 %0, %1\n\ts_waitcnt lgkmcnt(0)" : "=&v"(r) : "v"(lds_addr) : "memory"); return r; }
__device__ __forceinline__ unsigned off_b(unsigned row, unsigned ch) { return 256u * row + 16u * (ch ^ (((row & 3) << 2) | ((row >> 2) & 3))); }
__device__ __forceinline__ int crow(int reg, int h) { return (reg & 3) + 8 * (reg >> 2) + 4 * h; }
constexpr float SB_STOP = -104.0f;

constexpr int VT_STRIDE = 272;
__device__ __forceinline__ void tr8_sb0(unsigned addr, s16x4 (&r)[8]) {
    asm volatile(
        "ds_read_b64_tr_b16 %0, %8 offset:0\n\t"
        "ds_read_b64_tr_b16 %1, %8 offset:2176\n\t"
        "ds_read_b64_tr_b16 %2, %8 offset:4352\n\t"
        "ds_read_b64_tr_b16 %3, %8 offset:6528\n\t"
        "ds_read_b64_tr_b16 %4, %8 offset:64\n\t"
        "ds_read_b64_tr_b16 %5, %8 offset:2240\n\t"
        "ds_read_b64_tr_b16 %6, %8 offset:4416\n\t"
        "ds_read_b64_tr_b16 %7, %8 offset:6592\n\t"
        "s_waitcnt lgkmcnt(0)"
        : "=&v"(r[0]), "=&v"(r[1]), "=&v"(r[2]), "=&v"(r[3]), "=&v"(r[4]), "=&v"(r[5]), "=&v"(r[6]), "=&v"(r[7])
        : "v"(addr) : "memory");
}
__device__ __forceinline__ void tr8_sb1(unsigned addr, s16x4 (&r)[8]) {
    asm volatile(
        "ds_read_b64_tr_b16 %0, %8 offset:128\n\t"
        "ds_read_b64_tr_b16 %1, %8 offset:2304\n\t"
        "ds_read_b64_tr_b16 %2, %8 offset:4480\n\t"
        "ds_read_b64_tr_b16 %3, %8 offset:6656\n\t"
        "ds_read_b64_tr_b16 %4, %8 offset:192\n\t"
        "ds_read_b64_tr_b16 %5, %8 offset:2368\n\t"
        "ds_read_b64_tr_b16 %6, %8 offset:4544\n\t"
        "ds_read_b64_tr_b16 %7, %8 offset:6720\n\t"
        "s_waitcnt lgkmcnt(0)"
        : "=&v"(r[0]), "=&v"(r[1]), "=&v"(r[2]), "=&v"(r[3]), "=&v"(r[4]), "=&v"(r[5]), "=&v"(r[6]), "=&v"(r[7])
        : "v"(addr) : "memory");
}
__device__ __forceinline__ void tr8_dsa0(unsigned addr, s16x4 (&r)[8]) {
    asm volatile(
        "ds_read_b64_tr_b16 %0, %8 offset:0\n\t"
        "ds_read_b64_tr_b16 %1, %8 offset:4352\n\t"
        "ds_read_b64_tr_b16 %2, %8 offset:32\n\t"
        "ds_read_b64_tr_b16 %3, %8 offset:4384\n\t"
        "ds_read_b64_tr_b16 %4, %8 offset:64\n\t"
        "ds_read_b64_tr_b16 %5, %8 offset:4416\n\t"
        "ds_read_b64_tr_b16 %6, %8 offset:96\n\t"
        "ds_read_b64_tr_b16 %7, %8 offset:4448\n\t"
        "s_waitcnt lgkmcnt(0)"
        : "=&v"(r[0]), "=&v"(r[1]), "=&v"(r[2]), "=&v"(r[3]), "=&v"(r[4]), "=&v"(r[5]), "=&v"(r[6]), "=&v"(r[7])
        : "v"(addr) : "memory");
}
__device__ __forceinline__ void tr8_dsa1(unsigned addr, s16x4 (&r)[8]) {
    asm volatile(
        "ds_read_b64_tr_b16 %0, %8 offset:128\n\t"
        "ds_read_b64_tr_b16 %1, %8 offset:4480\n\t"
        "ds_read_b64_tr_b16 %2, %8 offset:160\n\t"
        "ds_read_b64_tr_b16 %3, %8 offset:4512\n\t"
        "ds_read_b64_tr_b16 %4, %8 offset:192\n\t"
        "ds_read_b64_tr_b16 %5, %8 offset:4544\n\t"
        "ds_read_b64_tr_b16 %6, %8 offset:224\n\t"
        "ds_read_b64_tr_b16 %7, %8 offset:4576\n\t"
        "s_waitcnt lgkmcnt(0)"
        : "=&v"(r[0]), "=&v"(r[1]), "=&v"(r[2]), "=&v"(r[3]), "=&v"(r[4]), "=&v"(r[5]), "=&v"(r[6]), "=&v"(r[7])
        : "v"(addr) : "memory");
}
__device__ __forceinline__ void tr16_sb(unsigned addr, s16x4 (&r)[16]) {
    asm volatile(
        "ds_read_b64_tr_b16 %0, %16 offset:0\n\t"
        "ds_read_b64_tr_b16 %1, %16 offset:2176\n\t"
        "ds_read_b64_tr_b16 %2, %16 offset:4352\n\t"
        "ds_read_b64_tr_b16 %3, %16 offset:6528\n\t"
        "ds_read_b64_tr_b16 %4, %16 offset:64\n\t"
        "ds_read_b64_tr_b16 %5, %16 offset:2240\n\t"
        "ds_read_b64_tr_b16 %6, %16 offset:4416\n\t"
        "ds_read_b64_tr_b16 %7, %16 offset:6592\n\t"
        "ds_read_b64_tr_b16 %8, %16 offset:128\n\t"
        "ds_read_b64_tr_b16 %9, %16 offset:2304\n\t"
        "ds_read_b64_tr_b16 %10, %16 offset:4480\n\t"
        "ds_read_b64_tr_b16 %11, %16 offset:6656\n\t"
        "ds_read_b64_tr_b16 %12, %16 offset:192\n\t"
        "ds_read_b64_tr_b16 %13, %16 offset:2368\n\t"
        "ds_read_b64_tr_b16 %14, %16 offset:4544\n\t"
        "ds_read_b64_tr_b16 %15, %16 offset:6720\n\t"
        "s_waitcnt lgkmcnt(0)"
        : "=&v"(r[0]), "=&v"(r[1]), "=&v"(r[2]), "=&v"(r[3]), "=&v"(r[4]), "=&v"(r[5]), "=&v"(r[6]), "=&v"(r[7]), "=&v"(r[8]), "=&v"(r[9]), "=&v"(r[10]), "=&v"(r[11]), "=&v"(r[12]), "=&v"(r[13]), "=&v"(r[14]), "=&v"(r[15])
        : "v"(addr) : "memory");
}
__device__ __forceinline__ void tr16_dsa(unsigned addr, s16x4 (&r)[16]) {
    asm volatile(
        "ds_read_b64_tr_b16 %0, %16 offset:0\n\t"
        "ds_read_b64_tr_b16 %1, %16 offset:4352\n\t"
        "ds_read_b64_tr_b16 %2, %16 offset:32\n\t"
        "ds_read_b64_tr_b16 %3, %16 offset:4384\n\t"
        "ds_read_b64_tr_b16 %4, %16 offset:64\n\t"
        "ds_read_b64_tr_b16 %5, %16 offset:4416\n\t"
        "ds_read_b64_tr_b16 %6, %16 offset:96\n\t"
        "ds_read_b64_tr_b16 %7, %16 offset:4448\n\t"
        "ds_read_b64_tr_b16 %8, %16 offset:128\n\t"
        "ds_read_b64_tr_b16 %9, %16 offset:4480\n\t"
        "ds_read_b64_tr_b16 %10, %16 offset:160\n\t"
        "ds_read_b64_tr_b16 %11, %16 offset:4512\n\t"
        "ds_read_b64_tr_b16 %12, %16 offset:192\n\t"
        "ds_read_b64_tr_b16 %13, %16 offset:4544\n\t"
        "ds_read_b64_tr_b16 %14, %16 offset:224\n\t"
        "ds_read_b64_tr_b16 %15, %16 offset:4576\n\t"
        "s_waitcnt lgkmcnt(0)"
        : "=&v"(r[0]), "=&v"(r[1]), "=&v"(r[2]), "=&v"(r[3]), "=&v"(r[4]), "=&v"(r[5]), "=&v"(r[6]), "=&v"(r[7]), "=&v"(r[8]), "=&v"(r[9]), "=&v"(r[10]), "=&v"(r[11]), "=&v"(r[12]), "=&v"(r[13]), "=&v"(r[14]), "=&v"(r[15])
        : "v"(addr) : "memory");
}
__device__ __forceinline__ void sb_wave(const bf16_t* __restrict__ QB, const bf16_t* __restrict__ KB, const bf16_t* __restrict__ VB, int b, int h, int q0, LAS unsigned char* vt, f32x16 (&o)[4]) {
    int lane = threadIdx.x & 63; asm volatile("" : "+v"(lane));
    const int r32 = lane & 31, hi = lane >> 5;
    bf16x8_t bq[8];
    { const bf16_t* qp = QB + (size_t)(b * S + q0 + r32) * 1024 + h * 128 + 64 * hi;
#pragma unroll
      for (int s = 0; s < 8; ++s) bq[s] = *(const bf16x8_t*)(qp + 8 * s); }
#pragma unroll
    for (int c = 0; c < 4; ++c)
#pragma unroll
        for (int i = 0; i < 16; ++i) o[c][i] = 0.f;
    float carry = 0.f;
    const int q16 = lane & 15, tq = q16 >> 2, tp = q16 & 3, blk = (lane >> 4) & 1;
    const unsigned traddr = (unsigned)(uintptr_t)vt + VT_STRIDE * (4 * hi + tq) + 32 * blk + 16 * (tp >> 1) + 8 * (tp & 1);
    const bf16_t* kbase = KB + (size_t)b * S * 1024 + h * 128 + 64 * hi + (size_t)r32 * 1024;
    const bf16_t* vbase = VB + (size_t)b * S * 1024 + h * 128 + (size_t)(lane >> 4) * 1024 + 8 * (lane & 15);
    bf16x8_t kf[8]; u32x4 vr[8];
    { const int kt = q0 >> 5;
#pragma unroll
      for (int s = 0; s < 8; ++s) kf[s] = *(const bf16x8_t*)(kbase + (size_t)kt * 32 * 1024 + 8 * s);
#pragma unroll
      for (int i = 0; i < 8; ++i) vr[i] = *(const u32x4*)(vbase + (size_t)(kt * 32 + 4 * i) * 1024); }
    for (int kt = q0 >> 5; kt >= 0; --kt) {
        const int k0 = kt * 32;
#pragma unroll
        for (int i = 0; i < 8; ++i) *(LAS u32x4*)(vt + (4 * i + (lane >> 4)) * VT_STRIDE + 16 * (lane & 15)) = vr[i];
        f32x16 z;
#pragma unroll
        for (int i = 0; i < 16; ++i) z[i] = 0.f;
#pragma unroll
        for (int s = 0; s < 8; ++s) z = __builtin_amdgcn_mfma_f32_32x32x16_bf16(kf[s], bq[s], z, 0, 0, 0);
        { const int kn = kt > 0 ? kt - 1 : 0;
#pragma unroll
          for (int s = 0; s < 8; ++s) kf[s] = *(const bf16x8_t*)(kbase + (size_t)kn * 32 * 1024 + 8 * s);
#pragma unroll
          for (int i = 0; i < 8; ++i) vr[i] = *(const u32x4*)(vbase + (size_t)(kn * 32 + 4 * i) * 1024); }
        const bool diag = (k0 == q0);
        float lm[16], sg[4];
#pragma unroll
        for (int g = 0; g < 4; ++g) sg[g] = 0.f;
#pragma unroll
        for (int i = 0; i < 16; ++i) { const float zz = z[i]; const float sp = fmaxf(zz, 0.f) + __logf(1.f + __expf(-fabsf(zz)));
            const bool valid = !diag || (crow(i, hi) < r32);
            lm[i] = valid ? -sp : 0.f; z[i] = valid ? (zz - sp) : -INFINITY; sg[i >> 2] += lm[i]; }
        float psg[4];
#pragma unroll
        for (int g = 0; g < 4; ++g) psg[g] = __shfl_xor(sg[g], 32);
        float aft[4];
        { float run = carry;
#pragma unroll
          for (int g = 3; g >= 0; --g) { if (hi == 0) { run += psg[g]; aft[g] = run; run += sg[g]; } else { aft[g] = run; run += sg[g]; run += psg[g]; } }
          carry = run; }
        float av[16];
#pragma unroll
        for (int g = 0; g < 4; ++g) { float run = aft[g];
#pragma unroll
            for (int r = 3; r >= 0; --r) { const int i = 4 * g + r; av[i] = __expf(z[i] + run); run += lm[i]; } }
        bf16x8_t pa[2];
#pragma unroll
        for (int s = 0; s < 2; ++s) { u32x4 p; p.x = pg8::cvt_pk_bf16(av[8 * s], av[8 * s + 1]); p.y = pg8::cvt_pk_bf16(av[8 * s + 2], av[8 * s + 3]); p.z = pg8::cvt_pk_bf16(av[8 * s + 4], av[8 * s + 5]); p.w = pg8::cvt_pk_bf16(av[8 * s + 6], av[8 * s + 7]); pa[s] = __builtin_bit_cast(bf16x8_t, p); }
        LDS_WAIT();
#pragma unroll
        for (int half = 0; half < 2; ++half) {
            s16x4 tr[8];
            if (half == 0) tr8_sb0(traddr, tr); else tr8_sb1(traddr, tr);
#pragma unroll
            for (int cc = 0; cc < 2; ++cc)
#pragma unroll
                for (int s = 0; s < 2; ++s) {
                    const bf16x8_t vf = __builtin_shufflevector(tr[(cc * 2 + s) * 2], tr[(cc * 2 + s) * 2 + 1], 0, 1, 2, 3, 4, 5, 6, 7);
                    o[2 * half + cc] = __builtin_amdgcn_mfma_f32_32x32x16_bf16(vf, pa[s], o[2 * half + cc], 0, 0, 0);
                }
        }
        if (__all(carry <= SB_STOP)) break;
    }
}
__device__ __forceinline__ void tr_read2(unsigned a0, unsigned a1, s16x4& r0, s16x4& r1) {
    asm volatile("ds_read_b64_tr_b16 %0, %2\n\tds_read_b64_tr_b16 %1, %3\n\ts_waitcnt lgkmcnt(0)" : "=&v"(r0), "=&v"(r1) : "v"(a0), "v"(a1) : "memory"); }
__device__ __forceinline__ int wave_sum_i(int v) {
    v += __builtin_amdgcn_update_dpp(0, v, 0xB1, 0xF, 0xF, true);
    v += __builtin_amdgcn_update_dpp(0, v, 0x4E, 0xF, 0xF, true);
    v += __builtin_amdgcn_update_dpp(0, v, 0x141, 0xF, 0xF, true);
    v += __builtin_amdgcn_update_dpp(0, v, 0x140, 0xF, 0xF, true);
    return __builtin_amdgcn_readlane(v, 0) + __builtin_amdgcn_readlane(v, 16) + __builtin_amdgcn_readlane(v, 32) + __builtin_amdgcn_readlane(v, 48);
}
template <int NR>
__device__ __forceinline__ void topk_row(const float* __restrict__ row, int n, LAS unsigned short* sel, int lane_in) {
    int lane = lane_in; asm volatile("" : "+v"(lane));
    unsigned key[NR];
#pragma unroll
    for (int i = 0; i < NR; ++i) { const int s = lane + 64 * i; const float v = __hip_atomic_load(row + s, __ATOMIC_RELAXED, __HIP_MEMORY_SCOPE_AGENT); key[i] = s < n ? fkey(v) : 0u; }
    unsigned T = 0u; bool exact = false;
    for (int bit = 31; bit >= 0; --bit) {
        const unsigned cand = T | (1u << bit);
        int c = 0;
#pragma unroll
        for (int i = 0; i < NR; ++i) c += (key[i] >= cand) ? 1 : 0;
        c = wave_sum_i(c);
        if (c >= 256) { T = cand; if (c == 256) { exact = true; break; } }
    }
    const unsigned long long ltm = (1ull << lane) - 1ull;
    if (exact) {
        int base = 0;
#pragma unroll
        for (int i = 0; i < NR; ++i) {
            const bool take = key[i] >= T;
            const unsigned long long mt = __ballot(take);
            if (take) sel[base + __popcll(mt & ltm)] = (unsigned short)(lane + 64 * i);
            base += __popcll(mt);
        }
    } else {
        int cg = 0;
#pragma unroll
        for (int i = 0; i < NR; ++i) cg += (key[i] > T) ? 1 : 0;
        const int need = 256 - wave_sum_i(cg);
        int base = 0, run_eq = 0;
#pragma unroll 1
        for (int i = 0; i < NR; ++i) {
            unsigned k = key[0];
#pragma unroll
            for (int q = 1; q < NR; ++q) k = (i == q) ? key[q] : k;
            const bool gt = k > T, eq = (k == T);
            const unsigned long long meq = __ballot(eq);
            const bool take = gt || (eq && (run_eq + __popcll(meq & ltm)) < need);
            const unsigned long long mt = __ballot(take);
            if (take) sel[base + __popcll(mt & ltm)] = (unsigned short)(lane + 64 * i);
            base += __popcll(mt); run_eq += __popcll(meq);
        }
    }
}
typedef float f32x2_t __attribute__((ext_vector_type(2)));
__device__ __forceinline__ void dsa_token(const unsigned char* __restrict__ KV8, const bf16_t* __restrict__ QA, const float* __restrict__ q_gain, const float* __restrict__ gn_a, bf16_t* __restrict__ O,
                                          int b, int t, int cnt, const LAS unsigned short* sel, const LAS float* s_bias, LAS unsigned char* vt) {
    int lane = threadIdx.x & 63; asm volatile("" : "+v"(lane));
    const int fr = lane & 15, g = lane >> 4, hd = fr & 7;
    const size_t m = (size_t)b * S + t;
    bf16x8_t bqa[4];
    {
        const bf16_t* qp = QA + m * 1024 + hd * 128 + 32 * g;
        float qf[32]; float ss = 0.f;
#pragma unroll
        for (int kk = 0; kk < 4; ++kk) { const u32x4 v = *(const u32x4*)(qp + 8 * kk);
#pragma unroll
            for (int j = 0; j < 4; ++j) { const unsigned w = v[j]; qf[8 * kk + 2 * j] = __uint_as_float(w << 16); qf[8 * kk + 2 * j + 1] = __uint_as_float(w & 0xffff0000u); } }
#pragma unroll
        for (int j = 0; j < 32; ++j) ss += qf[j] * qf[j];
        ss += __shfl_xor(ss, 16); ss += __shfl_xor(ss, 32);
        const float rs = (fr < 8) ? rsqrtf(ss * (1.f / 128.f) + EPS) * 0.08838834764831845f : 0.f;
        const float* gp = q_gain + 32 * g;
#pragma unroll
        for (int kk = 0; kk < 4; ++kk) { u32x4 p;
#pragma unroll
            for (int j = 0; j < 4; ++j) p[j] = pg8::cvt_pk_bf16(qf[8 * kk + 2 * j] * rs * gp[8 * kk + 2 * j], qf[8 * kk + 2 * j + 1] * rs * gp[8 * kk + 2 * j + 1]);
            bqa[kk] = __builtin_bit_cast(bf16x8_t, p); }
    }
    f32x4 lg[16];
    const unsigned char* kbase = KV8 + (size_t)b * S * 256 + 32 * g;
    u32x4 kr[8][2];
#define DSA_ISSUE_K(i, slot) do { const int s_ = sel[16 * (i) + fr]; const u32x4* kp_ = (const u32x4*)(kbase + (size_t)s_ * 256); kr[slot][0] = kp_[0]; kr[slot][1] = kp_[1]; } while (0)
#pragma unroll
    for (int i = 0; i < 8; ++i) DSA_ISSUE_K(i, i);
    asm volatile("" ::: "memory");
#pragma unroll
    for (int i = 0; i < 16; ++i) {
        f32x4 acc = (f32x4){0.f, 0.f, 0.f, 0.f};
#pragma unroll
        for (int kk = 0; kk < 4; ++kk) {
            const unsigned w0 = kr[i & 7][kk >> 1][2 * (kk & 1)], w1 = kr[i & 7][kk >> 1][2 * (kk & 1) + 1];
            const f32x2_t a0 = __builtin_amdgcn_cvt_pk_f32_fp8((int)w0, false), a1 = __builtin_amdgcn_cvt_pk_f32_fp8((int)w0, true), a2 = __builtin_amdgcn_cvt_pk_f32_fp8((int)w1, false), a3 = __builtin_amdgcn_cvt_pk_f32_fp8((int)w1, true);
            u32x4 p; p.x = pg8::cvt_pk_bf16(a0.x, a0.y); p.y = pg8::cvt_pk_bf16(a1.x, a1.y); p.z = pg8::cvt_pk_bf16(a2.x, a2.y); p.w = pg8::cvt_pk_bf16(a3.x, a3.y);
            acc = __builtin_amdgcn_mfma_f32_16x16x32_bf16(__builtin_bit_cast(bf16x8_t, p), bqa[kk], acc, 0, 0, 0);
        }
        lg[i] = acc;
        if (i + 8 < 16) DSA_ISSUE_K(i + 8, i & 7);
        asm volatile("" ::: "memory");
    }
#undef DSA_ISSUE_K
    const unsigned char* vb0 = KV8 + (size_t)b * S * 256 + 128 + 16 * (lane & 7);
    u32x4 vr[4][4];
#define DSA_ISSUE_V(ks, slot) do { _Pragma("unroll") for (int i = 0; i < 4; ++i) { const int s_ = sel[32 * (ks) + 8 * i + (lane >> 3)]; vr[slot][i] = *(const u32x4*)(vb0 + (size_t)s_ * 256); } } while (0)
    DSA_ISSUE_V(0, 0); DSA_ISSUE_V(1, 1);
    asm volatile("" ::: "memory");
    float mx = -INFINITY;
#pragma unroll
    for (int i = 0; i < 16; ++i) {
        const u32x2 sv = *(const LAS u32x2*)(sel + 16 * i + 4 * g);
#pragma unroll
        for (int r = 0; r < 4; ++r) { const int j = 16 * i + 4 * g + r; const int sj = (int)((r & 1) ? (sv[r >> 1] >> 16) : (sv[r >> 1] & 0xffffu));
            int d = t - sj; d = d < 0 ? 0 : (d > 127 ? 127 : d);
            const float v = (j < cnt) ? lg[i][r] + s_bias[d * 8 + hd] : -INFINITY; lg[i][r] = v; mx = fmaxf(mx, v); }
    }
    mx = fmaxf(mx, __shfl_xor(mx, 16)); mx = fmaxf(mx, __shfl_xor(mx, 32));
    float sm = 0.f;
#pragma unroll
    for (int i = 0; i < 16; ++i)
#pragma unroll
        for (int r = 0; r < 4; ++r) { const float p = __expf(lg[i][r] - mx); lg[i][r] = p; sm += p; }
    sm += __shfl_xor(sm, 16); sm += __shfl_xor(sm, 32);
    const float inv = 1.f / sm;
    bf16x8_t pa[8];
#pragma unroll
    for (int ks = 0; ks < 8; ++ks) { u32x4 p; const f32x4 p0 = lg[2 * ks], p1 = lg[2 * ks + 1];
        p.x = pg8::cvt_pk_bf16(p0[0], p0[1]); p.y = pg8::cvt_pk_bf16(p0[2], p0[3]); p.z = pg8::cvt_pk_bf16(p1[0], p1[1]); p.w = pg8::cvt_pk_bf16(p1[2], p1[3]);
        pa[ks] = __builtin_bit_cast(bf16x8_t, p); }
    f32x4 out[8];
#pragma unroll
    for (int c = 0; c < 8; ++c) out[c] = (f32x4){0.f, 0.f, 0.f, 0.f};
    const int tq = fr >> 2, tp = fr & 3;
    const unsigned traddr = (unsigned)(uintptr_t)vt + VT_STRIDE * (4 * g + tq) + 16 * (tp >> 1) + 8 * (tp & 1);
    DSA_ISSUE_V(2, 2); DSA_ISSUE_V(3, 3);
    asm volatile("" ::: "memory");
#pragma unroll
    for (int ks = 0; ks < 8; ++ks) {
#pragma unroll
        for (int i = 0; i < 4; ++i) {
            u32x4 lo, hi4;
#pragma unroll
            for (int q = 0; q < 4; ++q) { const unsigned w = vr[ks & 3][i][q];
                const f32x2_t a0 = __builtin_amdgcn_cvt_pk_f32_fp8((int)w, false), a1 = __builtin_amdgcn_cvt_pk_f32_fp8((int)w, true);
                const unsigned b0 = pg8::cvt_pk_bf16(a0.x, a0.y), b1 = pg8::cvt_pk_bf16(a1.x, a1.y);
                if (q < 2) { lo[2 * q] = b0; lo[2 * q + 1] = b1; } else { hi4[2 * (q - 2)] = b0; hi4[2 * (q - 2) + 1] = b1; } }
            LAS u32x4* dst = (LAS u32x4*)(vt + (8 * i + (lane >> 3)) * VT_STRIDE + 32 * (lane & 7));
            dst[0] = lo; dst[1] = hi4;
        }
        if (ks + 4 < 8) DSA_ISSUE_V(ks + 4, ks & 3);
        LDS_WAIT();
#pragma unroll
        for (int half = 0; half < 2; ++half) {
            s16x4 tr[8];
            if (half == 0) tr8_dsa0(traddr, tr); else tr8_dsa1(traddr, tr);
#pragma unroll
            for (int cc = 0; cc < 4; ++cc) {
                const bf16x8_t vf = __builtin_shufflevector(tr[2 * cc], tr[2 * cc + 1], 0, 1, 2, 3, 4, 5, 6, 7);
                out[4 * half + cc] = __builtin_amdgcn_mfma_f32_16x16x32_bf16(pa[ks], vf, out[4 * half + cc], 0, 0, 0);
            }
        }
        asm volatile("" ::: "memory");
    }
#undef DSA_ISSUE_V
    float invh[4];
#pragma unroll
    for (int r = 0; r < 4; ++r) invh[r] = __shfl(inv, 4 * (g & 1) + r);
    float ss = 0.f;
#pragma unroll
    for (int c = 0; c < 8; ++c)
#pragma unroll
        for (int r = 0; r < 4; ++r) { const float v = out[c][r] * invh[r]; out[c][r] = v; ss += (g < 2) ? v * v : 0.f; }
    const float rstd = rsqrtf(wave_sum(ss) * (1.f / 1024.f) + EPS);
    if (g < 2) {
#pragma unroll
        for (int c = 0; c < 8; ++c)
#pragma unroll
            for (int r = 0; r < 4; ++r) { const int e = (4 * g + r) * 128 + 16 * c + fr; O[m * D + e] = f2bf(out[c][r] * rstd * gn_a[e]); }
    }
}
__device__ __forceinline__ void idx4(const bf16_t* __restrict__ B0, const bf16_t* __restrict__ QI, int b, int t0, float* __restrict__ SCW) {
    int lane = threadIdx.x & 63; asm volatile("" : "+v"(lane));
    const int r32 = lane & 31, hi = lane >> 5;
    bf16x8_t aq[2][4]; float wv[2][16];
#pragma unroll
    for (int blk = 0; blk < 2; ++blk) {
        const int tt = (r32 >> 2) & 1, hh = (r32 & 3) + 4 * (r32 >> 3);
        const bf16_t* qp = QI + (size_t)(b * S + t0 + 2 * blk + tt) * 1024 + hh * 64 + 32 * hi;
#pragma unroll
        for (int kk = 0; kk < 4; ++kk) aq[blk][kk] = *(const bf16x8_t*)(qp + 8 * kk);
        const bf16_t* wp = B0 + (size_t)(b * S + t0 + 2 * blk + hi) * 1024 + 832;
        const u32x4 w0 = *(const u32x4*)wp, w1 = *(const u32x4*)(wp + 8);
#pragma unroll
        for (int j = 0; j < 4; ++j) { wv[blk][2 * j] = __uint_as_float(w0[j] << 16); wv[blk][2 * j + 1] = __uint_as_float(w0[j] & 0xffff0000u); wv[blk][8 + 2 * j] = __uint_as_float(w1[j] << 16); wv[blk][8 + 2 * j + 1] = __uint_as_float(w1[j] & 0xffff0000u); }
    }
    const bf16_t* kb = B0 + (size_t)(b * S + r32) * 1024 + 768 + 32 * hi;
    const int nsub = (t0 + 3) / 32 + 1;
    bf16x8_t bk[3][4];
#define IDX_ISSUE(sub, slot) do { const int sb_ = (sub) < nsub ? (sub) : nsub - 1; const bf16_t* p_ = kb + (size_t)sb_ * 32 * 1024; \
        _Pragma("unroll") for (int kk = 0; kk < 4; ++kk) bk[slot][kk] = *(const bf16x8_t*)(p_ + 8 * kk); } while (0)
    IDX_ISSUE(0, 0); IDX_ISSUE(1, 1); IDX_ISSUE(2, 2);
    for (int sub0 = 0; sub0 < nsub; sub0 += 3) {
#pragma unroll
        for (int j = 0; j < 3; ++j) {
            const int sub = sub0 + j;
            if (sub < nsub) {
#pragma unroll
                for (int blk = 0; blk < 2; ++blk) {
                    f32x16 sc;
#pragma unroll
                    for (int i = 0; i < 16; ++i) sc[i] = 0.f;
#pragma unroll
                    for (int kk = 0; kk < 4; ++kk) sc = __builtin_amdgcn_mfma_f32_32x32x16_bf16(aq[blk][kk], bk[j][kk], sc, 0, 0, 0);
                    float score = 0.f;
#pragma unroll
                    for (int i = 0; i < 16; ++i) score += wv[blk][i] * fmaxf(sc[i], 0.f);
                    SCW[(size_t)(2 * blk + hi) * 4096 + sub * 32 + r32] = score;
                }
            }
            IDX_ISSUE(sub + 3, j);
            asm volatile("" ::: "memory");
        }
    }
#undef IDX_ISSUE
}
__device__ __forceinline__ void p5_attn(const MkArgs& a, LAS unsigned char* lds) {
    const int tid = threadIdx.x, lane = tid & 63, wave = __builtin_amdgcn_readfirstlane(tid >> 6);
    const bf16_t* B0 = (const bf16_t*)(a.ws + WS_B0); const bf16_t* QI = (const bf16_t*)(a.ws + WS_QI); const bf16_t* QA = (const bf16_t*)(a.ws + WS_QA);
    const bf16_t* QB = (const bf16_t*)(a.ws + WS_QB); const bf16_t* KB = (const bf16_t*)(a.ws + WS_KB); const bf16_t* VB = (const bf16_t*)(a.ws + WS_VB);
    bf16_t* O = (bf16_t*)(a.ws + WS_O); float* OBS = (float*)(a.ws + WS_OBS); const float* rel_bias = a.in[10];
    const int gw = blockIdx.x * 8 + wave;
    float* SCW = (float*)(a.ws + (gw < 1024 ? WS_XN : WS_OBRAW)) + (size_t)(gw & 1023) * (4 * 4096);
    constexpr int KT_BYTES = 128 * 144;
    LAS unsigned char* s_kt = lds;
    LAS unsigned char* s_vt = lds + wave * 9216;
    LAS float* s_bias = (LAS float*)(lds + 73728);
    LAS unsigned short* s_sel = (LAS unsigned short*)(lds + 77824 + wave * 2048);
    for (int i = tid; i < 1024; i += MK_THREADS) s_bias[i] = rel_bias[t5_bucket(i >> 3) * 8 + (i & 7)];
    const bool xcd_ok = (gridDim.x & 7) == 0;
    const int xb = xcd_ok ? (((int)blockIdx.x & 7) >> 1) : 0, rbk = xcd_ok ? (((int)blockIdx.x >> 3) * 2 + ((int)blockIdx.x & 1)) : (int)blockIdx.x, RB = xcd_ok ? (int)(gridDim.x >> 2) : (int)gridDim.x;
    const int nitem = xcd_ok ? 128 : 512;
    for (int q = 0; q * RB < nitem; ++q) {
        const int it = (q & 1) ? (q * RB + (RB - 1 - rbk)) : (q * RB + rbk);
        if (it >= nitem) continue;
        const int b = xcd_ok ? xb : (it & 3), t0i = (xcd_ok ? it : (it >> 2)) * 32, t0 = t0i + 4 * wave;
        {
            int ln = lane; asm volatile("" : "+v"(ln));
            const int r32 = ln & 31, hi = ln >> 5;
            bf16x8_t aq[2][4]; float wv[2][16];
#pragma unroll
            for (int blk = 0; blk < 2; ++blk) {
                const int tt = (r32 >> 2) & 1, hh = (r32 & 3) + 4 * (r32 >> 3);
                const bf16_t* qp = QI + (size_t)(b * S + t0 + 2 * blk + tt) * 1024 + hh * 64 + 32 * hi;
#pragma unroll
                for (int kk = 0; kk < 4; ++kk) aq[blk][kk] = *(const bf16x8_t*)(qp + 8 * kk);
                const bf16_t* wp = B0 + (size_t)(b * S + t0 + 2 * blk + hi) * 1024 + 832;
                const u32x4 w0 = *(const u32x4*)wp, w1 = *(const u32x4*)(wp + 8);
#pragma unroll
                for (int j = 0; j < 4; ++j) { wv[blk][2 * j] = __uint_as_float(w0[j] << 16); wv[blk][2 * j + 1] = __uint_as_float(w0[j] & 0xffff0000u); wv[blk][8 + 2 * j] = __uint_as_float(w1[j] << 16); wv[blk][8 + 2 * j + 1] = __uint_as_float(w1[j] & 0xffff0000u); }
            }
            const int nkb = (t0i + 31) / 128 + 1;
            REP(50) {
                const int key = tid >> 2, q4 = tid & 3;
                const bf16_t* src = B0 + (size_t)(b * S + key) * 1024 + 768 + 16 * q4;
                u32x4 v0 = *(const u32x4*)src, v1 = *(const u32x4*)(src + 8);
                __syncthreads();
                *(LAS u32x4*)(s_kt + key * 144 + q4 * 32) = v0; *(LAS u32x4*)(s_kt + key * 144 + q4 * 32 + 16) = v1;
                __syncthreads();
                for (int kb = 0; kb < nkb; ++kb) {
                    LAS unsigned char* cur = s_kt + (kb & 1) * KT_BYTES; LAS unsigned char* nxt = s_kt + ((kb + 1) & 1) * KT_BYTES;
                    const bool more = kb + 1 < nkb;
                    if (more) { const bf16_t* sn = src + (size_t)(kb + 1) * 128 * 1024; v0 = *(const u32x4*)sn; v1 = *(const u32x4*)(sn + 8); }
#pragma unroll
                    for (int sub = 0; sub < 4; ++sub) {
                        bf16x8_t bk[4];
#pragma unroll
                        for (int kk = 0; kk < 4; ++kk) bk[kk] = *(const LAS bf16x8_t*)(cur + (32 * sub + r32) * 144 + (32 * hi + 8 * kk) * 2);
#pragma unroll
                        for (int blk = 0; blk < 2; ++blk) {
                            f32x16 sc;
#pragma unroll
                            for (int i = 0; i < 16; ++i) sc[i] = 0.f;
#pragma unroll
                            for (int kk = 0; kk < 4; ++kk) sc = __builtin_amdgcn_mfma_f32_32x32x16_bf16(aq[blk][kk], bk[kk], sc, 0, 0, 0);
                            float score = 0.f;
#pragma unroll
                            for (int i = 0; i < 16; ++i) score += wv[blk][i] * fmaxf(sc[i], 0.f);
                            SCW[(size_t)(2 * blk + hi) * 4096 + kb * 128 + sub * 32 + r32] = score;
                        }
                    }
                    if (more) { *(LAS u32x4*)(nxt + key * 144 + q4 * 32) = v0; *(LAS u32x4*)(nxt + key * 144 + q4 * 32 + 16) = v1; }
                    __syncthreads();
                }
            }
        }
        asm volatile("s_waitcnt vmcnt(0)" ::: "memory");
        REP(51) for (int tt = 0; tt < 4; ++tt) {
            const int t = t0 + tt, n = t + 1; const float* row = SCW + (size_t)tt * 4096; LAS unsigned short* sel = s_sel + tt * 256;
            if (n <= 256) { for (int i = 0; i < 4; ++i) { const int j = lane + 64 * i; sel[j] = (unsigned short)(j < n ? j : 0); } }
            else if (n <= 1024) topk_row<16>(row, n, sel, lane);
            else if (n <= 2048) topk_row<32>(row, n, sel, lane);
            else if (n <= 3072) topk_row<48>(row, n, sel, lane);
            else topk_row<64>(row, n, sel, lane);
        }
        LDS_WAIT();
        REP(52) for (int tt = 0; tt < 4; ++tt) {
            const int t = t0 + tt;
            dsa_token(a.ws + WS_KV8, QA, a.in[8], a.in[11], O, b, t, t + 1 < 256 ? t + 1 : 256, s_sel + tt * 256, s_bias, s_vt);
        }
        REP(53) {
            const int h = wave, q0 = t0i;
            f32x16 o[4];
            sb_wave(QB, KB, VB, b, h, q0, s_vt, o);
            const int r32 = lane & 31, hi = lane >> 5;
            float ss = 0.f;
#pragma unroll
            for (int c = 0; c < 4; ++c)
#pragma unroll
                for (int i = 0; i < 16; ++i) ss += o[c][i] * o[c][i];
            ss += __shfl_xor(ss, 32);
            const size_t m = (size_t)b * S + q0 + r32;
            if (hi == 0) OBS[m * 8 + h] = ss;
            bf16_t* op = O + m * D + 1024 + h * 128;
#pragma unroll
            for (int c = 0; c < 4; ++c)
#pragma unroll
                for (int g = 0; g < 4; ++g) { const int d = 32 * c + 8 * g + 4 * hi;
                    u32x2 w; w.x = pk2(o[c][4 * g], o[c][4 * g + 1]); w.y = pk2(o[c][4 * g + 2], o[c][4 * g + 3]); *(u32x2*)(op + d) = w; }
        }
    }
}
__device__ __forceinline__ void obnorm_pass(const MkArgs& a) {
    const int tid = threadIdx.x, lane = tid & 63, wave = __builtin_amdgcn_readfirstlane(tid >> 6);
    bf16_t* O = (bf16_t*)(a.ws + WS_O); const float* OBS = (const float*)(a.ws + WS_OBS); const float* gn_b = a.in[12];
    f32x4 gv[4];
#pragma unroll
    for (int j = 0; j < 4; ++j) gv[j] = *(const f32x4*)(gn_b + 16 * lane + 4 * j);
    for (int m = blockIdx.x * 8 + wave; m < M; m += gridDim.x * 8) {
        const f32x4 s0 = *(const f32x4*)(OBS + (size_t)m * 8), s1 = *(const f32x4*)(OBS + (size_t)m * 8 + 4);
        const float rstd = rsqrtf(((s0[0] + s0[1]) + (s0[2] + s0[3]) + (s1[0] + s1[1]) + (s1[2] + s1[3])) * (1.f / 1024.f) + EPS);
        u32x4* p = (u32x4*)(O + (size_t)m * D + 1024 + 16 * lane);
        u32x4 v0 = p[0], v1 = p[1];
#pragma unroll
        for (int j = 0; j < 4; ++j) { const float lo0 = __uint_as_float(v0[j] << 16) * rstd, hi0 = __uint_as_float(v0[j] & 0xffff0000u) * rstd;
            const float lo1 = __uint_as_float(v1[j] << 16) * rstd, hi1 = __uint_as_float(v1[j] & 0xffff0000u) * rstd;
            v0[j] = pk2(lo0 * gv[j >> 1][2 * (j & 1)], hi0 * gv[j >> 1][2 * (j & 1) + 1]); v1[j] = pk2(lo1 * gv[2 + (j >> 1)][2 * (j & 1)], hi1 * gv[2 + (j >> 1)][2 * (j & 1) + 1]); }
        p[0] = v0; p[1] = v1;
    }
}

constexpr int CW_BAR = 4096;
__global__ void __launch_bounds__(MK_THREADS, 2) mk_fwd(MkArgs a) {
    extern __shared__ __attribute__((aligned(16))) unsigned char lds_raw[];
    LAS unsigned char* lds = (LAS unsigned char*)lds_raw;
    const int lo = a.ph_lo, hi = a.ph_hi;
    const bool fused = (hi - lo) > 1;
    volatile LAS unsigned* misc = (volatile LAS unsigned*)(lds + MK_MISC_OFF);
    XcdBarrier bar; bar.bar = (unsigned*)(a.ws + WS_CTL) + CW_BAR; bar.x = 0; bar.st = misc + 8;
    if (fused) {
        if (threadIdx.x < 32) misc[threadIdx.x] = 0u;
        __syncthreads();
        bar = xcd_barrier_post((unsigned*)(a.ws + WS_CTL) + CW_BAR, misc + 8);
    }
    int nbar = 0;
    if (a.ph_lo < 0) cg::this_grid().sync();
#ifdef MK_TS_A
    volatile LAS unsigned* ts_ = (volatile LAS unsigned*)(lds + MK_MISC_OFF + 128); int nts_ = 0;
#define STAMP() do { if (threadIdx.x == 0) ts_[nts_] = (unsigned)__builtin_amdgcn_s_memrealtime(); ++nts_; } while (0)
#else
#define STAMP() do {} while (0)
#endif
    STAMP();
#define IN(k) (lo <= (k) && (k) < hi)
#define SEAM() do { if (fused) { xcd_barrier(bar); ++nbar; } STAMP(); } while (0)
    if (IN(0)) { REP(0) { p0_prep(a, lds); __syncthreads(); } SEAM(); }
    if (IN(1)) { REP(1) { p1_xn(a, lds); __syncthreads(); } SEAM(); }
    if (IN(2)) {
        pg8::Gemm g{(const bf16_t*)(a.ws + WS_XN), (const bf16_t*)(a.ws + WS_WTIN), M, 4096, D, D, D};
        pg8::StaticOrder S; S.init(g, (int)gridDim.x, (int)blockIdx.x, (MK_DUP) == 2 ? 2 : 1);
        EpiInProj E{(bf16_t*)(a.ws + WS_B0), (bf16_t*)(a.ws + WS_QB), (bf16_t*)(a.ws + WS_KB), (bf16_t*)(a.ws + WS_VB), (float*)(a.ws + WS_SSQ)};
        pg8::gemm_phase<EpiInProj, pg8::StaticOrder>(lds, g, S, E);
        SEAM();
    }
    if (IN(3)) {
        kanorm_pass(a);
        pg8::Gemm g{(const bf16_t*)(a.ws + WS_B0), (const bf16_t*)(a.ws + WS_WTQUP), M, 2048, 512, 1024, 512};
        pg8::StaticOrder S; S.init(g, (int)gridDim.x, (int)blockIdx.x, (MK_DUP) == 3 ? 2 : 1);
        EpiQupG E{(const float*)(a.ws + WS_SSQ), (bf16_t*)(a.ws + WS_QA), (bf16_t*)(a.ws + WS_QI)};
        pg8::gemm_phase<EpiQupG, pg8::StaticOrder>(lds, g, S, E);
        SEAM();
    }
    if (IN(5)) { REP(5) { p5_attn(a, lds); __syncthreads(); } SEAM(); }
    if (IN(7)) {
        obnorm_pass(a);
        pg8::Gemm g{(const bf16_t*)(a.ws + WS_O), (const bf16_t*)(a.ws + WS_WTOUT), M, D, D, D, D};
        pg8::StaticOrder S; S.init(g, (int)gridDim.x, (int)blockIdx.x, (MK_DUP) == 7 ? 2 : 1);
        EpiOutProj E{a.in[0], (const float*)(a.ws + WS_MOD), (bf16_t*)(a.ws + WS_X1B)};
        pg8::gemm_phase<EpiOutProj, pg8::StaticOrder>(lds, g, S, E);
        SEAM();
    }
    if (IN(8)) { p8_route(a, lds); SEAM(); }
    if (IN(9)) {
        const MoeTab t = moe_tab_build(a, lds);
        pg8::Gemm g{(const bf16_t*)(a.ws + WS_XN), (const bf16_t*)(a.ws + WS_WTGU), 0, 0, D, D, D};
        SchedGU S; S.init(t, a, (int)gridDim.x, (int)blockIdx.x, (MK_DUP) == 9 ? 2 : 1);
        EpiGU E{(bf16_t*)(a.ws + WS_U)};
        pg8::gemm_phase<EpiGU, SchedGU>(lds, g, S, E);
        SEAM();
    }
    if (IN(10)) {
        const MoeTab t = moe_tab_build(a, lds);
        pg8::Gemm g{(const bf16_t*)(a.ws + WS_U), (const bf16_t*)(a.ws + WS_WTDN), 0, 0, 512, 512, 512};
        SchedDN S; S.init(t, a, (int)gridDim.x, (int)blockIdx.x, (MK_DUP) == 10 ? 2 : 1);
        EpiY E{(bf16_t*)(a.ws + WS_Y)};
        pg8::gemm_phase<EpiY, SchedDN>(lds, g, S, E);
        SEAM();
    }
    if (IN(11)) {
        const MoeTab t = moe_tab_build(a, lds);
        REP(11) p11_combine(a, t);
    }
#ifdef MK_XBAR
    for (int i_ = 0; i_ < MK_XBAR; ++i_) { SEAM(); }
#endif
#ifdef MK_TS_A
    SEAM();
    __syncthreads();
    if (blockIdx.x == 0) {
        const float db = (MK_TS_A == 10) ? (float)(ts_[10] - ts_[0]) * 0.01f : (float)(ts_[MK_TS_A + 1] - ts_[MK_TS_A]) * 0.01f;
#ifdef MK_TS_Q
        const float dq = (float)(MK_TS_Q) * rintf(db / (float)(MK_TS_Q));
#else
        const float dq = db;
#endif
        for (int i = threadIdx.x; i < (1 << 20); i += MK_THREADS) a.out[4096 + i] *= (1.f + dq * (MK_TS_C));
    }
#endif
#undef IN
#undef SEAM
}

#ifndef MK_ONE_LAUNCH
#define MK_ONE_LAUNCH 1
#endif
extern "C" void kernel_launch(void* const* d_in, const int* in_sizes, int n_in, void* d_out, int out_size, void* d_ws, size_t ws_size, hipStream_t stream) {
    static int grid = 0;
    if (grid == 0) {
        if (ws_size < WS_END || n_in != 20 || out_size != M * D) { fprintf(stderr, "kernel_launch: unexpected sizes: ws %zu (need %zu), n_in %d, out %d\n", ws_size, (size_t)WS_END, n_in, out_size); grid = -1; return; }
        int dev = 0, cus = 0, per_cu = 0;
        if (hipGetDevice(&dev) != hipSuccess || hipDeviceGetAttribute(&cus, hipDeviceAttributeMultiprocessorCount, dev) != hipSuccess) { grid = -1; return; }
        if (hipFuncSetAttribute((const void*)mk_fwd, hipFuncAttributeMaxDynamicSharedMemorySize, MK_LDS) != hipSuccess) { fprintf(stderr, "kernel_launch: hipFuncSetAttribute failed\n"); grid = -1; return; }
        if (hipOccupancyMaxActiveBlocksPerMultiprocessor(&per_cu, (const void*)mk_fwd, MK_THREADS, MK_LDS) != hipSuccess || per_cu < 1) { fprintf(stderr, "kernel_launch: occupancy query failed (%d)\n", per_cu); grid = -1; return; }
        grid = cus < 256 ? cus : 256;
        fprintf(stderr, "kernel_launch: cus %d per_cu %d grid %d\n", cus, per_cu, grid);
    }
    if (grid < 0) return;
    if (hipMemsetAsync(d_ws, 0, 1 * MiB, stream) != hipSuccess) return;
    MkArgs a{};
    for (int i = 0; i < 20; ++i) a.in[i] = (const float*)d_in[i];
    a.out = (float*)d_out; a.ws = (unsigned char*)d_ws;
#if MK_ONE_LAUNCH
    a.ph_lo = 0; a.ph_hi = 12;
    void* args[] = {&a};
    const hipError_t e = hipLaunchCooperativeKernel((const void*)mk_fwd, dim3(grid), dim3(MK_THREADS), args, MK_LDS, stream);
    if (e != hipSuccess) fprintf(stderr, "kernel_launch: cooperative launch failed: %s (grid %d)\n", hipGetErrorString(e), grid);
#else
    const int phases[] = {0, 1, 2, 3, 5, 7, 8, 9, 10, 11};
    for (int ph : phases) { a.ph_lo = ph; a.ph_hi = ph + 1; hipLaunchKernelGGL(mk_fwd, dim3(grid), dim3(MK_THREADS), MK_LDS, stream, a); }
#endif
}
```
